# Optimizing an MI355X kernel written in HIP

```python
import math
import jax, jax.numpy as jnp
from jax import lax
import numpy as np

D_MODEL = 1024
BATCH = 4
SEQ = 8192
DEPTH = 2

GRID_W = 64
CTX_LEN = 256
HEAD_DIM = 64
N_Q_HEADS = 8
N_KV_HEADS = 4
GROUP = N_Q_HEADS // N_KV_HEADS
Q_W = N_Q_HEADS * HEAD_DIM
KV_W = N_KV_HEADS * HEAD_DIM
QKV_W = Q_W + 2 * KV_W
CONV_W = D_MODEL // 2
MIX_IN_W = QKV_W + 3 * CONV_W
MIX_OUT_W = Q_W + CONV_W
Q_BLOCK = 128
WINDOW = 128
ROPE_THETA = 10000.0
FILT_EMB = 33
FILT_WIDTH = 64
DECAY_TARGET = 1e-2
FAST_DECAY_PCT = 0.3
SLOW_DECAY_PCT = 1.5
DECAY_SHIFT = 0.05
D_FF = 2816
N_EVEN = (DEPTH + 1) // 2
N_ODD = DEPTH // 2
NEG_INF = -1e30
RMS_EPS = 1e-6

kernel_name = 'hybrid_flow_backbone'


def rmsnorm(x, g):
    xf = x.astype(jnp.float32)
    xf = xf * lax.rsqrt(jnp.mean(xf * xf, axis=-1, keepdims=True) + RMS_EPS)
    return xf.astype(x.dtype) * g


def modulate(x, g, shift, scale):
    return rmsnorm(x, g) * (1 + scale) + shift


def dwconv3(x, w):
    xp = jnp.pad(x, ((0, 0), (1, 1), (0, 0)))
    return xp[:, :-2] * w[0] + xp[:, 1:-1] * w[1] + xp[:, 2:] * w[2]


def axial_angles(rows):
    row = jnp.repeat(jnp.arange(rows), GRID_W).astype(jnp.float32)
    col = jnp.tile(jnp.arange(GRID_W), rows).astype(jnp.float32)
    n_freq = HEAD_DIM // 4
    inv = ROPE_THETA ** (-jnp.arange(n_freq, dtype=jnp.float32) / n_freq)
    return row[:, None] * inv, col[:, None] * inv


def rope_half(x, ang):
    x1, x2 = jnp.split(x, 2, axis=-1)
    cos = jnp.cos(ang).astype(x.dtype)
    sin = jnp.sin(ang).astype(x.dtype)
    return jnp.concatenate([x1 * cos - x2 * sin, x1 * sin + x2 * cos], axis=-1)


def rope_2d(x, ang_row, ang_col):
    xr, xc = jnp.split(x, 2, axis=-1)
    return jnp.concatenate([rope_half(xr, ang_row), rope_half(xc, ang_col)], axis=-1)


def split_kv(z):
    b, s, _ = z.shape
    k = z[..., :KV_W].reshape(b, s, N_KV_HEADS, HEAD_DIM).transpose(0, 2, 1, 3)
    v = z[..., KV_W:].reshape(b, s, N_KV_HEADS, HEAD_DIM).transpose(0, 2, 1, 3)
    return k, v


def split_qkv(z):
    b, s, _ = z.shape
    q = z[..., :Q_W].reshape(b, s, N_KV_HEADS, GROUP, HEAD_DIM).transpose(0, 2, 3, 1, 4)
    k, v = split_kv(z[..., Q_W:QKV_W])
    return q, k, v


def merge_heads(o):
    b, h, g, s, d = o.shape
    return o.transpose(0, 3, 1, 2, 4).reshape(b, s, h * g * d)


def attend(q, k, v, sink=None):
    s = jnp.einsum('bhgqd,bhkd->bhgqk', q, k).astype(jnp.float32) * HEAD_DIM ** -0.5
    if sink is None:
        p = jax.nn.softmax(s, axis=-1)
    else:
        sk = jnp.broadcast_to(sink.astype(jnp.float32)[None, :, :, None, None], s.shape[:-1] + (1,))
        p = jax.nn.softmax(jnp.concatenate([s, sk], axis=-1), axis=-1)[..., :-1]
    return jnp.einsum('bhgqk,bhkd->bhgqd', p.astype(v.dtype), v)


def dense_block_attention(q, k, v, kc, vc):
    b, h, g, s, d = q.shape
    nb = s // Q_BLOCK
    kk = jnp.concatenate([k, kc], axis=2)
    vv = jnp.concatenate([v, vc], axis=2)
    qb = q.reshape(b, h, g, nb, Q_BLOCK, d).transpose(3, 0, 1, 2, 4, 5)
    out = lax.map(lambda qblk: attend(qblk, kk, vv), qb)
    return out.transpose(1, 2, 3, 0, 4, 5).reshape(b, h, g, s, d)


def banded_attention(q, k, v, kc, vc, sink):
    b, h, g, s, d = q.shape
    nb = s // Q_BLOCK
    qb = q.reshape(b, h, g, nb, Q_BLOCK, d)

    def band(t):
        tp = jnp.pad(t.reshape(b, h, nb, Q_BLOCK, d), ((0, 0), (0, 0), (1, 1), (0, 0), (0, 0)))
        return jnp.concatenate([tp[:, :, :-2], tp[:, :, 1:-1], tp[:, :, 2:]], axis=3)

    kb, vb = band(k), band(v)
    scale = HEAD_DIM ** -0.5
    s_loc = jnp.einsum('bhgnqd,bhnkd->bhgnqk', qb, kb).astype(jnp.float32) * scale
    s_ctx = jnp.einsum('bhgnqd,bhkd->bhgnqk', qb, kc).astype(jnp.float32) * scale
    blk = jnp.arange(nb)[:, None, None]
    qi = blk * Q_BLOCK + jnp.arange(Q_BLOCK)[None, :, None]
    kj = (blk - 1) * Q_BLOCK + jnp.arange(3 * Q_BLOCK)[None, None, :]
    ok = (jnp.abs(kj - qi) <= WINDOW) & (kj >= 0) & (kj < s)
    s_loc = jnp.where(ok, s_loc, NEG_INF)
    sk = jnp.broadcast_to(sink.astype(jnp.float32)[None, :, :, None, None, None], s_loc.shape[:-1] + (1,))
    p = jax.nn.softmax(jnp.concatenate([s_loc, s_ctx, sk], axis=-1), axis=-1).astype(v.dtype)
    n_loc = 3 * Q_BLOCK
    o = (jnp.einsum('bhgnqk,bhnkd->bhgnqd', p[..., :n_loc], vb)
         + jnp.einsum('bhgnqk,bhkd->bhgnqd', p[..., n_loc:-1], vc))
    return o.reshape(b, h, g, s, d)


def implicit_filter(n, w1, b1, w2, b2, w3, b3, w4, freq):
    t01 = jnp.linspace(0.0, 1.0, n, dtype=jnp.float32)[:, None]
    bands = (FILT_EMB - 1) // 2
    w = 2.0 * math.pi * jnp.arange(n, dtype=jnp.float32)[:, None] / n
    f = jnp.linspace(1e-4, bands - 1, bands, dtype=jnp.float32)[None, :]
    feats = jnp.concatenate([t01, jnp.cos(f * w), -jnp.sin(f * w)], axis=-1)
    hid = jnp.sin(freq * (feats @ w1 + b1))
    hid = jnp.sin(freq * (hid @ w2 + b2))
    hid = jnp.sin(freq * (hid @ w3 + b3))
    hf = (hid @ w4).astype(jnp.float32)
    deltas = jnp.abs(jnp.linspace(math.log(DECAY_TARGET) / SLOW_DECAY_PCT,
                                  math.log(DECAY_TARGET) / FAST_DECAY_PCT, CONV_W, dtype=jnp.float32))
    window = jnp.exp(-t01 * deltas) + DECAY_SHIFT
    h_fwd = hf[:, :CONV_W] * window
    h_bwd = hf[:, CONV_W:] * window
    k = jnp.concatenate([h_fwd, jnp.zeros((1, CONV_W), jnp.float32), h_bwd[:0:-1]], axis=0)
    return k / jnp.sum(jnp.abs(k), axis=0, keepdims=True)


def hyena(z, conv_w, conv_b, w1, b1, w2, b2, w3, b3, w4, freq, bias_d):
    n = z.shape[1]
    z = dwconv3(z, conv_w) + conv_b
    x0, x1, v = jnp.split(z, 3, axis=-1)
    k = implicit_filter(n, w1, b1, w2, b2, w3, b3, w4, freq)
    u = (v * x1).astype(jnp.float32)
    y = jnp.fft.irfft(jnp.fft.rfft(u, n=2 * n, axis=1) * jnp.fft.rfft(k, n=2 * n, axis=0)[None],
                      n=2 * n, axis=1)[:, :n]
    y = y + u * bias_d
    return (y * x0.astype(jnp.float32)).astype(z.dtype)


def short_conv_mixer(z, conv_w):
    bg, cg, xv = jnp.split(z, 3, axis=-1)
    return bg * dwconv3(cg * xv, conv_w)


def conv_ffn(h, w_up, conv_w, conv_b, w_down):
    a, v = jnp.split(h @ w_up, 2, axis=-1)
    a = dwconv3(a, conv_w) + conv_b
    return (jax.nn.gelu(a) * v) @ w_down


def setup_inputs(seed: int = 0) -> dict:
    key = jax.random.key(seed)
    keys = iter(jax.random.split(key, 40))

    def nrm(shape, scale):
        return jax.random.normal(next(keys), shape, jnp.float32) * scale

    def gain(shape):
        return 1.0 + nrm(shape, 0.02)

    return {
        'x': nrm((BATCH, SEQ, D_MODEL), 1.0),
        'c': nrm((BATCH, D_MODEL), 1.0),
        'ctx': nrm((BATCH, CTX_LEN, D_MODEL), 1.0),
        'c_ctx': nrm((D_MODEL,), 1.0),
        'ada_w': nrm((DEPTH, D_MODEL, 6 * D_MODEL), 0.5 * D_MODEL ** -0.5),
        'ada_b': nrm((DEPTH, 6 * D_MODEL), 0.01),
        'norm_mix': gain((DEPTH, D_MODEL)),
        'norm_ffn': gain((DEPTH, D_MODEL)),
        'mix_w_in': nrm((DEPTH, D_MODEL, MIX_IN_W), D_MODEL ** -0.5),
        'mix_w_out': nrm((DEPTH, MIX_OUT_W, D_MODEL), MIX_OUT_W ** -0.5),
        'attn_q_norm': gain((DEPTH, HEAD_DIM)),
        'attn_k_norm': gain((DEPTH, HEAD_DIM)),
        'swa_sink': nrm((N_ODD, N_Q_HEADS), 0.5),
        'hy_conv_w': nrm((N_EVEN, 3, 3 * CONV_W), 3 ** -0.5),
        'hy_conv_b': nrm((N_EVEN, 3 * CONV_W), 0.01),
        'hy_w1': nrm((N_EVEN, FILT_EMB, FILT_WIDTH), FILT_EMB ** -0.5),
        'hy_b1': nrm((N_EVEN, FILT_WIDTH), 0.1),
        'hy_w2': nrm((N_EVEN, FILT_WIDTH, FILT_WIDTH), FILT_WIDTH ** -0.5),
        'hy_b2': nrm((N_EVEN, FILT_WIDTH), 0.1),
        'hy_w3': nrm((N_EVEN, FILT_WIDTH, FILT_WIDTH), FILT_WIDTH ** -0.5),
        'hy_b3': nrm((N_EVEN, FILT_WIDTH), 0.1),
        'hy_w4': nrm((N_EVEN, FILT_WIDTH, 2 * CONV_W), FILT_WIDTH ** -0.5),
        'hy_freq': gain((N_EVEN, FILT_WIDTH)),
        'hy_bias_d': nrm((N_EVEN, CONV_W), 1.0),
        'sc_conv_w': nrm((N_ODD, 3, CONV_W), 3 ** -0.5),
        'ffn_w_up': nrm((DEPTH, D_MODEL, 2 * D_FF), D_MODEL ** -0.5),
        'ffn_conv_w': nrm((DEPTH, 3, D_FF), 3 ** -0.5),
        'ffn_conv_b': nrm((DEPTH, D_FF), 0.01),
        'ffn_w_down': nrm((DEPTH, D_FF, D_MODEL), D_FF ** -0.5),
    }


def reference(x, c, ctx, c_ctx, ada_w, ada_b, norm_mix, norm_ffn, mix_w_in, mix_w_out,
              attn_q_norm, attn_k_norm, swa_sink, hy_conv_w, hy_conv_b, hy_w1, hy_b1, hy_w2, hy_b2,
              hy_w3, hy_b3, hy_w4, hy_freq, hy_bias_d, sc_conv_w, ffn_w_up, ffn_conv_w, ffn_conv_b,
              ffn_w_down):
    rows = x.shape[1] // GRID_W
    ang_r, ang_c = axial_angles(rows)
    xc = ctx
    for i in range(DEPTH):
        last = i == DEPTH - 1
        j = i // 2
        mod = jax.nn.silu(c) @ ada_w[i] + ada_b[i]
        mod_c = jax.nn.silu(c_ctx) @ ada_w[i] + ada_b[i]
        sh1, sc1, g1, sh2, sc2, g2 = [m[:, None, :] for m in jnp.split(mod, 6, axis=-1)]
        sh1c, sc1c, g1c, sh2c, sc2c, g2c = jnp.split(mod_c, 6, axis=-1)
        w_in = mix_w_in[i]

        h = modulate(x, norm_mix[i], sh1, sc1)
        z = h @ w_in
        q, k, v = split_qkv(z)
        q = rope_2d(rmsnorm(q, attn_q_norm[i]), ang_r, ang_c)
        k = rope_2d(rmsnorm(k, attn_k_norm[i]), ang_r, ang_c)

        hc = modulate(xc, norm_mix[i], sh1c, sc1c)
        if last:
            kc, vc = split_kv(hc @ w_in[:, Q_W:QKV_W])
        else:
            zc = hc @ w_in
            qc, kc, vc = split_qkv(zc)
            qc = rmsnorm(qc, attn_q_norm[i])
        kc = rmsnorm(kc, attn_k_norm[i])

        if i % 2 == 0:
            hy_args = (hy_conv_w[j], hy_conv_b[j], hy_w1[j], hy_b1[j], hy_w2[j], hy_b2[j],
                       hy_w3[j], hy_b3[j], hy_w4[j], hy_freq[j], hy_bias_d[j])
            o_attn = dense_block_attention(q, k, v, kc, vc)
            o_conv = hyena(z[..., QKV_W:], *hy_args)
            if not last:
                oc_attn = attend(qc, kc, vc)
                oc_conv = hyena(zc[..., QKV_W:], *hy_args)
        else:
            sink = swa_sink[j].reshape(N_KV_HEADS, GROUP)
            o_attn = banded_attention(q, k, v, kc, vc, sink)
            o_conv = short_conv_mixer(z[..., QKV_W:], sc_conv_w[j])
            if not last:
                oc_attn = attend(qc, kc, vc, sink)
                oc_conv = short_conv_mixer(zc[..., QKV_W:], sc_conv_w[j])

        y = jnp.concatenate([merge_heads(o_attn), o_conv], axis=-1) @ mix_w_out[i]
        x = x + g1 * y
        x = x + g2 * conv_ffn(modulate(x, norm_ffn[i], sh2, sc2),
                              ffn_w_up[i], ffn_conv_w[i], ffn_conv_b[i], ffn_w_down[i])
        if not last:
            yc = jnp.concatenate([merge_heads(oc_attn), oc_conv], axis=-1) @ mix_w_out[i]
            xc = xc + g1c * yc
            xc = xc + g2c * conv_ffn(modulate(xc, norm_ffn[i], sh2c, sc2c),
                                     ffn_w_up[i], ffn_conv_w[i], ffn_conv_b[i], ffn_w_down[i])
    return x
```

```cpp
#include <hip/hip_runtime.h>
#include <hip/hip_cooperative_groups.h>
#include <hip/hip_bf16.h>
#include <cstdio>
#include <cstdint>
#include <cmath>
namespace cg = cooperative_groups;
namespace pg8 {
#define PG8_LAS __attribute__((address_space(3)))
typedef unsigned short bf16_t;
typedef short bf16x8 __attribute__((ext_vector_type(8)));
typedef float f32x4 __attribute__((ext_vector_type(4)));
typedef unsigned u32x4 __attribute__((ext_vector_type(4)));
constexpr int BM = 256, BK = 64, HALF = 128, HTB = HALF * BK * 2  , STAGE_BYTES = 8 * HTB, NXCD = 8, WGM = 8;

__host__ __device__ __forceinline__ int lds_byte(int r, int c) { const int st = (r >> 4) * 2 + (c >> 5), rr = r & 15, cc = c & 31, ob = rr * 64 + cc * 2; return st * 1024 + (ob ^ (((ob >> 9) & 1) << 5)); }
__host__ __device__ __forceinline__ void stage_rc(int b, int& R, int& C) { const int st = b / 1024, sb = b % 1024, swz = sb ^ (((sb >> 9) & 1) << 5); R = (st >> 1) * 16 + swz / 64; C = (st & 1) * 32 + (swz % 64) / 2; }
__host__ __device__ __forceinline__ int perm32(int rho) { const int n = rho >> 4, i = rho & 15; return 8 * (i >> 2) + 4 * n + (i & 3); }

struct Unit { int pm, pn; };
struct Gemm { const bf16_t* A; const bf16_t* Bt; int M, N, K; };

struct StaticOrder {
    int nM, nN, nwg, G, c;
    __host__ __device__ void init(int M, int N, int G_, int c_) { nM = M / BM; nN = N / BM; nwg = nM * nN; G = G_; c = c_; }
    __host__ __device__ bool next(int i, Unit& u) const {
        const long L = (long)i * G + c; if (L >= nwg) return false;
        int wgid = (int)L; { const int q = nwg / NXCD, r = nwg % NXCD, xcd = wgid % NXCD, off = wgid / NXCD; wgid = (xcd < r ? xcd * (q + 1) : r * (q + 1) + (xcd - r) * q) + off; }
        const int nig = WGM * nN, gid = wgid / nig, fm = gid * WGM, gsz = (nM - fm) < WGM ? (nM - fm) : WGM;
        u.pm = fm + ((wgid % nig) % gsz); u.pn = (wgid % nig) / gsz; return true;
    }
    __device__ __forceinline__ void a_ready(const Unit&) const {}
    __device__ __forceinline__ void done(const Unit&) const {}
};

__device__ __forceinline__ unsigned cvt_pk_bf16(float lo, float hi) { unsigned r; asm volatile("v_cvt_pk_bf16_f32 %0, %1, %2" : "=v"(r) : "v"(lo), "v"(hi)); return r; }
template <class Epi, class Sched, bool ALIGN_EPI = false, bool SP2 = false>
__device__ __forceinline__ void gemm_phase(PG8_LAS unsigned char* lds, const Gemm g, const Sched& S, const Epi& E) {
    int tid_o = threadIdx.x; asm volatile("" : "+v"(tid_o));
    const int tid = tid_o, wid = __builtin_amdgcn_readfirstlane(tid >> 6), lane = tid & 63, wr = wid >> 2, wc = wid & 3, fr = lane & 15, fq = lane >> 4;
    const int K = g.K, nt = K / BK;
    unsigned voffA[2], voffB[2];
#pragma unroll
    for (int i = 0; i < 2; ++i) { int R, C; stage_rc(tid * 16 + i * 8192, R, C); const int Rb = Epi::PERM ? ((R & ~31) + perm32(R & 31)) : R;
        voffA[i] = (unsigned)(R * K + C) * 2u; voffB[i] = (unsigned)(Rb * K + C) * 2u; }
    const size_t kstep = (size_t)(BK * 2);
    const size_t hstep = (size_t)HALF * K * 2;
    const size_t tstep = 2 * hstep;
    const unsigned ldsw = (unsigned)wid * 1024u;
    const int aoff = lds_byte(wr * 64 + fr, fq * 8), boff = lds_byte(wc * 32 + fr, fq * 8);
#define PG8_SA(b, h) (((b) * 2 + (h)) * HTB)
#define PG8_SB(b, h) ((4 + (b) * 2 + (h)) * HTB)
#define PG8_STAGE(bufoff, gbase, voff) do { _Pragma("unroll") for (int _i = 0; _i < 2; ++_i) \
        __builtin_amdgcn_global_load_lds((const unsigned*)((const char*)(gbase) + (voff)[_i]), (PG8_LAS unsigned*)(lds + (bufoff) + ldsw + _i * 8192), 16, 0, 0); } while (0)
#define PG8_LDA(dst, b, h) do { _Pragma("unroll") for (int m = 0; m < 4; ++m) _Pragma("unroll") for (int k = 0; k < 2; ++k) dst[m][k] = *(const PG8_LAS bf16x8*)(lds + PG8_SA(b, h) + aoff + m * 2048 + k * 1024); } while (0)
#define PG8_LDB(dst, b, h) do { _Pragma("unroll") for (int n = 0; n < 2; ++n) _Pragma("unroll") for (int k = 0; k < 2; ++k) dst[n][k] = *(const PG8_LAS bf16x8*)(lds + PG8_SB(b, h) + boff + n * 2048 + k * 1024); } while (0)
#define PG8_MMA(ai, bj, At, Bt) do { __builtin_amdgcn_s_setprio(1); _Pragma("unroll") for (int m = 0; m < 4; ++m) _Pragma("unroll") for (int n = 0; n < 2; ++n) _Pragma("unroll") for (int k = 0; k < 2; ++k) \
        acc[ai][bj][m][n] = __builtin_amdgcn_mfma_f32_16x16x32_bf16(Bt[n][k], At[m][k], acc[ai][bj][m][n], 0, 0, 0); __builtin_amdgcn_s_setprio(0); } while (0)
#define PG8_WAIT_V(n) asm volatile("s_waitcnt vmcnt(" #n ")" ::: "memory")
#define PG8_WAIT_L(n) asm volatile("s_waitcnt lgkmcnt(" #n ")" ::: "memory")
#define PG8_BAR __builtin_amdgcn_s_barrier()
#define PG8_SCHED __builtin_amdgcn_sched_barrier(0)
    Unit cur, nxt; int ui = 0;
    if (!S.next(0, cur)) return;
    f32x4 acc[2][2][4][2];
#pragma unroll
    for (int a = 0; a < 2; ++a)
#pragma unroll
        for (int b = 0; b < 2; ++b)
#pragma unroll
            for (int m = 0; m < 4; ++m)
#pragma unroll
                for (int n = 0; n < 2; ++n) acc[a][b][m][n] = (f32x4){0.f, 0.f, 0.f, 0.f};
    bf16x8 At[4][2], B0[2][2], B1[2][2];
    const char* cA = (const char*)g.A + (size_t)cur.pm * tstep; const char* cB = (const char*)g.Bt + (size_t)cur.pn * tstep;
    S.a_ready(cur);
    if constexpr (SP2) {
        PG8_STAGE(PG8_SB(0, 0), cB, voffB); PG8_STAGE(PG8_SB(0, 1), cB + hstep, voffB); PG8_STAGE(PG8_SA(0, 0), cA, voffA); PG8_STAGE(PG8_SA(0, 1), cA + hstep, voffA);
        if (wr == 1) PG8_BAR;
        PG8_WAIT_V(2); PG8_BAR;
        PG8_STAGE(PG8_SB(1, 0), cB + kstep, voffB); PG8_STAGE(PG8_SA(1, 0), cA + kstep, voffA); PG8_STAGE(PG8_SB(1, 1), cB + hstep + kstep, voffB);
        PG8_WAIT_V(6); PG8_BAR;
    } else {
        PG8_STAGE(PG8_SB(0, 0), cB, voffB); PG8_STAGE(PG8_SA(0, 0), cA, voffA); PG8_STAGE(PG8_SB(0, 1), cB + hstep, voffB); PG8_STAGE(PG8_SA(0, 1), cA + hstep, voffA);
        if (wr == 1) PG8_BAR;
        PG8_WAIT_V(4); PG8_BAR;
        PG8_STAGE(PG8_SB(1, 0), cB + kstep, voffB); PG8_STAGE(PG8_SA(1, 0), cA + kstep, voffA); PG8_STAGE(PG8_SB(1, 1), cB + hstep + kstep, voffB);
        PG8_WAIT_V(6); PG8_BAR;
    }
    for (;;) {
        const bool has_next = S.next(ui + 1, nxt);
        const char* nA = has_next ? (const char*)g.A + (size_t)nxt.pm * tstep : cA; const char* nB = has_next ? (const char*)g.Bt + (size_t)nxt.pn * tstep : cB;
        for (int t = 0; t < nt; t += 2) {
            const bool last = (t == nt - 2);
            const char* a1 = cA + (size_t)(t + 1) * kstep;
            const char* a2 = last ? nA : cA + (size_t)(t + 2) * kstep; const char* b2 = last ? nB : cB + (size_t)(t + 2) * kstep;
            const char* a3 = a2 + kstep; const char* b3 = b2 + kstep;
            if (last && has_next) S.a_ready(nxt);
            if constexpr (SP2) {
            PG8_LDB(B0, 0, 0); PG8_LDB(B1, 0, 1); PG8_SCHED; PG8_LDA(At, 0, 0); PG8_STAGE(PG8_SA(1, 1), a1 + hstep, voffA);
            PG8_WAIT_V(8); PG8_WAIT_L(0); PG8_BAR; PG8_MMA(0, 0, At, B0); PG8_MMA(0, 1, At, B1); PG8_BAR; PG8_SCHED;
            PG8_LDA(At, 0, 1); PG8_STAGE(PG8_SB(0, 0), b2, voffB); PG8_STAGE(PG8_SB(0, 1), b2 + hstep, voffB); PG8_STAGE(PG8_SA(0, 0), a2, voffA);
            PG8_WAIT_V(8); PG8_WAIT_L(0); PG8_BAR; PG8_MMA(1, 0, At, B0); PG8_MMA(1, 1, At, B1); PG8_BAR; PG8_SCHED;
            PG8_LDB(B0, 1, 0); PG8_LDB(B1, 1, 1); PG8_SCHED; PG8_LDA(At, 1, 0); PG8_STAGE(PG8_SA(0, 1), a2 + hstep, voffA);
            PG8_WAIT_V(8); PG8_WAIT_L(0); PG8_BAR; PG8_MMA(0, 0, At, B0); PG8_MMA(0, 1, At, B1); PG8_BAR; PG8_SCHED;
            PG8_LDA(At, 1, 1); PG8_STAGE(PG8_SB(1, 0), b3, voffB); PG8_STAGE(PG8_SB(1, 1), b3 + hstep, voffB); PG8_STAGE(PG8_SA(1, 0), a3, voffA);
            PG8_WAIT_V(8); PG8_WAIT_L(0); PG8_BAR; PG8_MMA(1, 0, At, B0); PG8_MMA(1, 1, At, B1); PG8_BAR; PG8_SCHED;
            } else {
            PG8_LDB(B0, 0, 0); PG8_SCHED; PG8_LDA(At, 0, 0); PG8_STAGE(PG8_SA(1, 1), a1 + hstep, voffA);
            PG8_WAIT_L(8); PG8_BAR; PG8_WAIT_L(0); PG8_MMA(0, 0, At, B0); PG8_BAR; PG8_SCHED;
            PG8_LDB(B1, 0, 1); PG8_STAGE(PG8_SB(0, 0), b2, voffB);
            PG8_BAR; PG8_WAIT_L(0); PG8_MMA(0, 1, At, B1); PG8_BAR;
            PG8_LDA(At, 0, 1); PG8_STAGE(PG8_SA(0, 0), a2, voffA);
            PG8_BAR; PG8_WAIT_L(0); PG8_MMA(1, 0, At, B0); PG8_BAR; PG8_SCHED;
            PG8_STAGE(PG8_SB(0, 1), b2 + hstep, voffB);
            PG8_WAIT_V(6); PG8_BAR; PG8_MMA(1, 1, At, B1); PG8_BAR;
            PG8_LDB(B0, 1, 0); PG8_SCHED; PG8_LDA(At, 1, 0); PG8_STAGE(PG8_SA(0, 1), a2 + hstep, voffA);
            PG8_WAIT_L(8); PG8_BAR; PG8_WAIT_L(0); PG8_MMA(0, 0, At, B0); PG8_BAR; PG8_SCHED;
            PG8_LDB(B1, 1, 1); PG8_STAGE(PG8_SB(1, 0), b3, voffB);
            PG8_BAR; PG8_WAIT_L(0); PG8_MMA(0, 1, At, B1); PG8_BAR;
            PG8_LDA(At, 1, 1); PG8_STAGE(PG8_SA(1, 0), a3, voffA);
            PG8_BAR; PG8_WAIT_L(0); PG8_MMA(1, 0, At, B0); PG8_BAR; PG8_SCHED;
            PG8_STAGE(PG8_SB(1, 1), b3 + hstep, voffB);
            PG8_WAIT_V(6); PG8_BAR; PG8_MMA(1, 1, At, B1); PG8_BAR;
            }
        }
        if constexpr (ALIGN_EPI) { if (wr == 0) PG8_BAR; }
        if constexpr (!Epi::AFTER_DRAIN) { E(acc, cur, wr, wc, fr, fq); S.done(cur); }
        if (!has_next) break;
#pragma unroll
        for (int a = 0; a < 2; ++a)
#pragma unroll
            for (int b = 0; b < 2; ++b)
#pragma unroll
                for (int m = 0; m < 4; ++m)
#pragma unroll
                    for (int n = 0; n < 2; ++n) acc[a][b][m][n] = (f32x4){0.f, 0.f, 0.f, 0.f};
        cur = nxt; cA = nA; cB = nB; ++ui;
        if constexpr (ALIGN_EPI) { if (wr == 1) PG8_BAR; }
    }
    PG8_WAIT_V(0);
    if constexpr (!ALIGN_EPI) { if (wr == 0) PG8_BAR; }
    PG8_BAR;
    if constexpr (Epi::AFTER_DRAIN) { E.fused(acc, cur, wr, wc, fr, fq, lds, wid, lane); S.done(cur); }
#undef PG8_SA
#undef PG8_SB
#undef PG8_STAGE
#undef PG8_LDA
#undef PG8_LDB
#undef PG8_MMA
#undef PG8_WAIT_V
#undef PG8_WAIT_L
#undef PG8_BAR
#undef PG8_SCHED
}
}
#include <hip/hip_bf16.h>
#include <cmath>
namespace attn_body {
using bf16=__hip_bfloat16;
using bf16x8=__attribute__((ext_vector_type(8)))short;
using s16x4=__attribute__((ext_vector_type(4)))short;
using f32x16=__attribute__((ext_vector_type(16)))float;
using u32x4=__attribute__((ext_vector_type(4)))unsigned;
constexpr int D=64,ZP=2560,OP=1024;
constexpr int NW=8,QBLK=32,QB=QBLK*NW,KVBLK=64;
__device__ __forceinline__ int crow(int r,int hi){return (r&3)+8*(r>>2)+4*hi;}
#define SBAR() __builtin_amdgcn_sched_barrier(0)
__device__ __forceinline__ void cmask(f32x16&p0,f32x16&p1,int jb,int qrel,int hi){
  const float NEG=-INFINITY; int kb=64*jb+4*hi;
  #pragma unroll
  for(int r=0;r<16;++r){int kv=kb+(r&3)+8*(r>>2); if(kv>qrel)p0[r]=NEG; if(kv+32>qrel)p1[r]=NEG;}
}

__device__ __forceinline__ void bandmask(f32x16&p0,f32x16&p1,int ktile0,int qabs,int hi){
  const float NEG=-INFINITY; const int kb=ktile0+4*hi-qabs;
  #pragma unroll
  for(int r=0;r<16;++r){int d=kb+(r&3)+8*(r>>2); if(d>128||d<-128)p0[r]=NEG; if(d+32>128||d+32<-128)p1[r]=NEG;}
}
constexpr int NSLOT=3, SLOTB=8192;
constexpr int LDS_K=0, LDS_V=NSLOT*SLOTB, LDS_WS=2*NSLOT*SLOTB, LDS_OST=LDS_WS+NW*64*4, LDS_BYTES=LDS_OST+NW*4096;
constexpr float C2=0.125f*1.4426950408889634f;
__device__ __forceinline__ void glds16(const void*gsrc,unsigned lds_dst){unsigned keep;
  asm volatile("s_mov_b32 %0, m0\n\ts_mov_b32 m0, %2\n\ts_nop 0\n\tglobal_load_lds_dwordx4 %1, off\n\ts_mov_b32 m0, %0":"=&s"(keep):"v"(gsrc),"s"(lds_dst):"memory");}
__device__ __forceinline__ float max3f(float a,float b,float c){float r;asm("v_max3_f32 %0, %1, %2, %3":"=v"(r):"v"(a),"v"(b),"v"(c));return r;}
__device__ __forceinline__ float max2f(float a,float b){float r;asm("v_max_f32_e32 %0, %1, %2":"=v"(r):"v"(a),"v"(b));return r;}
__device__ __forceinline__ float fadd_s(float a,float b){float r;asm("v_add_f32_e32 %0, %1, %2":"=v"(r):"v"(a),"v"(b));return r;}
__device__ __forceinline__ float fsub_s(float a,float b){float r;asm("v_sub_f32_e32 %0, %1, %2":"=v"(r):"v"(a),"v"(b));return r;}
typedef float f32x2_t __attribute__((ext_vector_type(2))); typedef __bf16 bf16x2_t __attribute__((ext_vector_type(2)));
__device__ __forceinline__ unsigned cvtpk_s(float lo,float hi){f32x2_t v={lo,hi};bf16x2_t b=__builtin_convertvector(v,bf16x2_t);return __builtin_bit_cast(unsigned,b);}
#define WAIT_BAR(N) asm volatile("s_waitcnt vmcnt(" #N ") lgkmcnt(0)\n\ts_barrier":::"memory")

__device__ __forceinline__ void qkt(f32x16&p0,f32x16&p1,const char*Kslot,const bf16x8*qr,const f32x16&negm,int r32,int hi){
  const char*kb=Kslot+hi*1024+r32*16;
  #pragma unroll
  for(int d0=0;d0<4;++d0){
    const bf16x8 b0=*reinterpret_cast<const bf16x8*>(kb+d0*2048);
    const bf16x8 b1=*reinterpret_cast<const bf16x8*>(kb+d0*2048+512);
    if(d0==0){p0=__builtin_amdgcn_mfma_f32_32x32x16_bf16(b0,qr[0],negm,0,0,0);p1=__builtin_amdgcn_mfma_f32_32x32x16_bf16(b1,qr[0],negm,0,0,0);}
    else{p0=__builtin_amdgcn_mfma_f32_32x32x16_bf16(b0,qr[d0],p0,0,0,0);p1=__builtin_amdgcn_mfma_f32_32x32x16_bf16(b1,qr[d0],p1,0,0,0);}}
}
typedef __attribute__((address_space(3))) const char* lds_cptr;
typedef short v4i16_t __attribute__((ext_vector_type(4)));
__device__ __forceinline__ void kload8(bf16x8*kf,lds_cptr kp){
  kf[0]=*(const __attribute__((address_space(3))) bf16x8*)(kp);      kf[1]=*(const __attribute__((address_space(3))) bf16x8*)(kp+512);
  kf[2]=*(const __attribute__((address_space(3))) bf16x8*)(kp+2048); kf[3]=*(const __attribute__((address_space(3))) bf16x8*)(kp+2560);
  kf[4]=*(const __attribute__((address_space(3))) bf16x8*)(kp+4096); kf[5]=*(const __attribute__((address_space(3))) bf16x8*)(kp+4608);
  kf[6]=*(const __attribute__((address_space(3))) bf16x8*)(kp+6144); kf[7]=*(const __attribute__((address_space(3))) bf16x8*)(kp+6656);
}
__device__ __forceinline__ void kload2(bf16x8*kf,lds_cptr kp,int j){ kf[2*j]=*(const __attribute__((address_space(3))) bf16x8*)(kp+j*2048); kf[2*j+1]=*(const __attribute__((address_space(3))) bf16x8*)(kp+j*2048+512); }
__device__ __forceinline__ s16x4 vtr(lds_cptr p){ return __builtin_bit_cast(s16x4,__builtin_amdgcn_ds_read_tr16_b64_v4i16((__attribute__((address_space(3))) v4i16_t*)p)); }
__device__ __forceinline__ float rowmax(const f32x16&p0,const f32x16&p1){
  float a=max3f(p0[0],p0[1],p1[0]),b=max3f(p0[2],p0[3],p1[1]);a=max3f(a,p1[2],p1[3]);
  #pragma unroll
  for(int r=4;r<16;r+=4){a=max3f(a,p0[r],p0[r+1]);b=max3f(b,p0[r+2],p0[r+3]);a=max3f(a,p1[r],p1[r+1]);b=max3f(b,p1[r+2],p1[r+3]);}
  const float m=max2f(a,b);
  auto rr=__builtin_amdgcn_permlane32_swap(__float_as_uint(m),__float_as_uint(m),false,false);
  return max2f(__uint_as_float(rr[0]),__uint_as_float(rr[1]));
}
__device__ __forceinline__ void pv(f32x16*o,int vb,bf16x8 pa0,bf16x8 pa1,bf16x8 pa2,bf16x8 pa3){
  #pragma unroll
  for(int d0=0;d0<2;++d0){s16x4 lo[4],hi[4];
    #pragma unroll
    for(int ks=0;ks<4;++ks){
      asm volatile("ds_read_b64_tr_b16 %0,%1 offset:%c2":"=&v"(lo[ks]):"v"(vb),"i"(d0*4096+ks*1024):"memory");
      asm volatile("ds_read_b64_tr_b16 %0,%1 offset:%c2":"=&v"(hi[ks]):"v"(vb),"i"(d0*4096+ks*1024+512):"memory");}
    asm volatile("s_waitcnt lgkmcnt(0)":::"memory");SBAR();
    #define PK(k) (bf16x8){lo[k][0],lo[k][1],lo[k][2],lo[k][3],hi[k][0],hi[k][1],hi[k][2],hi[k][3]}
    o[d0]=__builtin_amdgcn_mfma_f32_32x32x16_bf16(pa0,PK(0),o[d0],0,0,0);
    o[d0]=__builtin_amdgcn_mfma_f32_32x32x16_bf16(pa1,PK(1),o[d0],0,0,0);
    o[d0]=__builtin_amdgcn_mfma_f32_32x32x16_bf16(pa2,PK(2),o[d0],0,0,0);
    o[d0]=__builtin_amdgcn_mfma_f32_32x32x16_bf16(pa3,PK(3),o[d0],0,0,0);
    #undef PK
  }
}

#ifndef ATTN_STORE16
#define ATTN_STORE16(p,v) (*(u32x4*)(p)=(v))
#endif
template<int THRL,bool BANDED> __device__ __forceinline__ void attn_unit(const bf16*Qrows,const bf16*__restrict__ Kc,const bf16*__restrict__ Kl,const bf16*__restrict__ Vc,const bf16*__restrict__ Vl,bf16*Orows,const int NT,const int qpos0,const int kpos0,const float sink_l2,char*shm){
  int tid_o=threadIdx.x; asm volatile("":"+v"(tid_o)); const int tid=tid_o,lane=tid&63,r32=lane&31,hi=lane>>5; const int wid=__builtin_amdgcn_readfirstlane(tid>>6);
  const bf16*Qw=Qrows+(long)(wid*QBLK)*ZP;
  const unsigned lds0=(unsigned)(uintptr_t)shm;
  float*wsf=(float*)(shm+LDS_WS)+wid*64;
  const long koff=(long)lane*ZP+wid*8, voff=(long)(16*(wid&3)+(lane>>2))*ZP+(wid>>2)*32+(lane&3)*8;
  const bf16*ksrc_c=Kc+koff,*ksrc_l=Kl+koff-(long)4*KVBLK*ZP,*vsrc_c=Vc+voff,*vsrc_l=Vl+voff-(long)4*KVBLK*ZP;
  const unsigned kdst=lds0+LDS_K+wid*1024, vdst=lds0+LDS_V+wid*1024;
  #define DMA_K(t,slot) glds16((((t)<4)?ksrc_c:ksrc_l)+(long)(t)*KVBLK*ZP,(unsigned)__builtin_amdgcn_readfirstlane(kdst+(slot)))
  #define DMA_V(t,slot) glds16((((t)<4)?vsrc_c:vsrc_l)+(long)(t)*KVBLK*ZP,(unsigned)__builtin_amdgcn_readfirstlane(vdst+(slot)))
  const int vb0=(int)(lds0+LDS_V)+((lane>>4)&1)*32+(lane&3)*8+(4*hi+((lane&15)>>2))*64;
  const char*Kbase=shm+LDS_K; bf16x8 kf[8];
  const lds_cptr shm3=(lds_cptr)shm; const lds_cptr kp0=shm3+LDS_K+hi*1024+r32*16; const lds_cptr vp0=shm3+LDS_V+((lane>>4)&1)*32+(lane&3)*8+(4*hi+((lane&15)>>2))*64;
  DMA_K(0,0);DMA_V(0,0);DMA_K(1,SLOTB);
  bf16x8 qr[4];
  #pragma unroll
  for(int d0=0;d0<4;++d0)qr[d0]=*reinterpret_cast<const bf16x8*>(&Qw[(long)r32*ZP+d0*16+hi*8]);
  float mhat=0.f,l_reg=0.f;f32x16 o[2];o[0]=f32x16{};o[1]=f32x16{};f32x16 negm=f32x16{};asm volatile("":"+v"(negm));
  const int qrel=wid*QBLK+r32;
  #define CMASK(P0,P1,t) do{ if(BANDED&&(t)>=4) bandmask(P0,P1,kpos0+64*((t)-4),qpos0+qrel,hi); }while(0)
  bool resc=false;
  #define START(P0,P1) do{ const float rm=rowmax(P0,P1); resc=false; \
    { const float dl=rm; mhat=fadd_s(mhat,dl); \
      _Pragma("unroll") for(int r=0;r<16;++r){P0[r]=fsub_s(P0[r],dl);P1[r]=fsub_s(P1[r],dl);} \
      _Pragma("unroll") for(int r=0;r<16;++r)negm[r]=-mhat; asm volatile("":"+v"(negm)); } \
    _Pragma("unroll") for(int r=0;r<16;++r)P0[r]=__builtin_amdgcn_exp2f(P0[r]); }while(0)
  #define RESC() do{ if(resc){ asm volatile("s_waitcnt lgkmcnt(0)":::"memory"); \
      _Pragma("unroll") for(int d_=0;d_<2;++d_) _Pragma("unroll") for(int r=0;r<16;++r)o[d_][r]*=wsf[crow(r,hi)]; } }while(0)
  f32x16 pA0,pA1,pB0,pB1;
  int sl_prev=0,sl_cur=0,sl_next=SLOTB;
  #define ROT() do{sl_prev=sl_cur;sl_cur=sl_next;sl_next=(sl_next==(NSLOT-1)*SLOTB)?0:sl_next+SLOTB;}while(0)
  DMA_K(2,2*SLOTB);
  WAIT_BAR(3);
  qkt(pA0,pA1,Kbase,qr,negm,r32,hi);asm volatile("s_nop 15\n\ts_nop 7":"+v"(pA0),"+v"(pA1));CMASK(pA0,pA1,0);
  START(pA0,pA1);
  _Pragma("unroll") for(int r=0;r<16;++r)pA1[r]=__builtin_amdgcn_exp2f(pA1[r]);
  WAIT_BAR(0);
  DMA_K(3,0);DMA_V(1,SLOTB);
  ROT();
  kload8(kf,kp0+sl_cur);
  WAIT_BAR(2);
  s16x4 vlo[8],vhi[8]; u32x4 pw0,pw1,pw2,pw3;
  #define PKW(P,B) cvtpk_s(P[B],P[B+1])
  #define PAF(k) __builtin_bit_cast(bf16x8,pw##k)
  #define VFR(i) (bf16x8){vlo[i][0],vlo[i][1],vlo[i][2],vlo[i][3],vhi[i][0],vhi[i][1],vhi[i][2],vhi[i][3]}
  #define PIN(x) asm volatile("":"+v"(x))
  #define MX3(a,b,c) __builtin_fmaxf(__builtin_fmaxf((a),(b)),(c))
  #define GAPA(MF,A0,A1,A2,A3,W0,W1,PW) do{ MF; sacc+=A0; sacc+=A1; sacc+=A2; sacc+=A3; PIN(sacc); W0; W1; PIN(PW); SBAR(); }while(0)
  #define EX(v) __builtin_amdgcn_exp2f(v)
  #define GAPB(MF,X,B) do{ MF; X[B]=EX(X[B]); X[B+1]=EX(X[B+1]); X[B+2]=EX(X[B+2]); X[B+3]=EX(X[B+3]); PIN(X); SBAR(); }while(0)
  #define VRD(i) do{ vlo[i]=vtr(vp_+(((i)>>2)*4096+((i)&3)*1024)); vhi[i]=vtr(vp_+(((i)>>2)*4096+((i)&3)*1024+512)); }while(0)
  #define KRD(G,j) do{ if(G){ kload2(kf,kp0+sl_next,j); SBAR(); } }while(0)
  #define STEP(C0,C1,P0,P1,t,GK,GV,GL) do{ SBAR(); \
    const lds_cptr vp_=vp0+sl_prev; \
    VRD(0); SBAR(); float sacc=(P0[0]+P0[1]); \
    GAPA(C0=__builtin_amdgcn_mfma_f32_32x32x16_bf16(kf[0],qr[0],negm,0,0,0), P0[2],P0[3],P0[4],P0[5],     pw0[0]=PKW(P0,0), pw0[1]=PKW(P0,2), pw0); \
    VRD(4); SBAR(); GAPA(C1=__builtin_amdgcn_mfma_f32_32x32x16_bf16(kf[1],qr[0],negm,0,0,0), P0[6],P0[7],P0[8],P0[9],     pw0[2]=PKW(P0,4), pw0[3]=PKW(P0,6), pw0); \
    VRD(1); SBAR(); GAPA(C0=__builtin_amdgcn_mfma_f32_32x32x16_bf16(kf[2],qr[1],C0,0,0,0),   P0[10],P0[11],P0[12],P0[13], pw1[0]=PKW(P0,8), pw1[1]=PKW(P0,10), pw1); \
    VRD(5); SBAR(); GAPA(C1=__builtin_amdgcn_mfma_f32_32x32x16_bf16(kf[3],qr[1],C1,0,0,0),   P0[14],P0[15],P1[0],P1[1],   pw1[2]=PKW(P0,12),pw1[3]=PKW(P0,14), pw1); \
    VRD(2); SBAR(); GAPA(C0=__builtin_amdgcn_mfma_f32_32x32x16_bf16(kf[4],qr[2],C0,0,0,0),   P1[2],P1[3],P1[4],P1[5],     pw2[0]=PKW(P1,0), pw2[1]=PKW(P1,2), pw2); \
    VRD(6); SBAR(); GAPA(C1=__builtin_amdgcn_mfma_f32_32x32x16_bf16(kf[5],qr[2],C1,0,0,0),   P1[6],P1[7],P1[8],P1[9],     pw2[2]=PKW(P1,4), pw2[3]=PKW(P1,6), pw2); \
    VRD(3); SBAR(); GAPA(C0=__builtin_amdgcn_mfma_f32_32x32x16_bf16(kf[6],qr[3],C0,0,0,0),   P1[10],P1[11],P1[12],P1[13], pw3[0]=PKW(P1,8), pw3[1]=PKW(P1,10), pw3); \
    VRD(7); SBAR(); GAPA(C1=__builtin_amdgcn_mfma_f32_32x32x16_bf16(kf[7],qr[3],C1,0,0,0),   P1[14],P1[15],0.f,0.f,       pw3[2]=PKW(P1,12),pw3[3]=PKW(P1,14), pw3); \
    l_reg+=sacc; \
    if(GK){DMA_K((t)+3,sl_cur);} if(GV){DMA_V((t)+1,sl_next);} \
    CMASK(C0,C1,t); \
    { float a=MX3(C0[0],C0[1],C1[0]),b=MX3(C0[2],C0[3],C1[1]); a=MX3(a,C1[2],C1[3]); \
      _Pragma("unroll") for(int r=4;r<16;r+=4){a=MX3(a,C0[r],C0[r+1]);b=MX3(b,C0[r+2],C0[r+3]);a=MX3(a,C1[r],C1[r+1]);b=MX3(b,C1[r+2],C1[r+3]);} \
      float rm=__builtin_fmaxf(a,b); { auto rr=__builtin_amdgcn_permlane32_swap(__float_as_uint(rm),__float_as_uint(rm),false,false); rm=__builtin_fmaxf(__uint_as_float(rr[0]),__uint_as_float(rr[1])); } \
      resc=false; \
      if(__builtin_expect(__any(rm>(float)THRL),0)){ const float dl=__builtin_fmaxf(rm,0.f); mhat+=dl; \
        _Pragma("unroll") for(int r=0;r<16;++r){C0[r]-=dl;C1[r]-=dl;} \
        _Pragma("unroll") for(int r=0;r<16;++r)negm[r]=-mhat; asm volatile("":"+v"(negm)); \
        const float f=__builtin_amdgcn_exp2f(-dl); l_reg*=f; if(hi==0)wsf[r32]=f; resc=true; } } \
    SBAR(); \
    GAPB(o[0]=__builtin_amdgcn_mfma_f32_32x32x16_bf16(PAF(0),VFR(0),o[0],0,0,0), C0,0); \
    GAPB(o[1]=__builtin_amdgcn_mfma_f32_32x32x16_bf16(PAF(0),VFR(4),o[1],0,0,0), C0,4); \
    KRD(GL,0); GAPB(o[0]=__builtin_amdgcn_mfma_f32_32x32x16_bf16(PAF(1),VFR(1),o[0],0,0,0), C0,8); \
    KRD(GL,1); GAPB(o[1]=__builtin_amdgcn_mfma_f32_32x32x16_bf16(PAF(1),VFR(5),o[1],0,0,0), C0,12); \
    KRD(GL,2); GAPB(o[0]=__builtin_amdgcn_mfma_f32_32x32x16_bf16(PAF(2),VFR(2),o[0],0,0,0), C1,0); \
    KRD(GL,3); GAPB(o[1]=__builtin_amdgcn_mfma_f32_32x32x16_bf16(PAF(2),VFR(6),o[1],0,0,0), C1,4); \
    GAPB(o[0]=__builtin_amdgcn_mfma_f32_32x32x16_bf16(PAF(3),VFR(3),o[0],0,0,0), C1,8); \
    GAPB(o[1]=__builtin_amdgcn_mfma_f32_32x32x16_bf16(PAF(3),VFR(7),o[1],0,0,0), C1,12); \
    }while(0)
  int t=1;
  for(;t+5<NT;t+=2){
    STEP(pB0,pB1,pA0,pA1,t,true,true,true);     WAIT_BAR(2); RESC(); ROT();
    STEP(pA0,pA1,pB0,pB1,t+1,true,true,true);   WAIT_BAR(2); RESC(); ROT();
  }
  #undef CMASK
  #define CMASK(P0,P1,t) do{ if(BANDED&&(t)>=4) bandmask(P0,P1,kpos0+64*((t)-4),qpos0+qrel,hi); }while(0)
  #define ENDW(tt) do{ if((tt)+3<NT){WAIT_BAR(2);} else if((tt)+2<NT){WAIT_BAR(1);} else {WAIT_BAR(0);} }while(0)
  for(;t+1<NT;t+=2){
    STEP(pB0,pB1,pA0,pA1,t,(t+3<NT),(t+1<NT),(t+1<NT));       ENDW(t);   RESC(); ROT();
    STEP(pA0,pA1,pB0,pB1,t+1,(t+4<NT),(t+2<NT),(t+2<NT));     ENDW(t+1); RESC(); ROT();
  }
  STEP(pB0,pB1,pA0,pA1,NT-1,false,false,false); RESC();
  { float sacc=pB0[0]+pB0[1]; _Pragma("unroll") for(int r=2;r<16;++r)sacc+=pB0[r]; _Pragma("unroll") for(int r=0;r<16;++r)sacc+=pB1[r]; l_reg+=sacc;
    pw0=(u32x4){PKW(pB0,0),PKW(pB0,2),PKW(pB0,4),PKW(pB0,6)};pw1=(u32x4){PKW(pB0,8),PKW(pB0,10),PKW(pB0,12),PKW(pB0,14)};pw2=(u32x4){PKW(pB1,0),PKW(pB1,2),PKW(pB1,4),PKW(pB1,6)};pw3=(u32x4){PKW(pB1,8),PKW(pB1,10),PKW(pB1,12),PKW(pB1,14)};
    SBAR(); pv(o,vb0+sl_cur,PAF(0),PAF(1),PAF(2),PAF(3)); }
  #undef PKW
  #undef PAF
  #undef VFR
  #undef PIN
  #undef MX3
  #undef GAPA
  #undef GAPB
  #undef EX
  #undef VRD
  #undef KRD
  #undef STEP
  #undef ENDW
  {auto rr=__builtin_amdgcn_permlane32_swap(__float_as_uint(l_reg),__float_as_uint(l_reg),false,false);l_reg=__uint_as_float(rr[0])+__uint_as_float(rr[1]);}
  if(BANDED) l_reg+=__builtin_amdgcn_exp2f(sink_l2-mhat);
  if(hi==0)wsf[32+r32]=l_reg;asm volatile("s_waitcnt lgkmcnt(0)":::"memory");
  float rli[16];
  #pragma unroll
  for(int r=0;r<16;++r)rli[r]=__builtin_amdgcn_rcpf(wsf[32+crow(r,hi)]);
  bf16*Ow=Orows+(long)(wid*QBLK)*OP;
  { bf16*stg=(bf16*)(shm+LDS_OST)+wid*2048;
    #pragma unroll
    for(int r=0;r<16;++r){const int orow=crow(r,hi);
      #pragma unroll
      for(int d0=0;d0<2;++d0)stg[orow*64+d0*32+r32]=__float2bfloat16(o[d0][r]*rli[r]);}
    asm volatile("s_waitcnt lgkmcnt(0)":::"memory");
    #pragma unroll
    for(int i=0;i<4;++i){const int row=i*8+(lane>>3),ch=lane&7; const u32x4 v=*(const u32x4*)(stg+row*64+ch*8); ATTN_STORE16(Ow+(long)row*OP+ch*8,v);} }
  asm volatile("s_waitcnt lgkmcnt(0)\n\ts_barrier":::"memory");
  #undef DMA_K
  #undef DMA_V
  #undef CMASK
  #undef START
  #undef RESC
  #undef ROT
}
constexpr int ATTN_LDS_BYTES=LDS_BYTES;
#undef SBAR
#undef WAIT_BAR
}

#define LAS __attribute__((address_space(3)))
typedef unsigned short bf16;
typedef unsigned v4u __attribute__((ext_vector_type(4)));
typedef float f32x4 __attribute__((ext_vector_type(4)));

constexpr int DM = 1024, NBATCH = 4, SEQ = 8192, CTXL = 256;
constexpr int ML = NBATCH * SEQ, MC = NBATCH * CTXL, MT = ML + MC;
constexpr int ZW = 2560, FF = 2816, FF2 = 5632, CW = 512, NFFT = 16384;
constexpr int NTHR = 512;
constexpr size_t MiB = 1u << 20;
constexpr size_t WS_MOD = 0;
constexpr size_t WS_TW = 256 * 1024;
constexpr size_t WS_ROPE = 320 * 1024;
constexpr size_t WS_FSUMC = 384 * 1024;
constexpr size_t WS_FSUM = 1 * MiB;
constexpr size_t WS_KC = 2 * MiB;
constexpr size_t WS_UC = 3 * MiB;
constexpr size_t WS_WB = 5 * MiB;
constexpr size_t WB_IN = 0, WB_OUT = 5 * MiB, WB_UP = 7 * MiB, WB_DOWN = 18 * MiB, WB_LAYER = 23 * MiB + 512 * 1024;
constexpr size_t WS_XC = 52 * MiB;
constexpr size_t WS_XN = 56 * MiB;
constexpr size_t WS_Z = 122 * MiB;
constexpr size_t WS_OC = 287 * MiB;
constexpr size_t WS_UT = 353 * MiB;
constexpr size_t WS_KF = 417 * MiB;
constexpr size_t WS_AV = 122 * MiB;
constexpr size_t WS_G = 309 * MiB;
constexpr size_t WS_END = 481 * MiB;
constexpr int LDS_BYTES = 147456;

__device__ __forceinline__ unsigned f2bf(float f) { unsigned u = __builtin_bit_cast(unsigned, f); return (u + 0x7fffu + ((u >> 16) & 1u)) >> 16; }
__device__ __forceinline__ unsigned pk2(float lo, float hi) { return f2bf(lo) | (f2bf(hi) << 16); }
__device__ __forceinline__ float bflo(unsigned w) { return __builtin_bit_cast(float, w << 16); }
__device__ __forceinline__ float bfhi(unsigned w) { return __builtin_bit_cast(float, w & 0xffff0000u); }
__device__ __forceinline__ void unpack8(const v4u w, float* f) { f[0] = bflo(w.x); f[1] = bfhi(w.x); f[2] = bflo(w.y); f[3] = bfhi(w.y); f[4] = bflo(w.z); f[5] = bfhi(w.z); f[6] = bflo(w.w); f[7] = bfhi(w.w); }
__device__ __forceinline__ v4u pack8(const float* f) { v4u o; o.x = pk2(f[0], f[1]); o.y = pk2(f[2], f[3]); o.z = pk2(f[4], f[5]); o.w = pk2(f[6], f[7]); return o; }
__device__ __forceinline__ float wave_sum(float v) {
#pragma unroll
    for (int o = 1; o < 64; o <<= 1) v += __shfl_xor(v, o);
    return v;
}

struct EpiStoreBf16 {
    static constexpr bool PERM = true, AFTER_DRAIN = false;
    bf16* O; int ldc;
    __device__ __forceinline__ void operator()(const pg8::f32x4 (&acc)[2][2][4][2], const pg8::Unit& u, int wr, int wc, int fr, int fq) const {
        const int row0 = u.pm * 256 + wr * 64 + fr, col0 = u.pn * 256 + wc * 32 + 8 * fq;
#pragma unroll
        for (int ai = 0; ai < 2; ++ai)
#pragma unroll
            for (int m = 0; m < 4; ++m) { bf16* rowp = O + (size_t)(row0 + ai * 128 + m * 16) * ldc + col0;
#pragma unroll
                for (int bj = 0; bj < 2; ++bj) { const pg8::f32x4 v0 = acc[ai][bj][m][0], v1 = acc[ai][bj][m][1]; v4u w;
                    w.x = pg8::cvt_pk_bf16(v0[0], v0[1]); w.y = pg8::cvt_pk_bf16(v0[2], v0[3]); w.z = pg8::cvt_pk_bf16(v1[0], v1[1]); w.w = pg8::cvt_pk_bf16(v1[2], v1[3]);
                    *(v4u*)(rowp + bj * 128) = w; } }
    }
};
struct EpiRes {
    static constexpr bool PERM = true, AFTER_DRAIN = false;
    const float* srcL; float* dstL; const float* srcC; float* dstC; const float* gate; int pm0;
    __device__ __forceinline__ void operator()(const pg8::f32x4 (&acc)[2][2][4][2], const pg8::Unit& u, int wr, int wc, int fr, int fq) const {
        const int pm = u.pm + pm0; const float* src; float* dst; const float* g; int rbase;
        if (pm < 128) { src = srcL; dst = dstL; g = gate + (pm >> 5) * 6144; rbase = pm * 256; } else { src = srcC; dst = dstC; g = gate + 4 * 6144; rbase = (pm - 128) * 256; }
        const int row0 = rbase + wr * 64 + fr, col0 = u.pn * 256 + wc * 32 + 8 * fq;
        f32x4 gv[2][2];
#pragma unroll
        for (int bj = 0; bj < 2; ++bj)
#pragma unroll
            for (int n = 0; n < 2; ++n) gv[bj][n] = *(const f32x4*)(g + col0 + bj * 128 + 4 * n);
#pragma unroll
        for (int ai = 0; ai < 2; ++ai)
#pragma unroll
            for (int m = 0; m < 4; ++m) { const size_t p = (size_t)(row0 + ai * 128 + m * 16) * DM + col0;
#pragma unroll
                for (int bj = 0; bj < 2; ++bj)
#pragma unroll
                    for (int n = 0; n < 2; ++n) { f32x4 v = *(const f32x4*)(src + p + bj * 128 + 4 * n); v = v + gv[bj][n] * acc[ai][bj][m][n]; *(f32x4*)(dst + p + bj * 128 + 4 * n) = v; } }
    }
};

__device__ __forceinline__ void transpose_item(const float* W, int K, int N, bf16* WT, int kb, int nb, int rbase, LAS float* scr, int lane) {
    const int k0 = 64 * kb, n0 = 32 * nb;
#pragma unroll 8
    for (int i = 0; i < 32; ++i) { const int kk = 2 * i + (lane >> 5); scr[kk * 33 + (lane & 31)] = W[(size_t)(k0 + kk) * N + n0 + (lane & 31)]; }
    asm volatile("s_waitcnt lgkmcnt(0)" ::: "memory");
    const int c = lane & 7;
#pragma unroll
    for (int j = 0; j < 4; ++j) { const int n = (lane >> 3) + 8 * j; const LAS float* s = scr + (8 * c) * 33 + n;
        v4u o; o.x = pk2(s[0 * 33], s[1 * 33]); o.y = pk2(s[2 * 33], s[3 * 33]); o.z = pk2(s[4 * 33], s[5 * 33]); o.w = pk2(s[6 * 33], s[7 * 33]);
        *(v4u*)(WT + (size_t)(rbase + n) * K + k0 + 8 * c) = o; }
    asm volatile("s_waitcnt lgkmcnt(0)" ::: "memory");
}
constexpr int TI_IN = 16 * 80, TI_OUT = 16 * 32, TI_UP = 16 * 176, TI_DOWN = 44 * 32, TI_LAYER = TI_IN + TI_OUT + TI_UP + TI_DOWN;
__device__ __forceinline__ void p0_weights(const float* w_in, const float* w_out, const float* w_up, const float* w_down, unsigned char* wb, LAS float* scr, int gw, int ngw, int lane) {
    for (int it = gw; it < 2 * TI_LAYER; it += ngw) {
        const int l = it / TI_LAYER; int r = it % TI_LAYER; unsigned char* base = wb + (size_t)l * WB_LAYER;
        if (r < TI_IN) { transpose_item(w_in + (size_t)l * DM * ZW, DM, ZW, (bf16*)(base + WB_IN), r / 80, r % 80, 32 * (r % 80), scr, lane); continue; } r -= TI_IN;
        if (r < TI_OUT) { transpose_item(w_out + (size_t)l * DM * DM, DM, DM, (bf16*)(base + WB_OUT), r / 32, r % 32, 32 * (r % 32), scr, lane); continue; } r -= TI_OUT;
        if (r < TI_UP) { const int nb = r % 176, n0 = 32 * nb; const int m = n0 < FF ? n0 : n0 - FF; const int rb = (m / 128) * 256 + (n0 < FF ? 0 : 128) + (m % 128);
            transpose_item(w_up + (size_t)l * DM * FF2, DM, FF2, (bf16*)(base + WB_UP), r / 176, nb, rb, scr, lane); continue; } r -= TI_UP;
        transpose_item(w_down + (size_t)l * FF * DM, FF, DM, (bf16*)(base + WB_DOWN), r / 32, r % 32, 32 * (r % 32), scr, lane);
    }
}
__device__ __forceinline__ void p0_mod_item(const float* c, const float* c_ctx, const float* ada_w, const float* ada_b, float* mod, LAS float* L, int item, int tid) {
    const int l = item / 96, n0 = (item % 96) * 64, wave = tid >> 6, lane = tid & 63;
    LAS float* sl = L; LAS float* red = L + 5 * 1024;
    for (int i = tid; i < 5 * 1024; i += NTHR) { const int r = i >> 10, k = i & 1023; const float v = r < 4 ? c[r * 1024 + k] : c_ctx[k]; sl[i] = v / (1.f + expf(-v)); }
    __syncthreads();
    float acc[5] = {0.f, 0.f, 0.f, 0.f, 0.f};
    const float* w = ada_w + (size_t)l * DM * 6144 + n0 + lane;
#pragma unroll 8
    for (int k = wave * 128; k < wave * 128 + 128; ++k) { const float wv = w[(size_t)k * 6144];
#pragma unroll
        for (int r = 0; r < 5; ++r) acc[r] += sl[r * 1024 + k] * wv; }
#pragma unroll
    for (int r = 0; r < 5; ++r) red[(wave * 5 + r) * 64 + lane] = acc[r];
    __syncthreads();
    if (tid < 320) { const int r = tid >> 6; float s = 0.f;
#pragma unroll
        for (int w8 = 0; w8 < 8; ++w8) s += red[(w8 * 5 + r) * 64 + lane];
        mod[(size_t)(l * 5 + r) * 6144 + n0 + lane] = s + ada_b[l * 6144 + n0 + lane]; }
    __syncthreads();
}
template <bool CTXF>
__device__ __forceinline__ void p0_filter_item(const float* w1, const float* b1, const float* w2, const float* b2, const float* w3, const float* b3, const float* w4, const float* freq,
                                               float* KT, float* FS, LAS float* L, int chunk, int tid) {
    constexpr int n = CTXF ? 256 : 8192; const int t0 = chunk * 32;
    LAS float* feats = L; LAS float* h1 = L + 32 * 36; LAS float* h2 = h1 + 2048; LAS float* h3 = h2 + 2048; LAS float* T = L + 8192;
    for (int i = tid; i < 32 * 33; i += NTHR) { const int tap = i / 33, e = i % 33, t = t0 + tap; float val;
        if (e == 0) val = (float)t / (float)(n - 1);
        else { const int j = (e - 1) & 15; const float f = 1e-4f + (float)j * ((15.0f - 1e-4f) / 15.0f); float sn, cs; sincospif(f * (2.0f * (float)t / (float)n), &sn, &cs); val = e <= 16 ? cs : -sn; }
        feats[tap * 36 + e] = val; }
    __syncthreads();
    const int tap4 = tid >> 4, jb = tid & 15;
    { float s4[4];
#pragma unroll
      for (int i = 0; i < 4; ++i) s4[i] = b1[jb + 16 * i];
#pragma unroll 3
      for (int e = 0; e < 33; ++e) { const float fv = feats[tap4 * 36 + e];
#pragma unroll
          for (int i = 0; i < 4; ++i) s4[i] += fv * w1[e * 64 + jb + 16 * i]; }
#pragma unroll
      for (int i = 0; i < 4; ++i) h1[tap4 * 64 + jb + 16 * i] = sinf(freq[jb + 16 * i] * s4[i]); }
    __syncthreads();
    { float s4[4];
#pragma unroll
      for (int i = 0; i < 4; ++i) s4[i] = b2[jb + 16 * i];
#pragma unroll 4
      for (int e = 0; e < 64; ++e) { const float fv = h1[tap4 * 64 + e];
#pragma unroll
          for (int i = 0; i < 4; ++i) s4[i] += fv * w2[e * 64 + jb + 16 * i]; }
#pragma unroll
      for (int i = 0; i < 4; ++i) h2[tap4 * 64 + jb + 16 * i] = sinf(freq[jb + 16 * i] * s4[i]); }
    __syncthreads();
    { float s4[4];
#pragma unroll
      for (int i = 0; i < 4; ++i) s4[i] = b3[jb + 16 * i];
#pragma unroll 4
      for (int e = 0; e < 64; ++e) { const float fv = h2[tap4 * 64 + e];
#pragma unroll
          for (int i = 0; i < 4; ++i) s4[i] += fv * w3[e * 64 + jb + 16 * i]; }
#pragma unroll
      for (int i = 0; i < 4; ++i) h3[tap4 * 64 + jb + 16 * i] = sinf(freq[jb + 16 * i] * s4[i]); }
    __syncthreads();
    float af[32], ab[32];
#pragma unroll
    for (int t = 0; t < 32; ++t) { af[t] = 0.f; ab[t] = 0.f; }
#pragma unroll 2
    for (int k = 0; k < 64; ++k) { const float wa = w4[k * 1024 + tid], wb = w4[k * 1024 + 512 + tid];
#pragma unroll
        for (int t = 0; t < 32; ++t) { const float h = h3[t * 64 + k]; af[t] += h * wa; ab[t] += h * wb; } }
    const float delta = 3.0701134573253944f + (float)tid * (12.280453829301577f / 511.f);
    float sf = 0.f, sb = 0.f;
#pragma unroll
    for (int t = 0; t < 32; ++t) { const float t01 = (float)(t0 + t) * (1.0f / (float)(n - 1)); const float win = __expf(-t01 * delta) + 0.05f;
        af[t] *= win; ab[t] *= win; sf += fabsf(af[t]); if (t0 + t > 0) sb += fabsf(ab[t]); }
    FS[chunk * 1024 + tid] = sf; FS[chunk * 1024 + 512 + tid] = sb;
    const int wave = tid >> 6, lane = tid & 63, cc = lane >> 5, tp = lane & 31, tt = t0 + tp;
#pragma unroll
    for (int t = 0; t < 32; ++t) T[tid * 33 + t] = af[t];
    __syncthreads();
#pragma unroll 1
    for (int cp = 0; cp < 32; ++cp) { const int c = wave * 64 + 2 * cp + cc; const float v = T[c * 33 + tp];
        if (CTXF) KT[(size_t)(255 + tt) * 512 + c] = v; else KT[(size_t)c * NFFT + tt] = v; }
    __syncthreads();
#pragma unroll
    for (int t = 0; t < 32; ++t) T[tid * 33 + t] = ab[t];
    __syncthreads();
#pragma unroll 1
    for (int cp = 0; cp < 32; ++cp) { const int c = wave * 64 + 2 * cp + cc; const float v = T[c * 33 + tp];
        if (tt > 0) { if (CTXF) KT[(size_t)(255 - tt) * 512 + c] = v; else KT[(size_t)c * NFFT + NFFT - tt] = v; } }
    if (!CTXF && chunk == 0) KT[(size_t)tid * NFFT + 8192] = 0.f;
    __syncthreads();
}

typedef float f32x2v __attribute__((ext_vector_type(2)));
constexpr int FFT_LDS_ELEMS = NFFT + NFFT / 32;
__device__ __forceinline__ int pidx(int i) { return i + (i >> 5); }
template <int S, int LOGR, bool INV>
__device__ __forceinline__ void fft_super(LAS f32x2v* buf, const f32x2v* __restrict__ TW, int tid) {
    constexpr int R = 1 << LOGR, BS = NFFT >> S, STR = BS / R, NG = NFFT / R;
    for (int g = tid; g < NG; g += NTHR) {
        const int lo = g % STR, hi = g / STR, base = hi * BS + lo;
        f32x2v x[R];
#pragma unroll
        for (int m = 0; m < R; ++m) x[m] = buf[pidx(base + m * STR)];
#pragma unroll
        for (int qq = 0; qq < LOGR; ++qq) {
            const int q = INV ? LOGR - 1 - qq : qq; const int bit = 1 << (LOGR - 1 - q);
#pragma unroll
            for (int m = 0; m < R; ++m) if (!(m & bit)) {
                const int j = (m & (bit - 1)) * STR + lo;
                const f32x2v w = TW[j << (S + q)];
                const f32x2v a = x[m], b = x[m + bit];
                if (!INV) { const f32x2v d = a - b; x[m] = a + b; x[m + bit] = (f32x2v){d.x * w.x - d.y * w.y, d.x * w.y + d.y * w.x}; }
                else { const f32x2v t = (f32x2v){b.x * w.x + b.y * w.y, b.y * w.x - b.x * w.y}; x[m] = a + t; x[m + bit] = a - t; }
            }
        }
#pragma unroll
        for (int m = 0; m < R; ++m) buf[pidx(base + m * STR)] = x[m];
    }
    __syncthreads();
}
__device__ __forceinline__ void fft_fwd(LAS f32x2v* buf, const f32x2v* TW, int tid) { fft_super<0, 4, false>(buf, TW, tid); fft_super<4, 4, false>(buf, TW, tid); fft_super<8, 4, false>(buf, TW, tid); fft_super<12, 2, false>(buf, TW, tid); }
__device__ __forceinline__ void fft_inv(LAS f32x2v* buf, const f32x2v* TW, int tid) { fft_super<12, 2, true>(buf, TW, tid); fft_super<8, 4, true>(buf, TW, tid); fft_super<4, 4, true>(buf, TW, tid); fft_super<0, 4, true>(buf, TW, tid); }

__device__ __forceinline__ void filter_fft_item(const float* KT, const float* FS, f32x2v* KF, const f32x2v* TW, LAS f32x2v* buf, LAS float* misc, int c, int tid) {
    const f32x4* src = (const f32x4*)(KT + (size_t)c * NFFT);
    for (int i = tid; i < NFFT / 4; i += NTHR) { const f32x4 v = src[i];
#pragma unroll
        for (int k = 0; k < 4; ++k) buf[pidx(4 * i + k)] = (f32x2v){v[k], 0.f}; }
    if (tid < 64) { float s = 0.f;
#pragma unroll
        for (int k = 0; k < 4; ++k) { const int ch = tid * 4 + k; s += FS[ch * 1024 + c] + FS[ch * 1024 + 512 + c]; }
        s = wave_sum(s); if (tid == 0) misc[0] = 1.f / (s * (float)NFFT); }
    __syncthreads();
    fft_fwd(buf, TW, tid);
    const float sc = misc[0]; f32x2v* dst = KF + (size_t)c * NFFT;
    for (int i = tid; i < NFFT; i += NTHR) dst[i] = buf[pidx(i)] * sc;
    __syncthreads();
}
__device__ __forceinline__ void conv_fft_item(float* UT, const f32x2v* KF, const f32x2v* TW, const float* bias_d, LAS f32x2v* buf, int item, int tid) {
    const int p = item >> 9, c = item & 511;
    f32x4* u0 = (f32x4*)(UT + ((size_t)(2 * p) * CW + c) * SEQ); f32x4* u1 = (f32x4*)(UT + ((size_t)(2 * p + 1) * CW + c) * SEQ);
    for (int i = tid; i < SEQ / 4; i += NTHR) { const f32x4 a = u0[i], b = u1[i];
#pragma unroll
        for (int k = 0; k < 4; ++k) { buf[pidx(4 * i + k)] = (f32x2v){a[k], b[k]}; buf[pidx(SEQ + 4 * i + k)] = (f32x2v){0.f, 0.f}; } }
    __syncthreads();
    fft_fwd(buf, TW, tid);
    const f32x2v* kf = KF + (size_t)c * NFFT;
    for (int i = tid; i < NFFT; i += NTHR) { const f32x2v k = kf[i], v = buf[pidx(i)]; buf[pidx(i)] = (f32x2v){v.x * k.x - v.y * k.y, v.x * k.y + v.y * k.x}; }
    __syncthreads();
    fft_inv(buf, TW, tid);
    const float bd = bias_d[c];
    for (int i = tid; i < SEQ / 4; i += NTHR) { f32x4 a = u0[i], b = u1[i];
#pragma unroll
        for (int k = 0; k < 4; ++k) { const f32x2v y = buf[pidx(4 * i + k)]; a[k] = y.x + a[k] * bd; b[k] = y.y + b[k] * bd; }
        u0[i] = a; u1[i] = b; }
    __syncthreads();
}

__device__ __forceinline__ void modulate_rows(const float* srcL, const float* srcC, const float* g, const float* mod  , int shoff, bf16* XN, int row_lo, int row_hi, int gw, int ngw, int lane) {
    for (int row = row_lo + gw; row < row_hi; row += ngw) {
        const float* src; const float* mr;
        if (row < ML) { src = srcL + (size_t)row * DM; mr = mod + (row >> 13) * 6144; } else { src = srcC + (size_t)(row - ML) * DM; mr = mod + 4 * 6144; }
        const f32x4* xr = (const f32x4*)src + lane; f32x4 v[4]; float ss = 0.f;
#pragma unroll
        for (int j = 0; j < 4; ++j) { v[j] = xr[64 * j]; ss += (v[j].x * v[j].x + v[j].y * v[j].y) + (v[j].z * v[j].z + v[j].w * v[j].w); }
        const float rinv = 1.0f / sqrtf(wave_sum(ss) * (1.f / DM) + 1e-6f);
        unsigned long long* o8 = (unsigned long long*)(XN + (size_t)row * DM) + lane;
#pragma unroll
        for (int j = 0; j < 4; ++j) { const int col = 4 * lane + 256 * j; const f32x4 gg = *(const f32x4*)(g + col), sh = *(const f32x4*)(mr + shoff + col), sc = *(const f32x4*)(mr + shoff + 1024 + col);
            const f32x4 y = v[j] * rinv * gg * (sc + 1.0f) + sh;
            o8[64 * j] = (unsigned long long)pk2(y.x, y.y) | ((unsigned long long)pk2(y.z, y.w) << 32); }
    }
}
__device__ __forceinline__ void qk_norm_rope(bf16* Z, const float* qn, const float* kn, const f32x2v* ROPE, int blk, int nblk, int tid) {
    constexpr float C2 = 0.125f * 1.4426950408889634f;
    const int j = tid & 7;
    for (int it = blk; it < MT * 12 / 64; it += nblk) {
        const int hr = it * 64 + (tid >> 3), row = hr / 12, head = hr % 12;
        bf16* p = Z + (size_t)row * ZW + head * 64 + 8 * j;
        float x[8]; unpack8(*(const v4u*)p, x);
        float ss = 0.f;
#pragma unroll
        for (int i = 0; i < 8; ++i) ss += x[i] * x[i];
        ss += __shfl_xor(ss, 1); ss += __shfl_xor(ss, 2); ss += __shfl_xor(ss, 4);
        const float rinv = 1.0f / sqrtf(ss * (1.f / 64.f) + 1e-6f);
        const float* gn = (head < 8 ? qn : kn) + 8 * j;
#pragma unroll
        for (int i = 0; i < 8; ++i) x[i] = x[i] * rinv * gn[i];
        float other[8];
#pragma unroll
        for (int i = 0; i < 8; ++i) other[i] = __shfl_xor(x[i], 2);
        if (row < ML) {
            const int t = row & (SEQ - 1), pos = (j >> 2) ? (t & 63) : (t >> 6), jj = j & 3, f0 = (jj & 1) * 8; const bool second = (jj >> 1) != 0;
            const f32x2v* rp = ROPE + pos * 16 + f0;
#pragma unroll
            for (int i = 0; i < 8; ++i) { const f32x2v cs = rp[i]; x[i] = second ? (other[i] * cs.y + x[i] * cs.x) : (x[i] * cs.x - other[i] * cs.y); }
        }
        if (head < 8) {
#pragma unroll
            for (int i = 0; i < 8; ++i) x[i] *= C2;
        }
        *(v4u*)p = pack8(x);
    }
}
__device__ __forceinline__ void hyena_pre(const bf16* Z, const float* cw, const float* cb, bf16* OC, float* UT, float* UC, LAS float* T, int blk, int nblk, int tid) {
    const int tt = tid >> 3, cg8 = (tid & 7) * 8;
    constexpr int NIT = (MT / 64) * 8;
    for (int it = blk; it < NIT; it += nblk) {
        const int rt = it >> 3, c0 = (it & 7) * 64, row = rt * 64 + tt, c = c0 + cg8;
        const bool lat = row < ML; const int tpos = lat ? (row & (SEQ - 1)) : ((row - ML) & (CTXL - 1)); const int slen = lat ? SEQ : CTXL;
        float zc[3][8];
#pragma unroll
        for (int gsel = 0; gsel < 3; ++gsel) {
            const int col = gsel * CW + c; const bf16* zp = Z + (size_t)row * ZW + 1024 + col;
            float a[8], b[8], d[8];
            unpack8(*(const v4u*)zp, b);
            if (tpos > 0) unpack8(*(const v4u*)(zp - ZW), a); else { for (int i = 0; i < 8; ++i) a[i] = 0.f; }
            if (tpos < slen - 1) unpack8(*(const v4u*)(zp + ZW), d); else { for (int i = 0; i < 8; ++i) d[i] = 0.f; }
#pragma unroll
            for (int i = 0; i < 8; ++i) zc[gsel][i] = a[i] * cw[col + i] + b[i] * cw[3 * CW + col + i] + d[i] * cw[6 * CW + col + i] + cb[col + i];
        }
        *(v4u*)(OC + (size_t)row * DM + 512 + c) = pack8(zc[0]);
        float u[8];
#pragma unroll
        for (int i = 0; i < 8; ++i) u[i] = zc[2][i] * zc[1][i];
        if (lat) {
#pragma unroll
            for (int i = 0; i < 8; ++i) T[tt * 65 + cg8 + i] = u[i];
            __syncthreads();
            const int cl = tid >> 3, seg = (tid & 7) * 8, b = row >> 13, tb = (rt * 64) & (SEQ - 1);
            f32x4 o0, o1;
#pragma unroll
            for (int i = 0; i < 4; ++i) { o0[i] = T[(seg + i) * 65 + cl]; o1[i] = T[(seg + 4 + i) * 65 + cl]; }
            float* dst = UT + ((size_t)b * CW + c0 + cl) * SEQ + tb + seg;
            *(f32x4*)dst = o0; *(f32x4*)(dst + 4) = o1;
            __syncthreads();
        } else {
            float* dst = UC + (size_t)(row - ML) * CW + c;
            *(f32x4*)dst = (f32x4){u[0], u[1], u[2], u[3]}; *(f32x4*)(dst + 4) = (f32x4){u[4], u[5], u[6], u[7]};
        }
    }
}
__device__ __forceinline__ void ctx_conv_item(const float* KC, const float* FSC, const float* UC, const float* bias_d, bf16* OC, int item, int tid) {
    const int b = item >> 8, t = item & 255, c = tid;
    float s = 0.f;
#pragma unroll
    for (int ch = 0; ch < 8; ++ch) s += FSC[ch * 1024 + c] + FSC[ch * 1024 + 512 + c];
    const float* ub = UC + (size_t)b * CTXL * CW + c; const float* kc = KC + (size_t)(t + 255) * CW + c;
    float acc = 0.f;
#pragma unroll 8
    for (int sidx = 0; sidx < CTXL; ++sidx) acc += kc[-(long)sidx * CW] * ub[(size_t)sidx * CW];
    bf16* op = OC + (size_t)(ML + b * CTXL + t) * DM + 512 + c;
    const float x0 = __builtin_bit_cast(float, (unsigned)(*op) << 16);
    *op = (bf16)f2bf((acc / s + ub[(size_t)t * CW] * bias_d[c]) * x0);
}
__device__ __forceinline__ void hyena_post(const float* UT, bf16* OC, LAS float* T, int blk, int nblk, int tid) {
    constexpr int NIT = (ML / 64) * 8;
    for (int it = blk; it < NIT; it += nblk) {
        const int rt = it >> 3, c0 = (it & 7) * 64, b = (rt * 64) >> 13, tb = (rt * 64) & (SEQ - 1);
        { const int cl = tid >> 3, seg = (tid & 7) * 8; const float* src = UT + ((size_t)b * CW + c0 + cl) * SEQ + tb + seg;
          const f32x4 o0 = *(const f32x4*)src, o1 = *(const f32x4*)(src + 4);
#pragma unroll
          for (int i = 0; i < 4; ++i) { T[(seg + i) * 65 + cl] = o0[i]; T[(seg + 4 + i) * 65 + cl] = o1[i]; } }
        __syncthreads();
        { const int tt = tid >> 3, cg8 = (tid & 7) * 8; bf16* op = OC + (size_t)(rt * 64 + tt) * DM + 512 + c0 + cg8;
          float x0[8]; unpack8(*(const v4u*)op, x0);
#pragma unroll
          for (int i = 0; i < 8; ++i) x0[i] *= T[tt * 65 + cg8 + i];
          *(v4u*)op = pack8(x0); }
        __syncthreads();
    }
}
__device__ __forceinline__ void short_conv(const bf16* Z, const float* cw, bf16* OC, int blk, int nblk, int tid) {
    const int cg8 = (tid & 63) * 8;
    for (int it = blk; it < ML / 8; it += nblk) {
        const int row = it * 8 + (tid >> 6), t = row & (SEQ - 1);
        const bf16* zp = Z + (size_t)row * ZW + 1024 + cg8;
        float bg[8], c1[8], x1[8], acc[8];
        unpack8(*(const v4u*)zp, bg); unpack8(*(const v4u*)(zp + 512), c1); unpack8(*(const v4u*)(zp + 1024), x1);
#pragma unroll
        for (int i = 0; i < 8; ++i) acc[i] = c1[i] * x1[i] * cw[CW + cg8 + i];
        if (t > 0) { unpack8(*(const v4u*)(zp - ZW + 512), c1); unpack8(*(const v4u*)(zp - ZW + 1024), x1);
#pragma unroll
            for (int i = 0; i < 8; ++i) acc[i] += c1[i] * x1[i] * cw[cg8 + i]; }
        if (t < SEQ - 1) { unpack8(*(const v4u*)(zp + ZW + 512), c1); unpack8(*(const v4u*)(zp + ZW + 1024), x1);
#pragma unroll
            for (int i = 0; i < 8; ++i) acc[i] += c1[i] * x1[i] * cw[2 * CW + cg8 + i]; }
#pragma unroll
        for (int i = 0; i < 8; ++i) acc[i] *= bg[i];
        *(v4u*)(OC + (size_t)row * DM + 512 + cg8) = pack8(acc);
    }
}
__device__ __forceinline__ float gelu_tanh(float x) { const float u = 0.7978845608028654f * (x + 0.044715f * x * x * x); const float e = __expf(2.f * u); const float th = 1.f - 2.f / (e + 1.f); return 0.5f * x * (1.f + th); }
__device__ __forceinline__ void ffn_gate(const bf16* AV, bf16* G, const float* cw, const float* cb, int row0, int nrows, int blk, int nblk, int tid) {
    const int rs = tid >> 5, jl = tid & 31;
    for (int it = blk; it < nrows / 64; it += nblk) {
        const int r0 = it * 64 + rs * 4;
        for (int cbk = 0; cbk < 11; ++cbk) {
            const int j = cbk * 256 + jl * 8;
            const int ca = (j >> 7) * 256 + (j & 127);
            float w0[8], w1[8], w2[8], bb[8];
#pragma unroll
            for (int i = 0; i < 8; ++i) { w0[i] = cw[j + i]; w1[i] = cw[FF + j + i]; w2[i] = cw[2 * FF + j + i]; bb[i] = cb[j + i]; }
            float prev[8], cur[8], nxt[8];
            { const int gr = row0 + r0; const bool lat = gr < ML; const int tpos = lat ? (gr & (SEQ - 1)) : ((gr - ML) & (CTXL - 1));
              if (tpos > 0) unpack8(*(const v4u*)(AV + (size_t)(r0 - 1) * FF2 + ca), prev); else { for (int i = 0; i < 8; ++i) prev[i] = 0.f; } }
            unpack8(*(const v4u*)(AV + (size_t)r0 * FF2 + ca), cur);
#pragma unroll
            for (int rr = 0; rr < 4; ++rr) {
                const int lr = r0 + rr, gr = row0 + lr; const bool lat = gr < ML; const int tpos = lat ? (gr & (SEQ - 1)) : ((gr - ML) & (CTXL - 1)); const int slen = lat ? SEQ : CTXL;
                if (tpos < slen - 1) unpack8(*(const v4u*)(AV + (size_t)(lr + 1) * FF2 + ca), nxt); else { for (int i = 0; i < 8; ++i) nxt[i] = 0.f; }
                float vv[8], o[8]; unpack8(*(const v4u*)(AV + (size_t)lr * FF2 + ca + 128), vv);
#pragma unroll
                for (int i = 0; i < 8; ++i) { const float a = prev[i] * w0[i] + cur[i] * w1[i] + nxt[i] * w2[i] + bb[i]; o[i] = gelu_tanh(a) * vv[i]; }
                *(v4u*)(G + (size_t)lr * FF + j) = pack8(o);
#pragma unroll
                for (int i = 0; i < 8; ++i) { prev[i] = cur[i]; cur[i] = nxt[i]; }
            }
        }
    }
}

struct Args { const float* in[29]; float* out; unsigned char* ws; };
enum { I_X = 0, I_C, I_CTX, I_CCTX, I_ADAW, I_ADAB, I_NMIX, I_NFFN, I_WIN, I_WOUT, I_QN, I_KN, I_SINK, I_HCW, I_HCB, I_HW1, I_HB1, I_HW2, I_HB2, I_HW3, I_HB3, I_HW4, I_HFREQ, I_HBIASD, I_SCW, I_WUP, I_FCW, I_FCB, I_WDOWN };

#ifndef PHMASK
#define PHMASK 0xffffffffu
#endif
#define PH(n) ((PHMASK >> (n)) & 1u)
typedef const float* const __attribute__((address_space(4))) * kargp_t;
#define IDS() int tid = threadIdx.x; asm volatile("" : "+v"(tid)); const int lane = tid & 63, wave = __builtin_amdgcn_readfirstlane(tid >> 6); int bx = blockIdx.x; asm volatile("" : "+s"(bx)); \
    const int gw = bx * 8 + wave, G = gridDim.x, ngw = G * 8; (void)lane; (void)gw; (void)wave; (void)ngw; \
    unsigned long long kb_ = (unsigned long long)__builtin_amdgcn_kernarg_segment_ptr(); asm volatile("" : "+s"(kb_)); const kargp_t KA = (kargp_t)kb_; \
    unsigned char* const ws = (unsigned char*)KA[30]; float* const OUT = (float*)KA[29]; (void)ws; (void)OUT; \
    const bool last = layer == 1; (void)last
#define IN(i) (KA[i])
#define P_MOD ((float*)(ws + WS_MOD))
#define P_TW ((f32x2v*)(ws + WS_TW))
#define P_ROPE ((f32x2v*)(ws + WS_ROPE))
#define P_FSUMC ((float*)(ws + WS_FSUMC))
#define P_FSUM ((float*)(ws + WS_FSUM))
#define P_KC ((float*)(ws + WS_KC))
#define P_UC ((float*)(ws + WS_UC))
#define P_XC ((float*)(ws + WS_XC))
#define P_XN ((bf16*)(ws + WS_XN))
#define P_Z ((bf16*)(ws + WS_Z))
#define P_OC ((bf16*)(ws + WS_OC))
#define P_UT ((float*)(ws + WS_UT))
#define P_KF ((f32x2v*)(ws + WS_KF))
#define P_AV ((bf16*)(ws + WS_AV))
#define P_G ((bf16*)(ws + WS_G))
#define P_MODL (P_MOD + (size_t)layer * 5 * 6144)
#define P_WB (ws + WS_WB + (size_t)layer * WB_LAYER)
#define RES_L (last ? (const float*)OUT : IN(I_X))
#define RES_C (last ? (const float*)P_XC : IN(I_CTX))
__global__ void __launch_bounds__(NTHR, 2) hfb_fwd(Args a) {
    extern __shared__ __attribute__((aligned(16))) unsigned char lds[];
    cg::grid_group grid = cg::this_grid();
    LAS unsigned char* L = (LAS unsigned char*)lds;
    (void)a;
    { const int layer = 0; IDS(); if (PH(0)) p0_weights(IN(I_WIN), IN(I_WOUT), IN(I_WUP), IN(I_WDOWN), ws + WS_WB, (LAS float*)(L + wave * 16384), gw, ngw, lane);
      __syncthreads(); }
    { const int layer = 0; IDS(); if (PH(1)) for (int it = bx; it < 192 + 20 + 264; it += G) {
        if (it < 192) p0_mod_item(IN(I_C), IN(I_CCTX), IN(I_ADAW), IN(I_ADAB), P_MOD, (LAS float*)L, it, tid);
        else if (it < 208) { const int k = (it - 192) * NTHR + tid; float s, c; sincospif(2.0f * (float)k / (float)NFFT, &s, &c); P_TW[k] = (f32x2v){c, -s}; }
        else if (it < 212) { const int e = (it - 208) * NTHR + tid, pos = e >> 4, f = e & 15; const float inv_pi = exp2f(-(float)f * 0.8304820237218406f) * 0.3183098861837907f; float sn, cs; sincospif((float)pos * inv_pi, &sn, &cs); P_ROPE[e] = (f32x2v){cs, sn}; }
        else if (it < 212 + 256) p0_filter_item<false>(IN(I_HW1), IN(I_HB1), IN(I_HW2), IN(I_HB2), IN(I_HW3), IN(I_HB3), IN(I_HW4), IN(I_HFREQ), P_UT, P_FSUM, (LAS float*)L, it - 212, tid);
        else p0_filter_item<true>(IN(I_HW1), IN(I_HB1), IN(I_HW2), IN(I_HB2), IN(I_HW3), IN(I_HB3), IN(I_HW4), IN(I_HFREQ), P_KC, P_FSUMC, (LAS float*)L, it - 468, tid);
    } }
    grid.sync();

#pragma unroll 1
    for (int layer = 0; layer < 2; ++layer) {
        { IDS(); if (PH(2)) if (!last) for (int c = bx; c < CW; c += G) filter_fft_item(P_UT, P_FSUM, P_KF, P_TW, (LAS f32x2v*)L, (LAS float*)(L + FFT_LDS_ELEMS * 8), c, tid);
          if (PH(3)) modulate_rows(RES_L, RES_C, IN(I_NMIX) + layer * DM, P_MODL, 0, P_XN, 0, MT, gw, ngw, lane); }
        grid.sync();
        { IDS(); if (PH(4)) { pg8::Gemm g{P_XN, (const bf16*)(P_WB + WB_IN), MT, ZW, DM}; pg8::StaticOrder S; S.init(MT, ZW, G, bx); EpiStoreBf16 E{P_Z, ZW};
          pg8::gemm_phase<EpiStoreBf16, pg8::StaticOrder, true, true>(L, g, S, E); } }
        grid.sync();
        { IDS(); if (PH(5)) qk_norm_rope(P_Z, IN(I_QN) + layer * 64, IN(I_KN) + layer * 64, P_ROPE, bx, G, tid);
          if (PH(6)) { if (!last) hyena_pre(P_Z, IN(I_HCW), IN(I_HCB), P_OC, P_UT, P_UC, (LAS float*)L, bx, G, tid);
                       else short_conv(P_Z, IN(I_SCW), P_OC, bx, G, tid); } }
        grid.sync();
        if (layer == 0) {
            { IDS(); if (PH(7)) for (int it = bx; it < 1024; it += G) conv_fft_item(P_UT, P_KF, P_TW, IN(I_HBIASD), (LAS f32x2v*)L, it, tid);
              if (PH(8)) for (int it = bx; it < 1024; it += G) ctx_conv_item(P_KC, P_FSUMC, P_UC, IN(I_HBIASD), P_OC, it, tid);
              __syncthreads(); }
            { IDS(); const int vcu = (G % 8 == 0) ? (bx % 8) * (G / 8) + bx / 8 : bx;
              if (PH(9)) for (int i = 0; i < 5; ++i) {
                const int u = i * 256 + vcu; if (i == 4 && vcu >= 32) break;
                const attn_body::bf16* Zb = (const attn_body::bf16*)P_Z; attn_body::bf16* Ob = (attn_body::bf16*)P_OC;
                int b, h, NT; size_t qrow, lrow;
                if (i < 4) { const int bh = u >> 5, qb = u & 31; b = bh >> 3; h = bh & 7; qrow = (size_t)b * SEQ + qb * 256; lrow = (size_t)b * SEQ; NT = 4 + SEQ / 64; }
                else { b = vcu >> 3; h = vcu & 7; qrow = (size_t)ML + b * CTXL; lrow = qrow; NT = 4; }
                const int kvh = h >> 1; const size_t crow = (size_t)ML + b * CTXL;
                attn_body::attn_unit<8, false>(Zb + qrow * ZW + h * 64, Zb + crow * ZW + 512 + kvh * 64, Zb + lrow * ZW + 512 + kvh * 64, Zb + crow * ZW + 768 + kvh * 64, Zb + lrow * ZW + 768 + kvh * 64,
                                               Ob + qrow * DM + h * 64, NT, 0, 0, 0.f, (char*)lds);
              } }
        } else {
            { IDS(); const int vcu = (G % 8 == 0) ? (bx % 8) * (G / 8) + bx / 8 : bx;
              if (PH(10)) for (int i = 0; i < 4; ++i) {
                const int u = i * 256 + vcu, bh = u >> 5, qb = u & 31, b = bh >> 3, h = bh & 7, kvh = h >> 1;
                const int q0 = qb * 256, klo = q0 - 128 < 0 ? 0 : q0 - 128, khi = q0 + 384 > SEQ ? SEQ : q0 + 384;
                const size_t qrow = (size_t)b * SEQ + q0, crow = (size_t)ML + b * CTXL, lrow = (size_t)b * SEQ + klo;
                const attn_body::bf16* Zb = (const attn_body::bf16*)P_Z; attn_body::bf16* Ob = (attn_body::bf16*)P_OC;
                attn_body::attn_unit<8, true>(Zb + qrow * ZW + h * 64, Zb + crow * ZW + 512 + kvh * 64, Zb + lrow * ZW + 512 + kvh * 64, Zb + crow * ZW + 768 + kvh * 64, Zb + lrow * ZW + 768 + kvh * 64,
                                              Ob + qrow * DM + h * 64, 4 + (khi - klo) / 64, q0, klo, IN(I_SINK)[h] * 1.4426950408889634f, (char*)lds);
              } }
        }
        grid.sync();
        if (layer == 0) { { IDS(); if (PH(11)) hyena_post(P_UT, P_OC, (LAS float*)L, bx, G, tid); } grid.sync(); }
        { IDS(); const int mrows = last ? ML : MT;
          if (PH(12)) { pg8::Gemm g{P_OC, (const bf16*)(P_WB + WB_OUT), mrows, DM, DM}; pg8::StaticOrder S; S.init(mrows, DM, G, bx);
          EpiRes E{RES_L, OUT, RES_C, P_XC, P_MODL + 2 * 1024, 0};
          pg8::gemm_phase<EpiRes, pg8::StaticOrder, true, true>(L, g, S, E); } }
        grid.sync();
        { IDS(); const int mrows = last ? ML : MT; if (PH(13)) modulate_rows(OUT, P_XC, IN(I_NFFN) + layer * DM, P_MODL, 3 * 1024, P_XN, 0, mrows, gw, ngw, lane); }
        grid.sync();
#pragma unroll 1
        for (int half = 0; half < 2; ++half) {
#define HALF_GEOM() const int mrows = last ? ML : MT; const int t_lo = half * 64, t_hi = half == 0 ? 64 : mrows / 256, nrows = (t_hi - t_lo) * 256, row0 = t_lo * 256; (void)row0
            { IDS(); HALF_GEOM(); if (PH(14)) { pg8::Gemm g{P_XN + (size_t)row0 * DM, (const bf16*)(P_WB + WB_UP), nrows, FF2, DM}; pg8::StaticOrder S; S.init(nrows, FF2, G, bx); EpiStoreBf16 E{P_AV, FF2};
              pg8::gemm_phase<EpiStoreBf16, pg8::StaticOrder, true, true>(L, g, S, E); } }
            grid.sync();
            { IDS(); HALF_GEOM(); if (PH(15)) ffn_gate(P_AV, P_G, IN(I_FCW) + (size_t)layer * 3 * FF, IN(I_FCB) + (size_t)layer * FF, row0, nrows, bx, G, tid); }
            grid.sync();
            { IDS(); HALF_GEOM(); if (PH(16)) { pg8::Gemm g{P_G, (const bf16*)(P_WB + WB_DOWN), nrows, DM, FF}; pg8::StaticOrder S; S.init(nrows, DM, G, bx);
              EpiRes E{OUT, OUT, P_XC, P_XC, P_MODL + 5 * 1024, t_lo};
              pg8::gemm_phase<EpiRes, pg8::StaticOrder, true, true>(L, g, S, E); } }
            if (!(layer == 1 && half == 1)) grid.sync();
        }
    }
}

extern "C" void kernel_launch(void* const* d_in, const int* in_sizes, int n_in, void* d_out, int out_size, void* d_ws, size_t ws_size, hipStream_t stream) {
    static int grid = 0;
    if (grid == 0) {
        if (n_in != 29 || out_size != ML * DM || ws_size < WS_END) { fprintf(stderr, "kernel_launch: unexpected shapes (n_in %d, out %d, ws %zu < %zu)\n", n_in, out_size, ws_size, (size_t)WS_END); grid = -1; return; }
        int dev = 0, cus = 0, per_cu = 0;
        hipGetDevice(&dev); hipDeviceGetAttribute(&cus, hipDeviceAttributeMultiprocessorCount, dev);
        if (hipFuncSetAttribute((const void*)hfb_fwd, hipFuncAttributeMaxDynamicSharedMemorySize, LDS_BYTES) != hipSuccess) { fprintf(stderr, "kernel_launch: hipFuncSetAttribute failed\n"); grid = -1; return; }
        if (hipOccupancyMaxActiveBlocksPerMultiprocessor(&per_cu, (const void*)hfb_fwd, NTHR, LDS_BYTES) != hipSuccess || per_cu < 1) { fprintf(stderr, "kernel_launch: occupancy query says %d\n", per_cu); per_cu = 1; }
        (void)hipGetLastError();
        grid = cus;
    }
    if (grid < 0) return;
    Args a{};
    for (int i = 0; i < 29; ++i) a.in[i] = (const float*)d_in[i];
    a.out = (float*)d_out; a.ws = (unsigned char*)d_ws;
    void* args[] = {&a};
    hipError_t e = hipLaunchCooperativeKernel((const void*)hfb_fwd, dim3(grid), dim3(NTHR), args, LDS_BYTES, stream);
    if (e != hipSuccess) fprintf(stderr, "cooperative launch failed: %s (grid %d)\n", hipGetErrorString(e), grid);
}
```

```cpp
#include <hip/hip_runtime.h>
#include <hip/hip_cooperative_groups.h>
#include <hip/hip_bf16.h>
#include <cstdio>
#include <cstdint>
#include <cmath>
namespace cg = cooperative_groups;
namespace pg8 {
#define PG8_LAS __attribute__((address_space(3)))
typedef unsigned short bf16_t;
typedef short bf16x8 __attribute__((ext_vector_type(8)));
typedef float f32x4 __attribute__((ext_vector_type(4)));
typedef unsigned u32x4 __attribute__((ext_vector_type(4)));
constexpr int BM = 256, BK = 64, HALF = 128, HTB = HALF * BK * 2  , STAGE_BYTES = 8 * HTB, NXCD = 8, WGM = 8;

__host__ __device__ __forceinline__ int lds_byte(int r, int c) { const int st = (r >> 4) * 2 + (c >> 5), rr = r & 15, cc = c & 31, ob = rr * 64 + cc * 2; return st * 1024 + (ob ^ (((ob >> 9) & 1) << 5)); }
__host__ __device__ __forceinline__ void stage_rc(int b, int& R, int& C) { const int st = b / 1024, sb = b % 1024, swz = sb ^ (((sb >> 9) & 1) << 5); R = (st >> 1) * 16 + swz / 64; C = (st & 1) * 32 + (swz % 64) / 2; }
__host__ __device__ __forceinline__ int perm32(int rho) { const int n = rho >> 4, i = rho & 15; return 8 * (i >> 2) + 4 * n + (i & 3); }

struct Unit { int pm, pn; };
struct Gemm { const bf16_t* A; const bf16_t* Bt; int M, N, K; };

struct StaticOrder {
    int nM, nN, nwg, G, c;
    __host__ __device__ void init(int M, int N, int G_, int c_) { nM = M / BM; nN = N / BM; nwg = nM * nN; G = G_; c = c_; }
    __host__ __device__ bool next(int i, Unit& u) const {
        const long L = (long)i * G + c; if (L >= nwg) return false;
        int wgid = (int)L; { const int q = nwg / NXCD, r = nwg % NXCD, xcd = wgid % NXCD, off = wgid / NXCD; wgid = (xcd < r ? xcd * (q + 1) : r * (q + 1) + (xcd - r) * q) + off; }
        const int nig = WGM * nN, gid = wgid / nig, fm = gid * WGM, gsz = (nM - fm) < WGM ? (nM - fm) : WGM;
        u.pm = fm + ((wgid % nig) % gsz); u.pn = (wgid % nig) / gsz; return true;
    }
    __device__ __forceinline__ void a_ready(const Unit&) const {}
    __device__ __forceinline__ void done(const Unit&) const {}
};

__device__ __forceinline__ unsigned cvt_pk_bf16(float lo, float hi) { unsigned r; asm volatile("v_cvt_pk_bf16_f32 %0, %1, %2" : "=v"(r) : "v"(lo), "v"(hi)); return r; }
template <class Epi, class Sched, bool ALIGN_EPI = false, bool SP2 = false>
__device__ __forceinline__ void gemm_phase(PG8_LAS unsigned char* lds, const Gemm g, const Sched& S, const Epi& E) {
    int tid_o = threadIdx.x; asm volatile("" : "+v"(tid_o));
    const int tid = tid_o, wid = __builtin_amdgcn_readfirstlane(tid >> 6), lane = tid & 63, wr = wid >> 2, wc = wid & 3, fr = lane & 15, fq = lane >> 4;
    const int K = g.K, nt = K / BK;
    unsigned voffA[2], voffB[2];
#pragma unroll
    for (int i = 0; i < 2; ++i) { int R, C; stage_rc(tid * 16 + i * 8192, R, C); const int Rb = Epi::PERM ? ((R & ~31) + perm32(R & 31)) : R;
        voffA[i] = (unsigned)(R * K + C) * 2u; voffB[i] = (unsigned)(Rb * K + C) * 2u; }
    const size_t kstep = (size_t)(BK * 2);
    const size_t hstep = (size_t)HALF * K * 2;
    const size_t tstep = 2 * hstep;
    const unsigned ldsw = (unsigned)wid * 1024u;
    const int aoff = lds_byte(wr * 64 + fr, fq * 8), boff = lds_byte(wc * 32 + fr, fq * 8);
#define PG8_SA(b, h) (((b) * 2 + (h)) * HTB)
#define PG8_SB(b, h) ((4 + (b) * 2 + (h)) * HTB)
#define PG8_STAGE(bufoff, gbase, voff) do { _Pragma("unroll") for (int _i = 0; _i < 2; ++_i) \
        __builtin_amdgcn_global_load_lds((const unsigned*)((const char*)(gbase) + (voff)[_i]), (PG8_LAS unsigned*)(lds + (bufoff) + ldsw + _i * 8192), 16, 0, 0); } while (0)
#define PG8_LDA(dst, b, h) do { _Pragma("unroll") for (int m = 0; m < 4; ++m) _Pragma("unroll") for (int k = 0; k < 2; ++k) dst[m][k] = *(const PG8_LAS bf16x8*)(lds + PG8_SA(b, h) + aoff + m * 2048 + k * 1024); } while (0)
#define PG8_LDB(dst, b, h) do { _Pragma("unroll") for (int n = 0; n < 2; ++n) _Pragma("unroll") for (int k = 0; k < 2; ++k) dst[n][k] = *(const PG8_LAS bf16x8*)(lds + PG8_SB(b, h) + boff + n * 2048 + k * 1024); } while (0)
#define PG8_MMA(ai, bj, At, Bt) do { __builtin_amdgcn_s_setprio(1); _Pragma("unroll") for (int m = 0; m < 4; ++m) _Pragma("unroll") for (int n = 0; n < 2; ++n) _Pragma("unroll") for (int k = 0; k < 2; ++k) \
        acc[ai][bj][m][n] = __builtin_amdgcn_mfma_f32_16x16x32_bf16(Bt[n][k], At[m][k], acc[ai][bj][m][n], 0, 0, 0); __builtin_amdgcn_s_setprio(0); } while (0)
#define PG8_WAIT_V(n) asm volatile("s_waitcnt vmcnt(" #n ")" ::: "memory")
#define PG8_WAIT_L(n) asm volatile("s_waitcnt lgkmcnt(" #n ")" ::: "memory")
#define PG8_BAR __builtin_amdgcn_s_barrier()
#define PG8_SCHED __builtin_amdgcn_sched_barrier(0)
    Unit cur, nxt; int ui = 0;
    if (!S.next(0, cur)) return;
    f32x4 acc[2][2][4][2];
#pragma unroll
    for (int a = 0; a < 2; ++a)
#pragma unroll
        for (int b = 0; b < 2; ++b)
#pragma unroll
            for (int m = 0; m < 4; ++m)
#pragma unroll
                for (int n = 0; n < 2; ++n) acc[a][b][m][n] = (f32x4){0.f, 0.f, 0.f, 0.f};
    bf16x8 At[4][2], B0[2][2], B1[2][2];
    const char* cA = (const char*)g.A + (size_t)cur.pm * tstep; const char* cB = (const char*)g.Bt + (size_t)cur.pn * tstep;
    S.a_ready(cur);
    if constexpr (SP2) {
        PG8_STAGE(PG8_SB(0, 0), cB, voffB); PG8_STAGE(PG8_SB(0, 1), cB + hstep, voffB); PG8_STAGE(PG8_SA(0, 0), cA, voffA); PG8_STAGE(PG8_SA(0, 1), cA + hstep, voffA);
        if (wr == 1) PG8_BAR;
        PG8_WAIT_V(2); PG8_BAR;
        PG8_STAGE(PG8_SB(1, 0), cB + kstep, voffB); PG8_STAGE(PG8_SA(1, 0), cA + kstep, voffA); PG8_STAGE(PG8_SB(1, 1), cB + hstep + kstep, voffB);
        PG8_WAIT_V(6); PG8_BAR;
    } else {
        PG8_STAGE(PG8_SB(0, 0), cB, voffB); PG8_STAGE(PG8_SA(0, 0), cA, voffA); PG8_STAGE(PG8_SB(0, 1), cB + hstep, voffB); PG8_STAGE(PG8_SA(0, 1), cA + hstep, voffA);
        if (wr == 1) PG8_BAR;
        PG8_WAIT_V(4); PG8_BAR;
        PG8_STAGE(PG8_SB(1, 0), cB + kstep, voffB); PG8_STAGE(PG8_SA(1, 0), cA + kstep, voffA); PG8_STAGE(PG8_SB(1, 1), cB + hstep + kstep, voffB);
        PG8_WAIT_V(6); PG8_BAR;
    }
    for (;;) {
        const bool has_next = S.next(ui + 1, nxt);
        const char* nA = has_next ? (const char*)g.A + (size_t)nxt.pm * tstep : cA; const char* nB = has_next ? (const char*)g.Bt + (size_t)nxt.pn * tstep : cB;
        for (int t = 0; t < nt; t += 2) {
            const bool last = (t == nt - 2);
            const char* a1 = cA + (size_t)(t + 1) * kstep;
            const char* a2 = last ? nA : cA + (size_t)(t + 2) * kstep; const char* b2 = last ? nB : cB + (size_t)(t + 2) * kstep;
            const char* a3 = a2 + kstep; const char* b3 = b2 + kstep;
            if (last && has_next) S.a_ready(nxt);
            if constexpr (SP2) {
            PG8_LDB(B0, 0, 0); PG8_LDB(B1, 0, 1); PG8_SCHED; PG8_LDA(At, 0, 0); PG8_STAGE(PG8_SA(1, 1), a1 + hstep, voffA);
            PG8_WAIT_V(8); PG8_WAIT_L(0); PG8_BAR; PG8_MMA(0, 0, At, B0); PG8_MMA(0, 1, At, B1); PG8_BAR; PG8_SCHED;
            PG8_LDA(At, 0, 1); PG8_STAGE(PG8_SB(0, 0), b2, voffB); PG8_STAGE(PG8_SB(0, 1), b2 + hstep, voffB); PG8_STAGE(PG8_SA(0, 0), a2, voffA);
            PG8_WAIT_V(8); PG8_WAIT_L(0); PG8_BAR; PG8_MMA(1, 0, At, B0); PG8_MMA(1, 1, At, B1); PG8_BAR; PG8_SCHED;
            PG8_LDB(B0, 1, 0); PG8_LDB(B1, 1, 1); PG8_SCHED; PG8_LDA(At, 1, 0); PG8_STAGE(PG8_SA(0, 1), a2 + hstep, voffA);
            PG8_WAIT_V(8); PG8_WAIT_L(0); PG8_BAR; PG8_MMA(0, 0, At, B0); PG8_MMA(0, 1, At, B1); PG8_BAR; PG8_SCHED;
            PG8_LDA(At, 1, 1); PG8_STAGE(PG8_SB(1, 0), b3, voffB); PG8_STAGE(PG8_SB(1, 1), b3 + hstep, voffB); PG8_STAGE(PG8_SA(1, 0), a3, voffA);
            PG8_WAIT_V(8); PG8_WAIT_L(0); PG8_BAR; PG8_MMA(1, 0, At, B0); PG8_MMA(1, 1, At, B1); PG8_BAR; PG8_SCHED;
            } else {
            PG8_LDB(B0, 0, 0); PG8_SCHED; PG8_LDA(At, 0, 0); PG8_STAGE(PG8_SA(1, 1), a1 + hstep, voffA);
            PG8_WAIT_L(8); PG8_BAR; PG8_WAIT_L(0); PG8_MMA(0, 0, At, B0); PG8_BAR; PG8_SCHED;
            PG8_LDB(B1, 0, 1); PG8_STAGE(PG8_SB(0, 0), b2, voffB);
            PG8_BAR; PG8_WAIT_L(0); PG8_MMA(0, 1, At, B1); PG8_BAR;
            PG8_LDA(At, 0, 1); PG8_STAGE(PG8_SA(0, 0), a2, voffA);
            PG8_BAR; PG8_WAIT_L(0); PG8_MMA(1, 0, At, B0); PG8_BAR; PG8_SCHED;
            PG8_STAGE(PG8_SB(0, 1), b2 + hstep, voffB);
            PG8_WAIT_V(6); PG8_BAR; PG8_MMA(1, 1, At, B1); PG8_BAR;
            PG8_LDB(B0, 1, 0); PG8_SCHED; PG8_LDA(At, 1, 0); PG8_STAGE(PG8_SA(0, 1), a2 + hstep, voffA);
            PG8_WAIT_L(8); PG8_BAR; PG8_WAIT_L(0); PG8_MMA(0, 0, At, B0); PG8_BAR; PG8_SCHED;
            PG8_LDB(B1, 1, 1); PG8_STAGE(PG8_SB(1, 0), b3, voffB);
            PG8_BAR; PG8_WAIT_L(0); PG8_MMA(0, 1, At, B1); PG8_BAR;
            PG8_LDA(At, 1, 1); PG8_STAGE(PG8_SA(1, 0), a3, voffA);
            PG8_BAR; PG8_WAIT_L(0); PG8_MMA(1, 0, At, B0); PG8_BAR; PG8_SCHED;
            PG8_STAGE(PG8_SB(1, 1), b3 + hstep, voffB);
            PG8_WAIT_V(6); PG8_BAR; PG8_MMA(1, 1, At, B1); PG8_BAR;
            }
        }
        if constexpr (ALIGN_EPI) { if (wr == 0) PG8_BAR; }
        if constexpr (!Epi::AFTER_DRAIN) { E(acc, cur, wr, wc, fr, fq); S.done(cur); }
        if (!has_next) break;
#pragma unroll
        for (int a = 0; a < 2; ++a)
#pragma unroll
            for (int b = 0; b < 2; ++b)
#pragma unroll
                for (int m = 0; m < 4; ++m)
#pragma unroll
                    for (int n = 0; n < 2; ++n) acc[a][b][m][n] = (f32x4){0.f, 0.f, 0.f, 0.f};
        cur = nxt; cA = nA; cB = nB; ++ui;
        if constexpr (ALIGN_EPI) { if (wr == 1) PG8_BAR; }
    }
    PG8_WAIT_V(0);
    if constexpr (!ALIGN_EPI) { if (wr == 0) PG8_BAR; }
    PG8_BAR;
    if constexpr (Epi::AFTER_DRAIN) { E.fused(acc, cur, wr, wc, fr, fq, lds, wid, lane); S.done(cur); }
#undef PG8_SA
#undef PG8_SB
#undef PG8_STAGE
#undef PG8_LDA
#undef PG8_LDB
#undef PG8_MMA
#undef PG8_WAIT_V
#undef PG8_WAIT_L
#undef PG8_BAR
#undef PG8_SCHED
}
}
#include <hip/hip_bf16.h>
#include <cmath>
namespace attn_body {
using bf16=__hip_bfloat16;
using bf16x8=__attribute__((ext_vector_type(8)))short;
using s16x4=__attribute__((ext_vector_type(4)))short;
using f32x16=__attribute__((ext_vector_type(16)))float;
using u32x4=__attribute__((ext_vector_type(4)))unsigned;
constexpr int D=64,ZP=2560,OP=1024;
constexpr int NW=8,QBLK=32,QB=QBLK*NW,KVBLK=64;
__device__ __forceinline__ int crow(int r,int hi){return (r&3)+8*(r>>2)+4*hi;}
#define SBAR() __builtin_amdgcn_sched_barrier(0)
__device__ __forceinline__ void cmask(f32x16&p0,f32x16&p1,int jb,int qrel,int hi){
  const float NEG=-INFINITY; int kb=64*jb+4*hi;
  #pragma unroll
  for(int r=0;r<16;++r){int kv=kb+(r&3)+8*(r>>2); if(kv>qrel)p0[r]=NEG; if(kv+32>qrel)p1[r]=NEG;}
}

__device__ __forceinline__ void bandmask(f32x16&p0,f32x16&p1,int ktile0,int qabs,int hi){
  const float NEG=-INFINITY; const int kb=ktile0+4*hi-qabs;
  #pragma unroll
  for(int r=0;r<16;++r){int d=kb+(r&3)+8*(r>>2); if(d>128||d<-128)p0[r]=NEG; if(d+32>128||d+32<-128)p1[r]=NEG;}
}
constexpr int NSLOT=3, SLOTB=8192;
constexpr int LDS_K=0, LDS_V=NSLOT*SLOTB, LDS_WS=2*NSLOT*SLOTB, LDS_OST=LDS_WS+NW*64*4, LDS_BYTES=LDS_OST+NW*4096;
constexpr float C2=0.125f*1.4426950408889634f;
__device__ __forceinline__ void glds16(const void*gsrc,unsigned lds_dst){unsigned keep;
  asm volatile("s_mov_b32 %0, m0\n\ts_mov_b32 m0, %2\n\ts_nop 0\n\tglobal_load_lds_dwordx4 %1, off\n\ts_mov_b32 m0, %0":"=&s"(keep):"v"(gsrc),"s"(lds_dst):"memory");}
__device__ __forceinline__ float max3f(float a,float b,float c){float r;asm("v_max3_f32 %0, %1, %2, %3":"=v"(r):"v"(a),"v"(b),"v"(c));return r;}
__device__ __forceinline__ float max2f(float a,float b){float r;asm("v_max_f32_e32 %0, %1, %2":"=v"(r):"v"(a),"v"(b));return r;}
__device__ __forceinline__ float fadd_s(float a,float b){float r;asm("v_add_f32_e32 %0, %1, %2":"=v"(r):"v"(a),"v"(b));return r;}
__device__ __forceinline__ float fsub_s(float a,float b){float r;asm("v_sub_f32_e32 %0, %1, %2":"=v"(r):"v"(a),"v"(b));return r;}
typedef float f32x2_t __attribute__((ext_vector_type(2))); typedef __bf16 bf16x2_t __attribute__((ext_vector_type(2)));
__device__ __forceinline__ unsigned cvtpk_s(float lo,float hi){f32x2_t v={lo,hi};bf16x2_t b=__builtin_convertvector(v,bf16x2_t);return __builtin_bit_cast(unsigned,b);}
#define WAIT_BAR(N) asm volatile("s_waitcnt vmcnt(" #N ") lgkmcnt(0)\n\ts_barrier":::"memory")

__device__ __forceinline__ void qkt(f32x16&p0,f32x16&p1,const char*Kslot,const bf16x8*qr,const f32x16&negm,int r32,int hi){
  const char*kb=Kslot+hi*1024+r32*16;
  #pragma unroll
  for(int d0=0;d0<4;++d0){
    const bf16x8 b0=*reinterpret_cast<const bf16x8*>(kb+d0*2048);
    const bf16x8 b1=*reinterpret_cast<const bf16x8*>(kb+d0*2048+512);
    if(d0==0){p0=__builtin_amdgcn_mfma_f32_32x32x16_bf16(b0,qr[0],negm,0,0,0);p1=__builtin_amdgcn_mfma_f32_32x32x16_bf16(b1,qr[0],negm,0,0,0);}
    else{p0=__builtin_amdgcn_mfma_f32_32x32x16_bf16(b0,qr[d0],p0,0,0,0);p1=__builtin_amdgcn_mfma_f32_32x32x16_bf16(b1,qr[d0],p1,0,0,0);}}
}
typedef __attribute__((address_space(3))) const char* lds_cptr;
typedef short v4i16_t __attribute__((ext_vector_type(4)));
__device__ __forceinline__ void kload8(bf16x8*kf,lds_cptr kp){
  kf[0]=*(const __attribute__((address_space(3))) bf16x8*)(kp);      kf[1]=*(const __attribute__((address_space(3))) bf16x8*)(kp+512);
  kf[2]=*(const __attribute__((address_space(3))) bf16x8*)(kp+2048); kf[3]=*(const __attribute__((address_space(3))) bf16x8*)(kp+2560);
  kf[4]=*(const __attribute__((address_space(3))) bf16x8*)(kp+4096); kf[5]=*(const __attribute__((address_space(3))) bf16x8*)(kp+4608);
  kf[6]=*(const __attribute__((address_space(3))) bf16x8*)(kp+6144); kf[7]=*(const __attribute__((address_space(3))) bf16x8*)(kp+6656);
}
__device__ __forceinline__ void kload2(bf16x8*kf,lds_cptr kp,int j){ kf[2*j]=*(const __attribute__((address_space(3))) bf16x8*)(kp+j*2048); kf[2*j+1]=*(const __attribute__((address_space(3))) bf16x8*)(kp+j*2048+512); }
__device__ __forceinline__ s16x4 vtr(lds_cptr p){ return __builtin_bit_cast(s16x4,__builtin_amdgcn_ds_read_tr16_b64_v4i16((__attribute__((address_space(3))) v4i16_t*)p)); }
__device__ __forceinline__ float rowmax(const f32x16&p0,const f32x16&p1){
  float a=max3f(p0[0],p0[1],p1[0]),b=max3f(p0[2],p0[3],p1[1]);a=max3f(a,p1[2],p1[3]);
  #pragma unroll
  for(int r=4;r<16;r+=4){a=max3f(a,p0[r],p0[r+1]);b=max3f(b,p0[r+2],p0[r+3]);a=max3f(a,p1[r],p1[r+1]);b=max3f(b,p1[r+2],p1[r+3]);}
  const float m=max2f(a,b);
  auto rr=__builtin_amdgcn_permlane32_swap(__float_as_uint(m),__float_as_uint(m),false,false);
  return max2f(__uint_as_float(rr[0]),__uint_as_float(rr[1]));
}
__device__ __forceinline__ void pv(f32x16*o,int vb,bf16x8 pa0,bf16x8 pa1,bf16x8 pa2,bf16x8 pa3){
  #pragma unroll
  for(int d0=0;d0<2;++d0){s16x4 lo[4],hi[4];
    #pragma unroll
    for(int ks=0;ks<4;++ks){
      asm volatile("ds_read_b64_tr_b16 %0,%1 offset:%c2":"=&v"(lo[ks]):"v"(vb),"i"(d0*4096+ks*1024):"memory");
      asm volatile("ds_read_b64_tr_b16 %0,%1 offset:%c2":"=&v"(hi[ks]):"v"(vb),"i"(d0*4096+ks*1024+512):"memory");}
    asm volatile("s_waitcnt lgkmcnt(0)":::"memory");SBAR();
    #define PK(k) (bf16x8){lo[k][0],lo[k][1],lo[k][2],lo[k][3],hi[k][0],hi[k][1],hi[k][2],hi[k][3]}
    o[d0]=__builtin_amdgcn_mfma_f32_32x32x16_bf16(pa0,PK(0),o[d0],0,0,0);
    o[d0]=__builtin_amdgcn_mfma_f32_32x32x16_bf16(pa1,PK(1),o[d0],0,0,0);
    o[d0]=__builtin_amdgcn_mfma_f32_32x32x16_bf16(pa2,PK(2),o[d0],0,0,0);
    o[d0]=__builtin_amdgcn_mfma_f32_32x32x16_bf16(pa3,PK(3),o[d0],0,0,0);
    #undef PK
  }
}

#ifndef ATTN_STORE16
#define ATTN_STORE16(p,v) (*(u32x4*)(p)=(v))
#endif
template<int THRL,bool BANDED> __device__ __forceinline__ void attn_unit(const bf16*Qrows,const bf16*__restrict__ Kc,const bf16*__restrict__ Kl,const bf16*__restrict__ Vc,const bf16*__restrict__ Vl,bf16*Orows,const int NT,const int qpos0,const int kpos0,const float sink_l2,char*shm){
  int tid_o=threadIdx.x; asm volatile("":"+v"(tid_o)); const int tid=tid_o,lane=tid&63,r32=lane&31,hi=lane>>5; const int wid=__builtin_amdgcn_readfirstlane(tid>>6);
  const bf16*Qw=Qrows+(long)(wid*QBLK)*ZP;
  const unsigned lds0=(unsigned)(uintptr_t)shm;
  float*wsf=(float*)(shm+LDS_WS)+wid*64;
  const long koff=(long)lane*ZP+wid*8, voff=(long)(16*(wid&3)+(lane>>2))*ZP+(wid>>2)*32+(lane&3)*8;
  const bf16*ksrc_c=Kc+koff,*ksrc_l=Kl+koff-(long)4*KVBLK*ZP,*vsrc_c=Vc+voff,*vsrc_l=Vl+voff-(long)4*KVBLK*ZP;
  const unsigned kdst=lds0+LDS_K+wid*1024, vdst=lds0+LDS_V+wid*1024;
  #define DMA_K(t,slot) glds16((((t)<4)?ksrc_c:ksrc_l)+(long)(t)*KVBLK*ZP,(unsigned)__builtin_amdgcn_readfirstlane(kdst+(slot)))
  #define DMA_V(t,slot) glds16((((t)<4)?vsrc_c:vsrc_l)+(long)(t)*KVBLK*ZP,(unsigned)__builtin_amdgcn_readfirstlane(vdst+(slot)))
  const int vb0=(int)(lds0+LDS_V)+((lane>>4)&1)*32+(lane&3)*8+(4*hi+((lane&15)>>2))*64;
  const char*Kbase=shm+LDS_K; bf16x8 kf[8];
  const lds_cptr shm3=(lds_cptr)shm; const lds_cptr kp0=shm3+LDS_K+hi*1024+r32*16; const lds_cptr vp0=shm3+LDS_V+((lane>>4)&1)*32+(lane&3)*8+(4*hi+((lane&15)>>2))*64;
  DMA_K(0,0);DMA_V(0,0);DMA_K(1,SLOTB);
  bf16x8 qr[4];
  #pragma unroll
  for(int d0=0;d0<4;++d0)qr[d0]=*reinterpret_cast<const bf16x8*>(&Qw[(long)r32*ZP+d0*16+hi*8]);
  float mhat=0.f,l_reg=0.f;f32x16 o[2];o[0]=f32x16{};o[1]=f32x16{};f32x16 negm=f32x16{};asm volatile("":"+v"(negm));
  const int qrel=wid*QBLK+r32;
  #define CMASK(P0,P1,t) do{ if(BANDED&&(t)>=4) bandmask(P0,P1,kpos0+64*((t)-4),qpos0+qrel,hi); }while(0)
  bool resc=false;
  #define START(P0,P1) do{ const float rm=rowmax(P0,P1); resc=false; \
    { const float dl=rm; mhat=fadd_s(mhat,dl); \
      _Pragma("unroll") for(int r=0;r<16;++r){P0[r]=fsub_s(P0[r],dl);P1[r]=fsub_s(P1[r],dl);} \
      _Pragma("unroll") for(int r=0;r<16;++r)negm[r]=-mhat; asm volatile("":"+v"(negm)); } \
    _Pragma("unroll") for(int r=0;r<16;++r)P0[r]=__builtin_amdgcn_exp2f(P0[r]); }while(0)
  #define RESC() do{ if(resc){ asm volatile("s_waitcnt lgkmcnt(0)":::"memory"); \
      _Pragma("unroll") for(int d_=0;d_<2;++d_) _Pragma("unroll") for(int r=0;r<16;++r)o[d_][r]*=wsf[crow(r,hi)]; } }while(0)
  f32x16 pA0,pA1,pB0,pB1;
  int sl_prev=0,sl_cur=0,sl_next=SLOTB;
  #define ROT() do{sl_prev=sl_cur;sl_cur=sl_next;sl_next=(sl_next==(NSLOT-1)*SLOTB)?0:sl_next+SLOTB;}while(0)
  DMA_K(2,2*SLOTB);
  WAIT_BAR(3);
  qkt(pA0,pA1,Kbase,qr,negm,r32,hi);asm volatile("s_nop 15\n\ts_nop 7":"+v"(pA0),"+v"(pA1));CMASK(pA0,pA1,0);
  START(pA0,pA1);
  _Pragma("unroll") for(int r=0;r<16;++r)pA1[r]=__builtin_amdgcn_exp2f(pA1[r]);
  WAIT_BAR(0);
  DMA_K(3,0);DMA_V(1,SLOTB);
  ROT();
  kload8(kf,kp0+sl_cur);
  WAIT_BAR(2);
  s16x4 vlo[8],vhi[8]; u32x4 pw0,pw1,pw2,pw3;
  #define PKW(P,B) cvtpk_s(P[B],P[B+1])
  #define PAF(k) __builtin_bit_cast(bf16x8,pw##k)
  #define VFR(i) (bf16x8){vlo[i][0],vlo[i][1],vlo[i][2],vlo[i][3],vhi[i][0],vhi[i][1],vhi[i][2],vhi[i][3]}
  #define PIN(x) asm volatile("":"+v"(x))
  #define MX3(a,b,c) __builtin_fmaxf(__builtin_fmaxf((a),(b)),(c))
  #define GAPA(MF,A0,A1,A2,A3,W0,W1,PW) do{ MF; sacc+=A0; sacc+=A1; sacc+=A2; sacc+=A3; PIN(sacc); W0; W1; PIN(PW); SBAR(); }while(0)
  #define EX(v) __builtin_amdgcn_exp2f(v)
  #define GAPB(MF,X,B) do{ MF; X[B]=EX(X[B]); X[B+1]=EX(X[B+1]); X[B+2]=EX(X[B+2]); X[B+3]=EX(X[B+3]); PIN(X); SBAR(); }while(0)
  #define VRD(i) do{ vlo[i]=vtr(vp_+(((i)>>2)*4096+((i)&3)*1024)); vhi[i]=vtr(vp_+(((i)>>2)*4096+((i)&3)*1024+512)); }while(0)
  #define KRD(G,j) do{ if(G){ kload2(kf,kp0+sl_next,j); SBAR(); } }while(0)
  #define STEP(C0,C1,P0,P1,t,GK,GV,GL) do{ SBAR(); \
    const lds_cptr vp_=vp0+sl_prev; \
    VRD(0); SBAR(); float sacc=(P0[0]+P0[1]); \
    GAPA(C0=__builtin_amdgcn_mfma_f32_32x32x16_bf16(kf[0],qr[0],negm,0,0,0), P0[2],P0[3],P0[4],P0[5],     pw0[0]=PKW(P0,0), pw0[1]=PKW(P0,2), pw0); \
    VRD(4); SBAR(); GAPA(C1=__builtin_amdgcn_mfma_f32_32x32x16_bf16(kf[1],qr[0],negm,0,0,0), P0[6],P0[7],P0[8],P0[9],     pw0[2]=PKW(P0,4), pw0[3]=PKW(P0,6), pw0); \
    VRD(1); SBAR(); GAPA(C0=__builtin_amdgcn_mfma_f32_32x32x16_bf16(kf[2],qr[1],C0,0,0,0),   P0[10],P0[11],P0[12],P0[13], pw1[0]=PKW(P0,8), pw1[1]=PKW(P0,10), pw1); \
    VRD(5); SBAR(); GAPA(C1=__builtin_amdgcn_mfma_f32_32x32x16_bf16(kf[3],qr[1],C1,0,0,0),   P0[14],P0[15],P1[0],P1[1],   pw1[2]=PKW(P0,12),pw1[3]=PKW(P0,14), pw1); \
    VRD(2); SBAR(); GAPA(C0=__builtin_amdgcn_mfma_f32_32x32x16_bf16(kf[4],qr[2],C0,0,0,0),   P1[2],P1[3],P1[4],P1[5],     pw2[0]=PKW(P1,0), pw2[1]=PKW(P1,2), pw2); \
    VRD(6); SBAR(); GAPA(C1=__builtin_amdgcn_mfma_f32_32x32x16_bf16(kf[5],qr[2],C1,0,0,0),   P1[6],P1[7],P1[8],P1[9],     pw2[2]=PKW(P1,4), pw2[3]=PKW(P1,6), pw2); \
    VRD(3); SBAR(); GAPA(C0=__builtin_amdgcn_mfma_f32_32x32x16_bf16(kf[6],qr[3],C0,0,0,0),   P1[10],P1[11],P1[12],P1[13], pw3[0]=PKW(P1,8), pw3[1]=PKW(P1,10), pw3); \
    VRD(7); SBAR(); GAPA(C1=__builtin_amdgcn_mfma_f32_32x32x16_bf16(kf[7],qr[3],C1,0,0,0),   P1[14],P1[15],0.f,0.f,       pw3[2]=PKW(P1,12),pw3[3]=PKW(P1,14), pw3); \
    l_reg+=sacc; \
    if(GK){DMA_K((t)+3,sl_cur);} if(GV){DMA_V((t)+1,sl_next);} \
    CMASK(C0,C1,t); \
    { float a=MX3(C0[0],C0[1],C1[0]),b=MX3(C0[2],C0[3],C1[1]); a=MX3(a,C1[2],C1[3]); \
      _Pragma("unroll") for(int r=4;r<16;r+=4){a=MX3(a,C0[r],C0[r+1]);b=MX3(b,C0[r+2],C0[r+3]);a=MX3(a,C1[r],C1[r+1]);b=MX3(b,C1[r+2],C1[r+3]);} \
      float rm=__builtin_fmaxf(a,b); { auto rr=__builtin_amdgcn_permlane32_swap(__float_as_uint(rm),__float_as_uint(rm),false,false); rm=__builtin_fmaxf(__uint_as_float(rr[0]),__uint_as_float(rr[1])); } \
      resc=false; \
      if(__builtin_expect(__any(rm>(float)THRL),0)){ const float dl=__builtin_fmaxf(rm,0.f); mhat+=dl; \
        _Pragma("unroll") for(int r=0;r<16;++r){C0[r]-=dl;C1[r]-=dl;} \
        _Pragma("unroll") for(int r=0;r<16;++r)negm[r]=-mhat; asm volatile("":"+v"(negm)); \
        const float f=__builtin_amdgcn_exp2f(-dl); l_reg*=f; if(hi==0)wsf[r32]=f; resc=true; } } \
    SBAR(); \
    GAPB(o[0]=__builtin_amdgcn_mfma_f32_32x32x16_bf16(PAF(0),VFR(0),o[0],0,0,0), C0,0); \
    GAPB(o[1]=__builtin_amdgcn_mfma_f32_32x32x16_bf16(PAF(0),VFR(4),o[1],0,0,0), C0,4); \
    KRD(GL,0); GAPB(o[0]=__builtin_amdgcn_mfma_f32_32x32x16_bf16(PAF(1),VFR(1),o[0],0,0,0), C0,8); \
    KRD(GL,1); GAPB(o[1]=__builtin_amdgcn_mfma_f32_32x32x16_bf16(PAF(1),VFR(5),o[1],0,0,0), C0,12); \
    KRD(GL,2); GAPB(o[0]=__builtin_amdgcn_mfma_f32_32x32x16_bf16(PAF(2),VFR(2),o[0],0,0,0), C1,0); \
    KRD(GL,3); GAPB(o[1]=__builtin_amdgcn_mfma_f32_32x32x16_bf16(PAF(2),VFR(6),o[1],0,0,0), C1,4); \
    GAPB(o[0]=__builtin_amdgcn_mfma_f32_32x32x16_bf16(PAF(3),VFR(3),o[0],0,0,0), C1,8); \
    GAPB(o[1]=__builtin_amdgcn_mfma_f32_32x32x16_bf16(PAF(3),VFR(7),o[1],0,0,0), C1,12); \
    }while(0)
  int t=1;
  for(;t+5<NT;t+=2){
    STEP(pB0,pB1,pA0,pA1,t,true,true,true);     WAIT_BAR(2); RESC(); ROT();
    STEP(pA0,pA1,pB0,pB1,t+1,true,true,true);   WAIT_BAR(2); RESC(); ROT();
  }
  #undef CMASK
  #define CMASK(P0,P1,t) do{ if(BANDED&&(t)>=4) bandmask(P0,P1,kpos0+64*((t)-4),qpos0+qrel,hi); }while(0)
  #define ENDW(tt) do{ if((tt)+3<NT){WAIT_BAR(2);} else if((tt)+2<NT){WAIT_BAR(1);} else {WAIT_BAR(0);} }while(0)
  for(;t+1<NT;t+=2){
    STEP(pB0,pB1,pA0,pA1,t,(t+3<NT),(t+1<NT),(t+1<NT));       ENDW(t);   RESC(); ROT();
    STEP(pA0,pA1,pB0,pB1,t+1,(t+4<NT),(t+2<NT),(t+2<NT));     ENDW(t+1); RESC(); ROT();
  }
  STEP(pB0,pB1,pA0,pA1,NT-1,false,false,false); RESC();
  { float sacc=pB0[0]+pB0[1]; _Pragma("unroll") for(int r=2;r<16;++r)sacc+=pB0[r]; _Pragma("unroll") for(int r=0;r<16;++r)sacc+=pB1[r]; l_reg+=sacc;
    pw0=(u32x4){PKW(pB0,0),PKW(pB0,2),PKW(pB0,4),PKW(pB0,6)};pw1=(u32x4){PKW(pB0,8),PKW(pB0,10),PKW(pB0,12),PKW(pB0,14)};pw2=(u32x4){PKW(pB1,0),PKW(pB1,2),PKW(pB1,4),PKW(pB1,6)};pw3=(u32x4){PKW(pB1,8),PKW(pB1,10),PKW(pB1,12),PKW(pB1,14)};
    SBAR(); pv(o,vb0+sl_cur,PAF(0),PAF(1),PAF(2),PAF(3)); }
  #undef PKW
  #undef PAF
  #undef VFR
  #undef PIN
  #undef MX3
  #undef GAPA
  #undef GAPB
  #undef EX
  #undef VRD
  #undef KRD
  #undef STEP
  #undef ENDW
  {auto rr=__builtin_amdgcn_permlane32_swap(__float_as_uint(l_reg),__float_as_uint(l_reg),false,false);l_reg=__uint_as_float(rr[0])+__uint_as_float(rr[1]);}
  if(BANDED) l_reg+=__builtin_amdgcn_exp2f(sink_l2-mhat);
  if(hi==0)wsf[32+r32]=l_reg;asm volatile("s_waitcnt lgkmcnt(0)":::"memory");
  float rli[16];
  #pragma unroll
  for(int r=0;r<16;++r)rli[r]=__builtin_amdgcn_rcpf(wsf[32+crow(r,hi)]);
  bf16*Ow=Orows+(long)(wid*QBLK)*OP;
  { bf16*stg=(bf16*)(shm+LDS_OST)+wid*2048;
    #pragma unroll
    for(int r=0;r<16;++r){const int orow=crow(r,hi);
      #pragma unroll
      for(int d0=0;d0<2;++d0)stg[orow*64+d0*32+r32]=__float2bfloat16(o[d0][r]*rli[r]);}
    asm volatile("s_waitcnt lgkmcnt(0)":::"memory");
    #pragma unroll
    for(int i=0;i<4;++i){const int row=i*8+(lane>>3),ch=lane&7; const u32x4 v=*(const u32x4*)(stg+row*64+ch*8); ATTN_STORE16(Ow+(long)row*OP+ch*8,v);} }
  asm volatile("s_waitcnt lgkmcnt(0)\n\ts_barrier":::"memory");
  #undef DMA_K
  #undef DMA_V
  #undef CMASK
  #undef START
  #undef RESC
  #undef ROT
}
constexpr int ATTN_LDS_BYTES=LDS_BYTES;
#undef SBAR
#undef WAIT_BAR
}

#define LAS __attribute__((address_space(3)))
typedef unsigned short bf16;
typedef unsigned v4u __attribute__((ext_vector_type(4)));
typedef float f32x4 __attribute__((ext_vector_type(4)));

constexpr int DM = 1024, NBATCH = 4, SEQ = 8192, CTXL = 256;
constexpr int ML = NBATCH * SEQ, MC = NBATCH * CTXL, MT = ML + MC;
constexpr int ZW = 2560, FF = 2816, FF2 = 5632, CW = 512, NFFT = 16384;
constexpr int NTHR = 512;
constexpr size_t MiB = 1u << 20;
constexpr size_t WS_MOD = 0;
constexpr size_t WS_TW = 256 * 1024;
constexpr size_t WS_ROPE = 320 * 1024;
constexpr size_t WS_FSUMC = 384 * 1024;
constexpr size_t WS_BAR = 448 * 1024;
constexpr size_t WS_FSUM = 1 * MiB;
constexpr size_t WS_KC = 2 * MiB;
constexpr size_t WS_UC = 3 * MiB;
constexpr size_t WS_WB = 5 * MiB;
constexpr size_t WB_IN = 0, WB_OUT = 5 * MiB, WB_UP = 7 * MiB, WB_DOWN = 18 * MiB, WB_LAYER = 23 * MiB + 512 * 1024;
constexpr size_t WS_XC = 52 * MiB;
constexpr size_t WS_XN = 56 * MiB;
constexpr size_t WS_Z = 122 * MiB;
constexpr size_t WS_OC = 287 * MiB;
constexpr size_t WS_UT = 353 * MiB;
constexpr size_t WS_KF = 417 * MiB;
constexpr size_t WS_AV = 122 * MiB;
constexpr size_t WS_G = 309 * MiB;
constexpr size_t WS_END = 481 * MiB;
constexpr int LDS_BYTES = 147456;

__device__ __forceinline__ unsigned f2bf(float f) { unsigned u = __builtin_bit_cast(unsigned, f); return (u + 0x7fffu + ((u >> 16) & 1u)) >> 16; }
__device__ __forceinline__ unsigned pk2(float lo, float hi) { return f2bf(lo) | (f2bf(hi) << 16); }
__device__ __forceinline__ float bflo(unsigned w) { return __builtin_bit_cast(float, w << 16); }
__device__ __forceinline__ float bfhi(unsigned w) { return __builtin_bit_cast(float, w & 0xffff0000u); }
__device__ __forceinline__ void unpack8(const v4u w, float* f) { f[0] = bflo(w.x); f[1] = bfhi(w.x); f[2] = bflo(w.y); f[3] = bfhi(w.y); f[4] = bflo(w.z); f[5] = bfhi(w.z); f[6] = bflo(w.w); f[7] = bfhi(w.w); }
__device__ __forceinline__ v4u pack8(const float* f) { v4u o; o.x = pk2(f[0], f[1]); o.y = pk2(f[2], f[3]); o.z = pk2(f[4], f[5]); o.w = pk2(f[6], f[7]); return o; }
__device__ __forceinline__ float wave_sum(float v) {
#pragma unroll
    for (int o = 1; o < 64; o <<= 1) v += __shfl_xor(v, o);
    return v;
}

struct EpiStoreBf16 {
    static constexpr bool PERM = true, AFTER_DRAIN = false;
    bf16* O; int ldc;
    __device__ __forceinline__ void operator()(const pg8::f32x4 (&acc)[2][2][4][2], const pg8::Unit& u, int wr, int wc, int fr, int fq) const {
        const int row0 = u.pm * 256 + wr * 64 + fr, col0 = u.pn * 256 + wc * 32 + 8 * fq;
#pragma unroll
        for (int ai = 0; ai < 2; ++ai)
#pragma unroll
            for (int m = 0; m < 4; ++m) { bf16* rowp = O + (size_t)(row0 + ai * 128 + m * 16) * ldc + col0;
#pragma unroll
                for (int bj = 0; bj < 2; ++bj) { const pg8::f32x4 v0 = acc[ai][bj][m][0], v1 = acc[ai][bj][m][1]; v4u w;
                    w.x = pg8::cvt_pk_bf16(v0[0], v0[1]); w.y = pg8::cvt_pk_bf16(v0[2], v0[3]); w.z = pg8::cvt_pk_bf16(v1[0], v1[1]); w.w = pg8::cvt_pk_bf16(v1[2], v1[3]);
                    *(v4u*)(rowp + bj * 128) = w; } }
    }
};
struct EpiRes {
    static constexpr bool PERM = true, AFTER_DRAIN = false;
    const float* srcL; float* dstL; const float* srcC; float* dstC; const float* gate; int pm0;
    __device__ __forceinline__ void operator()(const pg8::f32x4 (&acc)[2][2][4][2], const pg8::Unit& u, int wr, int wc, int fr, int fq) const {
        const int pm = u.pm + pm0; const float* src; float* dst; const float* g; int rbase;
        if (pm < 128) { src = srcL; dst = dstL; g = gate + (pm >> 5) * 6144; rbase = pm * 256; } else { src = srcC; dst = dstC; g = gate + 4 * 6144; rbase = (pm - 128) * 256; }
        const int row0 = rbase + wr * 64 + fr, col0 = u.pn * 256 + wc * 32 + 8 * fq;
        f32x4 gv[2][2];
#pragma unroll
        for (int bj = 0; bj < 2; ++bj)
#pragma unroll
            for (int n = 0; n < 2; ++n) gv[bj][n] = *(const f32x4*)(g + col0 + bj * 128 + 4 * n);
#pragma unroll
        for (int ai = 0; ai < 2; ++ai)
#pragma unroll
            for (int m = 0; m < 4; ++m) { const size_t p = (size_t)(row0 + ai * 128 + m * 16) * DM + col0;
#pragma unroll
                for (int bj = 0; bj < 2; ++bj)
#pragma unroll
                    for (int n = 0; n < 2; ++n) { f32x4 v = *(const f32x4*)(src + p + bj * 128 + 4 * n); v = v + gv[bj][n] * acc[ai][bj][m][n]; *(f32x4*)(dst + p + bj * 128 + 4 * n) = v; } }
    }
};

__device__ __forceinline__ void transpose_item(const float* W, int K, int N, bf16* WT, int kb, int nb, int rbase, LAS float* scr, int lane) {
    const int k0 = 64 * kb, n0 = 32 * nb;
#pragma unroll 8
    for (int i = 0; i < 32; ++i) { const int kk = 2 * i + (lane >> 5); scr[kk * 33 + (lane & 31)] = W[(size_t)(k0 + kk) * N + n0 + (lane & 31)]; }
    asm volatile("s_waitcnt lgkmcnt(0)" ::: "memory");
    const int c = lane & 7;
#pragma unroll
    for (int j = 0; j < 4; ++j) { const int n = (lane >> 3) + 8 * j; const LAS float* s = scr + (8 * c) * 33 + n;
        v4u o; o.x = pk2(s[0 * 33], s[1 * 33]); o.y = pk2(s[2 * 33], s[3 * 33]); o.z = pk2(s[4 * 33], s[5 * 33]); o.w = pk2(s[6 * 33], s[7 * 33]);
        *(v4u*)(WT + (size_t)(rbase + n) * K + k0 + 8 * c) = o; }
    asm volatile("s_waitcnt lgkmcnt(0)" ::: "memory");
}
constexpr int TI_IN = 16 * 80, TI_OUT = 16 * 32, TI_UP = 16 * 176, TI_DOWN = 44 * 32, TI_LAYER = TI_IN + TI_OUT + TI_UP + TI_DOWN;
__device__ __forceinline__ void p0_weights(const float* w_in, const float* w_out, const float* w_up, const float* w_down, unsigned char* wb, LAS float* scr, int gw, int ngw, int lane) {
    for (int it = gw; it < 2 * TI_LAYER; it += ngw) {
        const int l = it / TI_LAYER; int r = it % TI_LAYER; unsigned char* base = wb + (size_t)l * WB_LAYER;
        if (r < TI_IN) { transpose_item(w_in + (size_t)l * DM * ZW, DM, ZW, (bf16*)(base + WB_IN), r / 80, r % 80, 32 * (r % 80), scr, lane); continue; } r -= TI_IN;
        if (r < TI_OUT) { transpose_item(w_out + (size_t)l * DM * DM, DM, DM, (bf16*)(base + WB_OUT), r / 32, r % 32, 32 * (r % 32), scr, lane); continue; } r -= TI_OUT;
        if (r < TI_UP) { const int nb = r % 176, n0 = 32 * nb; const int m = n0 < FF ? n0 : n0 - FF; const int rb = (m / 128) * 256 + (n0 < FF ? 0 : 128) + (m % 128);
            transpose_item(w_up + (size_t)l * DM * FF2, DM, FF2, (bf16*)(base + WB_UP), r / 176, nb, rb, scr, lane); continue; } r -= TI_UP;
        transpose_item(w_down + (size_t)l * FF * DM, FF, DM, (bf16*)(base + WB_DOWN), r / 32, r % 32, 32 * (r % 32), scr, lane);
    }
}
__device__ __forceinline__ void p0_mod_item(const float* c, const float* c_ctx, const float* ada_w, const float* ada_b, float* mod, LAS float* L, int item, int tid) {
    const int l = item / 96, n0 = (item % 96) * 64, wave = tid >> 6, lane = tid & 63;
    LAS float* sl = L; LAS float* red = L + 5 * 1024;
    for (int i = tid; i < 5 * 1024; i += NTHR) { const int r = i >> 10, k = i & 1023; const float v = r < 4 ? c[r * 1024 + k] : c_ctx[k]; sl[i] = v / (1.f + expf(-v)); }
    __syncthreads();
    float acc[5] = {0.f, 0.f, 0.f, 0.f, 0.f};
    const float* w = ada_w + (size_t)l * DM * 6144 + n0 + lane;
#pragma unroll 8
    for (int k = wave * 128; k < wave * 128 + 128; ++k) { const float wv = w[(size_t)k * 6144];
#pragma unroll
        for (int r = 0; r < 5; ++r) acc[r] += sl[r * 1024 + k] * wv; }
#pragma unroll
    for (int r = 0; r < 5; ++r) red[(wave * 5 + r) * 64 + lane] = acc[r];
    __syncthreads();
    if (tid < 320) { const int r = tid >> 6; float s = 0.f;
#pragma unroll
        for (int w8 = 0; w8 < 8; ++w8) s += red[(w8 * 5 + r) * 64 + lane];
        mod[(size_t)(l * 5 + r) * 6144 + n0 + lane] = s + ada_b[l * 6144 + n0 + lane]; }
    __syncthreads();
}
template <bool CTXF>
__device__ __forceinline__ void p0_filter_item(const float* w1, const float* b1, const float* w2, const float* b2, const float* w3, const float* b3, const float* w4, const float* freq,
                                               float* KT, float* FS, LAS float* L, int chunk, int tid) {
    constexpr int n = CTXF ? 256 : 8192; const int t0 = chunk * 32;
    LAS float* feats = L; LAS float* h1 = L + 32 * 36; LAS float* h2 = h1 + 2048; LAS float* h3 = h2 + 2048; LAS float* T = L + 8192;
    for (int i = tid; i < 32 * 33; i += NTHR) { const int tap = i / 33, e = i % 33, t = t0 + tap; float val;
        if (e == 0) val = (float)t / (float)(n - 1);
        else { const int j = (e - 1) & 15; const float f = 1e-4f + (float)j * ((15.0f - 1e-4f) / 15.0f); float sn, cs; sincospif(f * (2.0f * (float)t / (float)n), &sn, &cs); val = e <= 16 ? cs : -sn; }
        feats[tap * 36 + e] = val; }
    __syncthreads();
    const int tap4 = tid >> 4, jb = tid & 15;
    { float s4[4];
#pragma unroll
      for (int i = 0; i < 4; ++i) s4[i] = b1[jb + 16 * i];
#pragma unroll 3
      for (int e = 0; e < 33; ++e) { const float fv = feats[tap4 * 36 + e];
#pragma unroll
          for (int i = 0; i < 4; ++i) s4[i] += fv * w1[e * 64 + jb + 16 * i]; }
#pragma unroll
      for (int i = 0; i < 4; ++i) h1[tap4 * 64 + jb + 16 * i] = sinf(freq[jb + 16 * i] * s4[i]); }
    __syncthreads();
    { float s4[4];
#pragma unroll
      for (int i = 0; i < 4; ++i) s4[i] = b2[jb + 16 * i];
#pragma unroll 4
      for (int e = 0; e < 64; ++e) { const float fv = h1[tap4 * 64 + e];
#pragma unroll
          for (int i = 0; i < 4; ++i) s4[i] += fv * w2[e * 64 + jb + 16 * i]; }
#pragma unroll
      for (int i = 0; i < 4; ++i) h2[tap4 * 64 + jb + 16 * i] = sinf(freq[jb + 16 * i] * s4[i]); }
    __syncthreads();
    { float s4[4];
#pragma unroll
      for (int i = 0; i < 4; ++i) s4[i] = b3[jb + 16 * i];
#pragma unroll 4
      for (int e = 0; e < 64; ++e) { const float fv = h2[tap4 * 64 + e];
#pragma unroll
          for (int i = 0; i < 4; ++i) s4[i] += fv * w3[e * 64 + jb + 16 * i]; }
#pragma unroll
      for (int i = 0; i < 4; ++i) h3[tap4 * 64 + jb + 16 * i] = sinf(freq[jb + 16 * i] * s4[i]); }
    __syncthreads();
    float af[32], ab[32];
#pragma unroll
    for (int t = 0; t < 32; ++t) { af[t] = 0.f; ab[t] = 0.f; }
#pragma unroll 2
    for (int k = 0; k < 64; ++k) { const float wa = w4[k * 1024 + tid], wb = w4[k * 1024 + 512 + tid];
#pragma unroll
        for (int t = 0; t < 32; ++t) { const float h = h3[t * 64 + k]; af[t] += h * wa; ab[t] += h * wb; } }
    const float delta = 3.0701134573253944f + (float)tid * (12.280453829301577f / 511.f);
    float sf = 0.f, sb = 0.f;
#pragma unroll
    for (int t = 0; t < 32; ++t) { const float t01 = (float)(t0 + t) * (1.0f / (float)(n - 1)); const float win = __expf(-t01 * delta) + 0.05f;
        af[t] *= win; ab[t] *= win; sf += fabsf(af[t]); if (t0 + t > 0) sb += fabsf(ab[t]); }
    FS[chunk * 1024 + tid] = sf; FS[chunk * 1024 + 512 + tid] = sb;
    const int wave = tid >> 6, lane = tid & 63, cc = lane >> 5, tp = lane & 31, tt = t0 + tp;
#pragma unroll
    for (int t = 0; t < 32; ++t) T[tid * 33 + t] = af[t];
    __syncthreads();
#pragma unroll 1
    for (int cp = 0; cp < 32; ++cp) { const int c = wave * 64 + 2 * cp + cc; const float v = T[c * 33 + tp];
        if (CTXF) KT[(size_t)(255 + tt) * 512 + c] = v; else KT[(size_t)c * NFFT + tt] = v; }
    __syncthreads();
#pragma unroll
    for (int t = 0; t < 32; ++t) T[tid * 33 + t] = ab[t];
    __syncthreads();
#pragma unroll 1
    for (int cp = 0; cp < 32; ++cp) { const int c = wave * 64 + 2 * cp + cc; const float v = T[c * 33 + tp];
        if (tt > 0) { if (CTXF) KT[(size_t)(255 - tt) * 512 + c] = v; else KT[(size_t)c * NFFT + NFFT - tt] = v; } }
    if (!CTXF && chunk == 0) KT[(size_t)tid * NFFT + 8192] = 0.f;
    __syncthreads();
}

typedef float f32x2v __attribute__((ext_vector_type(2)));
constexpr int FFT_LDS_ELEMS = NFFT + NFFT / 32;
__device__ __forceinline__ int pidx(int i) { return i + (i >> 5); }
template <int S, int LOGR, bool INV>
__device__ __forceinline__ void fft_super(LAS f32x2v* buf, const f32x2v* __restrict__ TW, int tid) {
    constexpr int R = 1 << LOGR, BS = NFFT >> S, STR = BS / R, NG = NFFT / R;
    for (int g = tid; g < NG; g += NTHR) {
        const int lo = g % STR, hi = g / STR, base = hi * BS + lo;
        f32x2v x[R];
#pragma unroll
        for (int m = 0; m < R; ++m) x[m] = buf[pidx(base + m * STR)];
#pragma unroll
        for (int qq = 0; qq < LOGR; ++qq) {
            const int q = INV ? LOGR - 1 - qq : qq; const int bit = 1 << (LOGR - 1 - q);
#pragma unroll
            for (int m = 0; m < R; ++m) if (!(m & bit)) {
                const int j = (m & (bit - 1)) * STR + lo;
                const f32x2v w = TW[j << (S + q)];
                const f32x2v a = x[m], b = x[m + bit];
                if (!INV) { const f32x2v d = a - b; x[m] = a + b; x[m + bit] = (f32x2v){d.x * w.x - d.y * w.y, d.x * w.y + d.y * w.x}; }
                else { const f32x2v t = (f32x2v){b.x * w.x + b.y * w.y, b.y * w.x - b.x * w.y}; x[m] = a + t; x[m + bit] = a - t; }
            }
        }
#pragma unroll
        for (int m = 0; m < R; ++m) buf[pidx(base + m * STR)] = x[m];
    }
    __syncthreads();
}
__device__ __forceinline__ void fft_fwd(LAS f32x2v* buf, const f32x2v* TW, int tid) { fft_super<0, 4, false>(buf, TW, tid); fft_super<4, 4, false>(buf, TW, tid); fft_super<8, 4, false>(buf, TW, tid); fft_super<12, 2, false>(buf, TW, tid); }
__device__ __forceinline__ void fft_inv(LAS f32x2v* buf, const f32x2v* TW, int tid) { fft_super<12, 2, true>(buf, TW, tid); fft_super<8, 4, true>(buf, TW, tid); fft_super<4, 4, true>(buf, TW, tid); fft_super<0, 4, true>(buf, TW, tid); }

__device__ __forceinline__ void filter_fft_item(const float* KT, const float* FS, f32x2v* KF, const f32x2v* TW, LAS f32x2v* buf, LAS float* misc, int c, int tid) {
    const f32x4* src = (const f32x4*)(KT + (size_t)c * NFFT);
    for (int i = tid; i < NFFT / 4; i += NTHR) { const f32x4 v = src[i];
#pragma unroll
        for (int k = 0; k < 4; ++k) buf[pidx(4 * i + k)] = (f32x2v){v[k], 0.f}; }
    if (tid < 64) { float s = 0.f;
#pragma unroll
        for (int k = 0; k < 4; ++k) { const int ch = tid * 4 + k; s += FS[ch * 1024 + c] + FS[ch * 1024 + 512 + c]; }
        s = wave_sum(s); if (tid == 0) misc[0] = 1.f / (s * (float)NFFT); }
    __syncthreads();
    fft_fwd(buf, TW, tid);
    const float sc = misc[0]; f32x2v* dst = KF + (size_t)c * NFFT;
    for (int i = tid; i < NFFT; i += NTHR) dst[i] = buf[pidx(i)] * sc;
    __syncthreads();
}
__device__ __forceinline__ void conv_fft_item(float* UT, const f32x2v* KF, const f32x2v* TW, const float* bias_d, LAS f32x2v* buf, int item, int tid) {
    const int p = item >> 9, c = item & 511;
    f32x4* u0 = (f32x4*)(UT + ((size_t)(2 * p) * CW + c) * SEQ); f32x4* u1 = (f32x4*)(UT + ((size_t)(2 * p + 1) * CW + c) * SEQ);
    for (int i = tid; i < SEQ / 4; i += NTHR) { const f32x4 a = u0[i], b = u1[i];
#pragma unroll
        for (int k = 0; k < 4; ++k) { buf[pidx(4 * i + k)] = (f32x2v){a[k], b[k]}; buf[pidx(SEQ + 4 * i + k)] = (f32x2v){0.f, 0.f}; } }
    __syncthreads();
    fft_fwd(buf, TW, tid);
    const f32x2v* kf = KF + (size_t)c * NFFT;
    for (int i = tid; i < NFFT; i += NTHR) { const f32x2v k = kf[i], v = buf[pidx(i)]; buf[pidx(i)] = (f32x2v){v.x * k.x - v.y * k.y, v.x * k.y + v.y * k.x}; }
    __syncthreads();
    fft_inv(buf, TW, tid);
    const float bd = bias_d[c];
    for (int i = tid; i < SEQ / 4; i += NTHR) { f32x4 a = u0[i], b = u1[i];
#pragma unroll
        for (int k = 0; k < 4; ++k) { const f32x2v y = buf[pidx(4 * i + k)]; a[k] = y.x + a[k] * bd; b[k] = y.y + b[k] * bd; }
        u0[i] = a; u1[i] = b; }
    __syncthreads();
}

__device__ __forceinline__ void modulate_rows(const float* srcL, const float* srcC, const float* g, const float* mod  , int shoff, bf16* XN, int row_lo, int row_hi, int gw, int ngw, int lane) {
    for (int row = row_lo + gw; row < row_hi; row += ngw) {
        const float* src; const float* mr;
        if (row < ML) { src = srcL + (size_t)row * DM; mr = mod + (row >> 13) * 6144; } else { src = srcC + (size_t)(row - ML) * DM; mr = mod + 4 * 6144; }
        const f32x4* xr = (const f32x4*)src + lane; f32x4 v[4]; float ss = 0.f;
#pragma unroll
        for (int j = 0; j < 4; ++j) { v[j] = xr[64 * j]; ss += (v[j].x * v[j].x + v[j].y * v[j].y) + (v[j].z * v[j].z + v[j].w * v[j].w); }
        const float rinv = 1.0f / sqrtf(wave_sum(ss) * (1.f / DM) + 1e-6f);
        unsigned long long* o8 = (unsigned long long*)(XN + (size_t)row * DM) + lane;
#pragma unroll
        for (int j = 0; j < 4; ++j) { const int col = 4 * lane + 256 * j; const f32x4 gg = *(const f32x4*)(g + col), sh = *(const f32x4*)(mr + shoff + col), sc = *(const f32x4*)(mr + shoff + 1024 + col);
            const f32x4 y = v[j] * rinv * gg * (sc + 1.0f) + sh;
            o8[64 * j] = (unsigned long long)pk2(y.x, y.y) | ((unsigned long long)pk2(y.z, y.w) << 32); }
    }
}
__device__ __forceinline__ void qk_norm_rope(bf16* Z, const float* qn, const float* kn, const f32x2v* ROPE, int blk, int nblk, int tid) {
    constexpr float C2 = 0.125f * 1.4426950408889634f;
    const int j = tid & 7;
    for (int it = blk; it < MT * 12 / 64; it += nblk) {
        const int hr = it * 64 + (tid >> 3), row = hr / 12, head = hr % 12;
        bf16* p = Z + (size_t)row * ZW + head * 64 + 8 * j;
        float x[8]; unpack8(*(const v4u*)p, x);
        float ss = 0.f;
#pragma unroll
        for (int i = 0; i < 8; ++i) ss += x[i] * x[i];
        ss += __shfl_xor(ss, 1); ss += __shfl_xor(ss, 2); ss += __shfl_xor(ss, 4);
        const float rinv = 1.0f / sqrtf(ss * (1.f / 64.f) + 1e-6f);
        const float* gn = (head < 8 ? qn : kn) + 8 * j;
#pragma unroll
        for (int i = 0; i < 8; ++i) x[i] = x[i] * rinv * gn[i];
        float other[8];
#pragma unroll
        for (int i = 0; i < 8; ++i) other[i] = __shfl_xor(x[i], 2);
        if (row < ML) {
            const int t = row & (SEQ - 1), pos = (j >> 2) ? (t & 63) : (t >> 6), jj = j & 3, f0 = (jj & 1) * 8; const bool second = (jj >> 1) != 0;
            const f32x2v* rp = ROPE + pos * 16 + f0;
#pragma unroll
            for (int i = 0; i < 8; ++i) { const f32x2v cs = rp[i]; x[i] = second ? (other[i] * cs.y + x[i] * cs.x) : (x[i] * cs.x - other[i] * cs.y); }
        }
        if (head < 8) {
#pragma unroll
            for (int i = 0; i < 8; ++i) x[i] *= C2;
        }
        *(v4u*)p = pack8(x);
    }
}
__device__ __forceinline__ void hyena_pre(const bf16* Z, const float* cw, const float* cb, bf16* OC, float* UT, float* UC, LAS float* T, int blk, int nblk, int tid) {
    const int tt = tid >> 3, cg8 = (tid & 7) * 8;
    constexpr int NIT = (MT / 64) * 8;
    for (int it = blk; it < NIT; it += nblk) {
        const int rt = it >> 3, c0 = (it & 7) * 64, row = rt * 64 + tt, c = c0 + cg8;
        const bool lat = row < ML; const int tpos = lat ? (row & (SEQ - 1)) : ((row - ML) & (CTXL - 1)); const int slen = lat ? SEQ : CTXL;
        float zc[3][8];
#pragma unroll
        for (int gsel = 0; gsel < 3; ++gsel) {
            const int col = gsel * CW + c; const bf16* zp = Z + (size_t)row * ZW + 1024 + col;
            float a[8], b[8], d[8];
            unpack8(*(const v4u*)zp, b);
            if (tpos > 0) unpack8(*(const v4u*)(zp - ZW), a); else { for (int i = 0; i < 8; ++i) a[i] = 0.f; }
            if (tpos < slen - 1) unpack8(*(const v4u*)(zp + ZW), d); else { for (int i = 0; i < 8; ++i) d[i] = 0.f; }
#pragma unroll
            for (int i = 0; i < 8; ++i) zc[gsel][i] = a[i] * cw[col + i] + b[i] * cw[3 * CW + col + i] + d[i] * cw[6 * CW + col + i] + cb[col + i];
        }
        *(v4u*)(OC + (size_t)row * DM + 512 + c) = pack8(zc[0]);
        float u[8];
#pragma unroll
        for (int i = 0; i < 8; ++i) u[i] = zc[2][i] * zc[1][i];
        if (lat) {
#pragma unroll
            for (int i = 0; i < 8; ++i) T[tt * 65 + cg8 + i] = u[i];
            __syncthreads();
            const int cl = tid >> 3, seg = (tid & 7) * 8, b = row >> 13, tb = (rt * 64) & (SEQ - 1);
            f32x4 o0, o1;
#pragma unroll
            for (int i = 0; i < 4; ++i) { o0[i] = T[(seg + i) * 65 + cl]; o1[i] = T[(seg + 4 + i) * 65 + cl]; }
            float* dst = UT + ((size_t)b * CW + c0 + cl) * SEQ + tb + seg;
            *(f32x4*)dst = o0; *(f32x4*)(dst + 4) = o1;
            __syncthreads();
        } else {
            float* dst = UC + (size_t)(row - ML) * CW + c;
            *(f32x4*)dst = (f32x4){u[0], u[1], u[2], u[3]}; *(f32x4*)(dst + 4) = (f32x4){u[4], u[5], u[6], u[7]};
        }
    }
}
__device__ __forceinline__ void ctx_conv_item(const float* KC, const float* FSC, const float* UC, const float* bias_d, bf16* OC, int item, int tid) {
    const int b = item >> 8, t = item & 255, c = tid;
    float s = 0.f;
#pragma unroll
    for (int ch = 0; ch < 8; ++ch) s += FSC[ch * 1024 + c] + FSC[ch * 1024 + 512 + c];
    const float* ub = UC + (size_t)b * CTXL * CW + c; const float* kc = KC + (size_t)(t + 255) * CW + c;
    float acc = 0.f;
#pragma unroll 8
    for (int sidx = 0; sidx < CTXL; ++sidx) acc += kc[-(long)sidx * CW] * ub[(size_t)sidx * CW];
    bf16* op = OC + (size_t)(ML + b * CTXL + t) * DM + 512 + c;
    const float x0 = __builtin_bit_cast(float, (unsigned)(*op) << 16);
    *op = (bf16)f2bf((acc / s + ub[(size_t)t * CW] * bias_d[c]) * x0);
}
__device__ __forceinline__ void hyena_post(const float* UT, bf16* OC, LAS float* T, int blk, int nblk, int tid) {
    constexpr int NIT = (ML / 64) * 8;
    for (int it = blk; it < NIT; it += nblk) {
        const int rt = it >> 3, c0 = (it & 7) * 64, b = (rt * 64) >> 13, tb = (rt * 64) & (SEQ - 1);
        { const int cl = tid >> 3, seg = (tid & 7) * 8; const float* src = UT + ((size_t)b * CW + c0 + cl) * SEQ + tb + seg;
          const f32x4 o0 = *(const f32x4*)src, o1 = *(const f32x4*)(src + 4);
#pragma unroll
          for (int i = 0; i < 4; ++i) { T[(seg + i) * 65 + cl] = o0[i]; T[(seg + 4 + i) * 65 + cl] = o1[i]; } }
        __syncthreads();
        { const int tt = tid >> 3, cg8 = (tid & 7) * 8; bf16* op = OC + (size_t)(rt * 64 + tt) * DM + 512 + c0 + cg8;
          float x0[8]; unpack8(*(const v4u*)op, x0);
#pragma unroll
          for (int i = 0; i < 8; ++i) x0[i] *= T[tt * 65 + cg8 + i];
          *(v4u*)op = pack8(x0); }
        __syncthreads();
    }
}
__device__ __forceinline__ void short_conv(const bf16* Z, const float* cw, bf16* OC, int blk, int nblk, int tid) {
    const int cg8 = (tid & 63) * 8;
    for (int it = blk; it < ML / 8; it += nblk) {
        const int row = it * 8 + (tid >> 6), t = row & (SEQ - 1);
        const bf16* zp = Z + (size_t)row * ZW + 1024 + cg8;
        float bg[8], c1[8], x1[8], acc[8];
        unpack8(*(const v4u*)zp, bg); unpack8(*(const v4u*)(zp + 512), c1); unpack8(*(const v4u*)(zp + 1024), x1);
#pragma unroll
        for (int i = 0; i < 8; ++i) acc[i] = c1[i] * x1[i] * cw[CW + cg8 + i];
        if (t > 0) { unpack8(*(const v4u*)(zp - ZW + 512), c1); unpack8(*(const v4u*)(zp - ZW + 1024), x1);
#pragma unroll
            for (int i = 0; i < 8; ++i) acc[i] += c1[i] * x1[i] * cw[cg8 + i]; }
        if (t < SEQ - 1) { unpack8(*(const v4u*)(zp + ZW + 512), c1); unpack8(*(const v4u*)(zp + ZW + 1024), x1);
#pragma unroll
            for (int i = 0; i < 8; ++i) acc[i] += c1[i] * x1[i] * cw[2 * CW + cg8 + i]; }
#pragma unroll
        for (int i = 0; i < 8; ++i) acc[i] *= bg[i];
        *(v4u*)(OC + (size_t)row * DM + 512 + cg8) = pack8(acc);
    }
}
__device__ __forceinline__ float gelu_tanh(float x) { const float u = 0.7978845608028654f * (x + 0.044715f * x * x * x); const float e = __expf(2.f * u); const float th = 1.f - 2.f / (e + 1.f); return 0.5f * x * (1.f + th); }
__device__ __forceinline__ void ffn_gate(const bf16* AV, bf16* G, const float* cw, const float* cb, int row0, int nrows, int blk, int nblk, int tid) {
    const int rs = tid >> 5, jl = tid & 31;
    for (int it = blk; it < nrows / 64; it += nblk) {
        const int r0 = it * 64 + rs * 4;
        for (int cbk = 0; cbk < 11; ++cbk) {
            const int j = cbk * 256 + jl * 8;
            const int ca = (j >> 7) * 256 + (j & 127);
            float w0[8], w1[8], w2[8], bb[8];
#pragma unroll
            for (int i = 0; i < 8; ++i) { w0[i] = cw[j + i]; w1[i] = cw[FF + j + i]; w2[i] = cw[2 * FF + j + i]; bb[i] = cb[j + i]; }
            float prev[8], cur[8], nxt[8];
            { const int gr = row0 + r0; const bool lat = gr < ML; const int tpos = lat ? (gr & (SEQ - 1)) : ((gr - ML) & (CTXL - 1));
              if (tpos > 0) unpack8(*(const v4u*)(AV + (size_t)(r0 - 1) * FF2 + ca), prev); else { for (int i = 0; i < 8; ++i) prev[i] = 0.f; } }
            unpack8(*(const v4u*)(AV + (size_t)r0 * FF2 + ca), cur);
#pragma unroll
            for (int rr = 0; rr < 4; ++rr) {
                const int lr = r0 + rr, gr = row0 + lr; const bool lat = gr < ML; const int tpos = lat ? (gr & (SEQ - 1)) : ((gr - ML) & (CTXL - 1)); const int slen = lat ? SEQ : CTXL;
                if (tpos < slen - 1) unpack8(*(const v4u*)(AV + (size_t)(lr + 1) * FF2 + ca), nxt); else { for (int i = 0; i < 8; ++i) nxt[i] = 0.f; }
                float vv[8], o[8]; unpack8(*(const v4u*)(AV + (size_t)lr * FF2 + ca + 128), vv);
#pragma unroll
                for (int i = 0; i < 8; ++i) { const float a = prev[i] * w0[i] + cur[i] * w1[i] + nxt[i] * w2[i] + bb[i]; o[i] = gelu_tanh(a) * vv[i]; }
                *(v4u*)(G + (size_t)lr * FF + j) = pack8(o);
#pragma unroll
                for (int i = 0; i < 8; ++i) { prev[i] = cur[i]; cur[i] = nxt[i]; }
            }
        }
    }
}

#define RLX_AGENT __ATOMIC_RELAXED, __HIP_MEMORY_SCOPE_AGENT

#define XB_TMO      128
#define XB_XCNT(j)  (256  + 64 * (j))
#define XB_XSUB(j)  (1280 + 64 * (j))
#define XB_XGEN(j)  (2304 + 64 * (j))
#define XB_TOP      3328
#define XB_TOPGEN   3392
#define XCD_BAR_WORDS 3456
#define XB_SPIN_CAP (1u << 18)

__device__ __forceinline__ unsigned xb_ld(unsigned* p)              { return __hip_atomic_load(p, __ATOMIC_RELAXED, __HIP_MEMORY_SCOPE_AGENT); }
__device__ __forceinline__ unsigned xb_add(unsigned* p, unsigned v) { return __hip_atomic_fetch_add(p, v, __ATOMIC_RELAXED, __HIP_MEMORY_SCOPE_AGENT); }
__device__ __forceinline__ unsigned xb_xcc_id() { return (unsigned)__builtin_amdgcn_s_getreg((3 << 11) | 20) & 0xFu; }
#define XB_SPIN(cond, bar) do { unsigned _sp = 0; while (cond) { __builtin_amdgcn_s_sleep(1); \
    if ((++_sp & 255u) == 0u) { if (xb_ld(&(bar)[XB_TMO])) break; if (_sp > XB_SPIN_CAP) { atomicAdd(&(bar)[XB_TMO], 1u); break; } } } } while (0)

struct XcdBarrier {
    unsigned* bar; unsigned x;
    volatile LAS unsigned* st;
};

__device__ __forceinline__ XcdBarrier xcd_barrier_post(unsigned* bar, volatile LAS unsigned* st) {
    XcdBarrier b; b.bar = bar; b.x = xb_xcc_id(); b.st = st;
    if (threadIdx.x == 0) (void)xb_add(&bar[XB_XCNT(b.x)], 1u);
    return b;
}
__device__ __forceinline__ void xcd_barrier_complete(unsigned* bar, unsigned x, unsigned& nloc, unsigned& nx) {
    const unsigned G = gridDim.x * gridDim.y * gridDim.z;
    unsigned sum, cnt, mine, sp = 0u;
    for (;;) {
        sum = 0u; cnt = 0u; mine = 0u;
#pragma unroll
        for (unsigned j = 0; j < 16; ++j) { const unsigned c = xb_ld(&bar[XB_XCNT(j)]); sum += c; cnt += (c > 0u) ? 1u : 0u; mine = (j == x) ? c : mine; }
        if (sum == G) break;
        __builtin_amdgcn_s_sleep(1);
        if ((++sp & 255u) == 0u) { if (xb_ld(&bar[XB_TMO])) break; if (sp > XB_SPIN_CAP) { atomicAdd(&bar[XB_TMO], 1u); break; } }
    }
    nloc = mine > 0u ? mine : 1u; nx = cnt > 0u ? cnt : 1u;
}

__device__ __forceinline__ void xcd_barrier(const XcdBarrier& b) {
    asm volatile("s_waitcnt vmcnt(0)" ::: "memory");
    __syncthreads();
    if (threadIdx.x == 0) {
        unsigned* bar = b.bar;
        __builtin_amdgcn_s_waitcnt(0);
        unsigned nloc = b.st[0], nx = b.st[1];
        if (nloc == 0u) { xcd_barrier_complete(bar, b.x, nloc, nx); b.st[0] = nloc; b.st[1] = nx; }
        const unsigned old = xb_add(&bar[XB_XSUB(b.x)], 1u);
        const unsigned gen = old / nloc;
        if (old + 1u == (gen + 1u) * nloc) {
            __builtin_amdgcn_fence(__ATOMIC_RELEASE, "agent");
            asm volatile("s_waitcnt vmcnt(0)" ::: "memory");
            const unsigned og = xb_add(&bar[XB_TOP], 1u);
            const unsigned tg = og / nx;
            if (og + 1u == (tg + 1u) * nx) xb_add(&bar[XB_TOPGEN], 1u);
            else XB_SPIN(xb_ld(&bar[XB_TOPGEN]) == tg, bar);
            __builtin_amdgcn_fence(__ATOMIC_ACQUIRE, "agent");
            xb_add(&bar[XB_XGEN(b.x)], 1u);
            asm volatile("s_waitcnt vmcnt(0)" ::: "memory");
        } else {
            XB_SPIN(xb_ld(&bar[XB_XGEN(b.x)]) == gen, bar);
            __builtin_amdgcn_fence(__ATOMIC_ACQUIRE, "agent");
            asm volatile("s_waitcnt vmcnt(0)" ::: "memory");
        }
    }
    __syncthreads();
}


struct Args { const float* in[29]; float* out; unsigned char* ws; };
enum { I_X = 0, I_C, I_CTX, I_CCTX, I_ADAW, I_ADAB, I_NMIX, I_NFFN, I_WIN, I_WOUT, I_QN, I_KN, I_SINK, I_HCW, I_HCB, I_HW1, I_HB1, I_HW2, I_HB2, I_HW3, I_HB3, I_HW4, I_HFREQ, I_HBIASD, I_SCW, I_WUP, I_FCW, I_FCB, I_WDOWN };

#ifndef PHMASK
#define PHMASK 0xffffffffu
#endif
#define PH(n) ((PHMASK >> (n)) & 1u)
#ifndef DBL
#define DBL 0
#endif
#define REP(b) for (int rep_ = 0; rep_ < (((DBL >> (b)) & 1) ? 2 : 1); ++rep_)
#define GSYNC() do { xcd_barrier(xbar); if (DBL & 1) xcd_barrier(xbar); } while (0)
typedef const float* const __attribute__((address_space(4))) * kargp_t;
#define IDS() int tid = threadIdx.x; asm volatile("" : "+v"(tid)); const int lane = tid & 63, wave = __builtin_amdgcn_readfirstlane(tid >> 6); int bx = blockIdx.x; asm volatile("" : "+s"(bx)); \
    const int gw = bx * 8 + wave, G = gridDim.x, ngw = G * 8; (void)lane; (void)gw; (void)wave; (void)ngw; \
    unsigned long long kb_ = (unsigned long long)__builtin_amdgcn_kernarg_segment_ptr(); asm volatile("" : "+s"(kb_)); const kargp_t KA = (kargp_t)kb_; \
    unsigned char* const ws = (unsigned char*)KA[30]; float* const OUT = (float*)KA[29]; (void)ws; (void)OUT; \
    const bool last = layer == 1; (void)last
#define IN(i) (KA[i])
#define P_MOD ((float*)(ws + WS_MOD))
#define P_TW ((f32x2v*)(ws + WS_TW))
#define P_ROPE ((f32x2v*)(ws + WS_ROPE))
#define P_FSUMC ((float*)(ws + WS_FSUMC))
#define P_FSUM ((float*)(ws + WS_FSUM))
#define P_KC ((float*)(ws + WS_KC))
#define P_UC ((float*)(ws + WS_UC))
#define P_XC ((float*)(ws + WS_XC))
#define P_XN ((bf16*)(ws + WS_XN))
#define P_Z ((bf16*)(ws + WS_Z))
#define P_OC ((bf16*)(ws + WS_OC))
#define P_UT ((float*)(ws + WS_UT))
#define P_KF ((f32x2v*)(ws + WS_KF))
#define P_AV ((bf16*)(ws + WS_AV))
#define P_G ((bf16*)(ws + WS_G))
#define P_MODL (P_MOD + (size_t)layer * 5 * 6144)
#define P_WB (ws + WS_WB + (size_t)layer * WB_LAYER)
#define RES_L (last ? (const float*)OUT : IN(I_X))
#define RES_C (last ? (const float*)P_XC : IN(I_CTX))
__global__ void __launch_bounds__(NTHR, 2) hfb_fwd(Args a) {
    extern __shared__ __attribute__((aligned(16))) unsigned char lds[];
    cg::grid_group grid = cg::this_grid();
    LAS unsigned char* L = (LAS unsigned char*)lds;
    (void)a;
    volatile LAS unsigned* xst = (volatile LAS unsigned*)(L + LDS_BYTES - 64);
    if (threadIdx.x < 2) xst[threadIdx.x] = 0u;
    __syncthreads();
    XcdBarrier xbar;
    { unsigned long long kb0 = (unsigned long long)__builtin_amdgcn_kernarg_segment_ptr(); unsigned char* ws0 = (unsigned char*)((kargp_t)kb0)[30]; xbar = xcd_barrier_post((unsigned*)(ws0 + WS_BAR), xst); }
    { const int layer = 0; IDS(); if (PH(0)) p0_weights(IN(I_WIN), IN(I_WOUT), IN(I_WUP), IN(I_WDOWN), ws + WS_WB, (LAS float*)(L + wave * 16384), gw, ngw, lane);
      __syncthreads(); }
    { const int layer = 0; IDS(); if (PH(1)) for (int it = bx; it < 192 + 20 + 264; it += G) {
        if (it < 192) p0_mod_item(IN(I_C), IN(I_CCTX), IN(I_ADAW), IN(I_ADAB), P_MOD, (LAS float*)L, it, tid);
        else if (it < 208) { const int k = (it - 192) * NTHR + tid; float s, c; sincospif(2.0f * (float)k / (float)NFFT, &s, &c); P_TW[k] = (f32x2v){c, -s}; }
        else if (it < 212) { const int e = (it - 208) * NTHR + tid, pos = e >> 4, f = e & 15; const float inv_pi = exp2f(-(float)f * 0.8304820237218406f) * 0.3183098861837907f; float sn, cs; sincospif((float)pos * inv_pi, &sn, &cs); P_ROPE[e] = (f32x2v){cs, sn}; }
        else if (it < 212 + 256) p0_filter_item<false>(IN(I_HW1), IN(I_HB1), IN(I_HW2), IN(I_HB2), IN(I_HW3), IN(I_HB3), IN(I_HW4), IN(I_HFREQ), P_UT, P_FSUM, (LAS float*)L, it - 212, tid);
        else p0_filter_item<true>(IN(I_HW1), IN(I_HB1), IN(I_HW2), IN(I_HB2), IN(I_HW3), IN(I_HB3), IN(I_HW4), IN(I_HFREQ), P_KC, P_FSUMC, (LAS float*)L, it - 468, tid);
    } }
    grid.sync();

#pragma unroll 1
    for (int layer = 0; layer < 2; ++layer) {
        { IDS(); if (PH(2)) if (!last) REP(2) for (int c = bx; c < CW; c += G) filter_fft_item(P_UT, P_FSUM, P_KF, P_TW, (LAS f32x2v*)L, (LAS float*)(L + FFT_LDS_ELEMS * 8), c, tid);
          if (PH(3)) REP(3) modulate_rows(RES_L, RES_C, IN(I_NMIX) + layer * DM, P_MODL, 0, P_XN, 0, MT, gw, ngw, lane); }
        GSYNC();
        { IDS(); if (PH(4)) REP(6) { pg8::Gemm g{P_XN, (const bf16*)(P_WB + WB_IN), MT, ZW, DM}; pg8::StaticOrder S; S.init(MT, ZW, G, bx); EpiStoreBf16 E{P_Z, ZW};
          pg8::gemm_phase<EpiStoreBf16, pg8::StaticOrder, true, true>(L, g, S, E); } }
        GSYNC();
        { IDS(); if (PH(5)) qk_norm_rope(P_Z, IN(I_QN) + layer * 64, IN(I_KN) + layer * 64, P_ROPE, bx, G, tid);
          if (PH(6)) { if (!last) hyena_pre(P_Z, IN(I_HCW), IN(I_HCB), P_OC, P_UT, P_UC, (LAS float*)L, bx, G, tid);
                       else short_conv(P_Z, IN(I_SCW), P_OC, bx, G, tid); } }
        GSYNC();
        if (layer == 0) {
            { IDS(); if (PH(7)) for (int it = bx; it < 1024; it += G) conv_fft_item(P_UT, P_KF, P_TW, IN(I_HBIASD), (LAS f32x2v*)L, it, tid);
              if (PH(8)) for (int it = bx; it < 1024; it += G) ctx_conv_item(P_KC, P_FSUMC, P_UC, IN(I_HBIASD), P_OC, it, tid);
              __syncthreads(); }
            { IDS(); const int vcu = (G % 8 == 0) ? (bx % 8) * (G / 8) + bx / 8 : bx;
              if (PH(9)) REP(1) for (int i = 0; i < 5; ++i) {
                const int u = i * 256 + vcu; if (i == 4 && vcu >= 32) break;
                const attn_body::bf16* Zb = (const attn_body::bf16*)P_Z; attn_body::bf16* Ob = (attn_body::bf16*)P_OC;
                int b, h, NT; size_t qrow, lrow;
                if (i < 4) { const int bh = u >> 5, qb = u & 31; b = bh >> 3; h = bh & 7; qrow = (size_t)b * SEQ + qb * 256; lrow = (size_t)b * SEQ; NT = 4 + SEQ / 64; }
                else { b = vcu >> 3; h = vcu & 7; qrow = (size_t)ML + b * CTXL; lrow = qrow; NT = 4; }
                const int kvh = h >> 1; const size_t crow = (size_t)ML + b * CTXL;
                attn_body::attn_unit<8, false>(Zb + qrow * ZW + h * 64, Zb + crow * ZW + 512 + kvh * 64, Zb + lrow * ZW + 512 + kvh * 64, Zb + crow * ZW + 768 + kvh * 64, Zb + lrow * ZW + 768 + kvh * 64,
                                               Ob + qrow * DM + h * 64, NT, 0, 0, 0.f, (char*)lds);
              } }
        } else {
            { IDS(); const int vcu = (G % 8 == 0) ? (bx % 8) * (G / 8) + bx / 8 : bx;
              if (PH(10)) for (int i = 0; i < 4; ++i) {
                const int u = i * 256 + vcu, bh = u >> 5, qb = u & 31, b = bh >> 3, h = bh & 7, kvh = h >> 1;
                const int q0 = qb * 256, klo = q0 - 128 < 0 ? 0 : q0 - 128, khi = q0 + 384 > SEQ ? SEQ : q0 + 384;
                const size_t qrow = (size_t)b * SEQ + q0, crow = (size_t)ML + b * CTXL, lrow = (size_t)b * SEQ + klo;
                const attn_body::bf16* Zb = (const attn_body::bf16*)P_Z; attn_body::bf16* Ob = (attn_body::bf16*)P_OC;
                attn_body::attn_unit<8, true>(Zb + qrow * ZW + h * 64, Zb + crow * ZW + 512 + kvh * 64, Zb + lrow * ZW + 512 + kvh * 64, Zb + crow * ZW + 768 + kvh * 64, Zb + lrow * ZW + 768 + kvh * 64,
                                              Ob + qrow * DM + h * 64, 4 + (khi - klo) / 64, q0, klo, IN(I_SINK)[h] * 1.4426950408889634f, (char*)lds);
              } }
        }
        GSYNC();
        if (layer == 0) { { IDS(); if (PH(11)) hyena_post(P_UT, P_OC, (LAS float*)L, bx, G, tid); } GSYNC(); }
        { IDS(); const int mrows = last ? ML : MT;
          if (PH(12)) { pg8::Gemm g{P_OC, (const bf16*)(P_WB + WB_OUT), mrows, DM, DM}; pg8::StaticOrder S; S.init(mrows, DM, G, bx);
          EpiRes E{RES_L, OUT, RES_C, P_XC, P_MODL + 2 * 1024, 0};
          pg8::gemm_phase<EpiRes, pg8::StaticOrder, true, true>(L, g, S, E); } }
        GSYNC();
        { IDS(); const int mrows = last ? ML : MT; if (PH(13)) REP(3) modulate_rows(OUT, P_XC, IN(I_NFFN) + layer * DM, P_MODL, 3 * 1024, P_XN, 0, mrows, gw, ngw, lane); }
        GSYNC();
#pragma unroll 1
        for (int half = 0; half < 2; ++half) {
#define HALF_GEOM() const int mrows = last ? ML : MT; const int t_lo = half * 64, t_hi = half == 0 ? 64 : mrows / 256, nrows = (t_hi - t_lo) * 256, row0 = t_lo * 256; (void)row0
            { IDS(); HALF_GEOM(); if (PH(14)) REP(4) { pg8::Gemm g{P_XN + (size_t)row0 * DM, (const bf16*)(P_WB + WB_UP), nrows, FF2, DM}; pg8::StaticOrder S; S.init(nrows, FF2, G, bx); EpiStoreBf16 E{P_AV, FF2};
              pg8::gemm_phase<EpiStoreBf16, pg8::StaticOrder, true, true>(L, g, S, E); } }
            GSYNC();
            { IDS(); HALF_GEOM(); if (PH(15)) REP(5) ffn_gate(P_AV, P_G, IN(I_FCW) + (size_t)layer * 3 * FF, IN(I_FCB) + (size_t)layer * FF, row0, nrows, bx, G, tid); }
            GSYNC();
            { IDS(); HALF_GEOM(); if (PH(16)) { pg8::Gemm g{P_G, (const bf16*)(P_WB + WB_DOWN), nrows, DM, FF}; pg8::StaticOrder S; S.init(nrows, DM, G, bx);
              EpiRes E{OUT, OUT, P_XC, P_XC, P_MODL + 5 * 1024, t_lo};
              pg8::gemm_phase<EpiRes, pg8::StaticOrder, true, true>(L, g, S, E); } }
            if (!(layer == 1 && half == 1)) GSYNC();
        }
    }
}

extern "C" void kernel_launch(void* const* d_in, const int* in_sizes, int n_in, void* d_out, int out_size, void* d_ws, size_t ws_size, hipStream_t stream) {
    static int grid = 0;
    if (grid == 0) {
        if (n_in != 29 || out_size != ML * DM || ws_size < WS_END) { fprintf(stderr, "kernel_launch: unexpected shapes (n_in %d, out %d, ws %zu < %zu)\n", n_in, out_size, ws_size, (size_t)WS_END); grid = -1; return; }
        int dev = 0, cus = 0, per_cu = 0;
        hipGetDevice(&dev); hipDeviceGetAttribute(&cus, hipDeviceAttributeMultiprocessorCount, dev);
        if (hipFuncSetAttribute((const void*)hfb_fwd, hipFuncAttributeMaxDynamicSharedMemorySize, LDS_BYTES) != hipSuccess) { fprintf(stderr, "kernel_launch: hipFuncSetAttribute failed\n"); grid = -1; return; }
        if (hipOccupancyMaxActiveBlocksPerMultiprocessor(&per_cu, (const void*)hfb_fwd, NTHR, LDS_BYTES) != hipSuccess || per_cu < 1) { fprintf(stderr, "kernel_launch: occupancy query says %d\n", per_cu); per_cu = 1; }
        (void)hipGetLastError();
        grid = cus;
    }
    if (grid < 0) return;
    if (hipMemsetAsync((char*)d_ws + WS_BAR, 0, XCD_BAR_WORDS * 4, stream) != hipSuccess) { fprintf(stderr, "kernel_launch: memset of the barrier words failed\n"); return; }
    Args a{};
    for (int i = 0; i < 29; ++i) a.in[i] = (const float*)d_in[i];
    a.out = (float*)d_out; a.ws = (unsigned char*)d_ws;
    void* args[] = {&a};
    hipError_t e = hipLaunchCooperativeKernel((const void*)hfb_fwd, dim3(grid), dim3(NTHR), args, LDS_BYTES, stream);
    if (e != hipSuccess) fprintf(stderr, "cooperative launch failed: %s (grid %d)\n", hipGetErrorString(e), grid);
}
```

```cpp
#include <hip/hip_runtime.h>
#include <hip/hip_cooperative_groups.h>
#include <hip/hip_bf16.h>
#include <cstdio>
#include <cstdint>
#include <cmath>
namespace cg = cooperative_groups;
namespace pg8 {
#define PG8_LAS __attribute__((address_space(3)))
typedef unsigned short bf16_t;
typedef short bf16x8 __attribute__((ext_vector_type(8)));
typedef float f32x4 __attribute__((ext_vector_type(4)));
typedef unsigned u32x4 __attribute__((ext_vector_type(4)));
constexpr int BM = 256, BK = 64, HALF = 128, HTB = HALF * BK * 2  , STAGE_BYTES = 8 * HTB, NXCD = 8, WGM = 8;

__host__ __device__ __forceinline__ int lds_byte(int r, int c) { const int st = (r >> 4) * 2 + (c >> 5), rr = r & 15, cc = c & 31, ob = rr * 64 + cc * 2; return st * 1024 + (ob ^ (((ob >> 9) & 1) << 5)); }
__host__ __device__ __forceinline__ void stage_rc(int b, int& R, int& C) { const int st = b / 1024, sb = b % 1024, swz = sb ^ (((sb >> 9) & 1) << 5); R = (st >> 1) * 16 + swz / 64; C = (st & 1) * 32 + (swz % 64) / 2; }
__host__ __device__ __forceinline__ int perm32(int rho) { const int n = rho >> 4, i = rho & 15; return 8 * (i >> 2) + 4 * n + (i & 3); }

struct Unit { int pm, pn; };
struct Gemm { const bf16_t* A; const bf16_t* Bt; int M, N, K; };

struct StaticOrder {
    int nM, nN, nwg, G, c;
    __host__ __device__ void init(int M, int N, int G_, int c_) { nM = M / BM; nN = N / BM; nwg = nM * nN; G = G_; c = c_; }
    __host__ __device__ bool next(int i, Unit& u) const {
        const long L = (long)i * G + c; if (L >= nwg) return false;
        int wgid = (int)L; { const int q = nwg / NXCD, r = nwg % NXCD, xcd = wgid % NXCD, off = wgid / NXCD; wgid = (xcd < r ? xcd * (q + 1) : r * (q + 1) + (xcd - r) * q) + off; }
        const int nig = WGM * nN, gid = wgid / nig, fm = gid * WGM, gsz = (nM - fm) < WGM ? (nM - fm) : WGM;
        u.pm = fm + ((wgid % nig) % gsz); u.pn = (wgid % nig) / gsz; return true;
    }
    __device__ __forceinline__ void a_ready(const Unit&) const {}
    __device__ __forceinline__ void done(const Unit&) const {}
};

__device__ __forceinline__ unsigned cvt_pk_bf16(float lo, float hi) { unsigned r; asm volatile("v_cvt_pk_bf16_f32 %0, %1, %2" : "=v"(r) : "v"(lo), "v"(hi)); return r; }
template <class Epi, class Sched, bool ALIGN_EPI = false, bool SP2 = false>
__device__ __forceinline__ void gemm_phase(PG8_LAS unsigned char* lds, const Gemm g, const Sched& S, const Epi& E) {
    int tid_o = threadIdx.x; asm volatile("" : "+v"(tid_o));
    const int tid = tid_o, wid = __builtin_amdgcn_readfirstlane(tid >> 6), lane = tid & 63, wr = wid >> 2, wc = wid & 3, fr = lane & 15, fq = lane >> 4;
    const int K = g.K, nt = K / BK;
    unsigned voffA[2], voffB[2];
#pragma unroll
    for (int i = 0; i < 2; ++i) { int R, C; stage_rc(tid * 16 + i * 8192, R, C); const int Rb = Epi::PERM ? ((R & ~31) + perm32(R & 31)) : R;
        voffA[i] = (unsigned)(R * K + C) * 2u; voffB[i] = (unsigned)(Rb * K + C) * 2u; }
    const size_t kstep = (size_t)(BK * 2);
    const size_t hstep = (size_t)HALF * K * 2;
    const size_t tstep = 2 * hstep;
    const unsigned ldsw = (unsigned)wid * 1024u;
    const int aoff = lds_byte(wr * 64 + fr, fq * 8), boff = lds_byte(wc * 32 + fr, fq * 8);
#define PG8_SA(b, h) (((b) * 2 + (h)) * HTB)
#define PG8_SB(b, h) ((4 + (b) * 2 + (h)) * HTB)
#define PG8_STAGE(bufoff, gbase, voff) do { _Pragma("unroll") for (int _i = 0; _i < 2; ++_i) \
        __builtin_amdgcn_global_load_lds((const unsigned*)((const char*)(gbase) + (voff)[_i]), (PG8_LAS unsigned*)(lds + (bufoff) + ldsw + _i * 8192), 16, 0, 0); } while (0)
#define PG8_LDA(dst, b, h) do { _Pragma("unroll") for (int m = 0; m < 4; ++m) _Pragma("unroll") for (int k = 0; k < 2; ++k) dst[m][k] = *(const PG8_LAS bf16x8*)(lds + PG8_SA(b, h) + aoff + m * 2048 + k * 1024); } while (0)
#define PG8_LDB(dst, b, h) do { _Pragma("unroll") for (int n = 0; n < 2; ++n) _Pragma("unroll") for (int k = 0; k < 2; ++k) dst[n][k] = *(const PG8_LAS bf16x8*)(lds + PG8_SB(b, h) + boff + n * 2048 + k * 1024); } while (0)
#define PG8_MMA(ai, bj, At, Bt) do { __builtin_amdgcn_s_setprio(1); _Pragma("unroll") for (int m = 0; m < 4; ++m) _Pragma("unroll") for (int n = 0; n < 2; ++n) _Pragma("unroll") for (int k = 0; k < 2; ++k) \
        acc[ai][bj][m][n] = __builtin_amdgcn_mfma_f32_16x16x32_bf16(Bt[n][k], At[m][k], acc[ai][bj][m][n], 0, 0, 0); __builtin_amdgcn_s_setprio(0); } while (0)
#define PG8_WAIT_V(n) asm volatile("s_waitcnt vmcnt(" #n ")" ::: "memory")
#define PG8_WAIT_L(n) asm volatile("s_waitcnt lgkmcnt(" #n ")" ::: "memory")
#define PG8_BAR __builtin_amdgcn_s_barrier()
#define PG8_SCHED __builtin_amdgcn_sched_barrier(0)
    Unit cur, nxt; int ui = 0;
    if (!S.next(0, cur)) return;
    f32x4 acc[2][2][4][2];
#pragma unroll
    for (int a = 0; a < 2; ++a)
#pragma unroll
        for (int b = 0; b < 2; ++b)
#pragma unroll
            for (int m = 0; m < 4; ++m)
#pragma unroll
                for (int n = 0; n < 2; ++n) acc[a][b][m][n] = (f32x4){0.f, 0.f, 0.f, 0.f};
    bf16x8 At[4][2], B0[2][2], B1[2][2];
    const char* cA = (const char*)g.A + (size_t)cur.pm * tstep; const char* cB = (const char*)g.Bt + (size_t)cur.pn * tstep;
    S.a_ready(cur);
    if constexpr (SP2) {
        PG8_STAGE(PG8_SB(0, 0), cB, voffB); PG8_STAGE(PG8_SB(0, 1), cB + hstep, voffB); PG8_STAGE(PG8_SA(0, 0), cA, voffA); PG8_STAGE(PG8_SA(0, 1), cA + hstep, voffA);
        if (wr == 1) PG8_BAR;
        PG8_WAIT_V(2); PG8_BAR;
        PG8_STAGE(PG8_SB(1, 0), cB + kstep, voffB); PG8_STAGE(PG8_SA(1, 0), cA + kstep, voffA); PG8_STAGE(PG8_SB(1, 1), cB + hstep + kstep, voffB);
        PG8_WAIT_V(6); PG8_BAR;
    } else {
        PG8_STAGE(PG8_SB(0, 0), cB, voffB); PG8_STAGE(PG8_SA(0, 0), cA, voffA); PG8_STAGE(PG8_SB(0, 1), cB + hstep, voffB); PG8_STAGE(PG8_SA(0, 1), cA + hstep, voffA);
        if (wr == 1) PG8_BAR;
        PG8_WAIT_V(4); PG8_BAR;
        PG8_STAGE(PG8_SB(1, 0), cB + kstep, voffB); PG8_STAGE(PG8_SA(1, 0), cA + kstep, voffA); PG8_STAGE(PG8_SB(1, 1), cB + hstep + kstep, voffB);
        PG8_WAIT_V(6); PG8_BAR;
    }
    for (;;) {
        const bool has_next = S.next(ui + 1, nxt);
        const char* nA = has_next ? (const char*)g.A + (size_t)nxt.pm * tstep : cA; const char* nB = has_next ? (const char*)g.Bt + (size_t)nxt.pn * tstep : cB;
        for (int t = 0; t < nt; t += 2) {
            const bool last = (t == nt - 2);
            const char* a1 = cA + (size_t)(t + 1) * kstep;
            const char* a2 = last ? nA : cA + (size_t)(t + 2) * kstep; const char* b2 = last ? nB : cB + (size_t)(t + 2) * kstep;
            const char* a3 = a2 + kstep; const char* b3 = b2 + kstep;
            if (last && has_next) S.a_ready(nxt);
            if constexpr (SP2) {
            PG8_LDB(B0, 0, 0); PG8_LDB(B1, 0, 1); PG8_SCHED; PG8_LDA(At, 0, 0); PG8_STAGE(PG8_SA(1, 1), a1 + hstep, voffA);
            PG8_WAIT_V(8); PG8_WAIT_L(0); PG8_BAR; PG8_MMA(0, 0, At, B0); PG8_MMA(0, 1, At, B1); PG8_BAR; PG8_SCHED;
            PG8_LDA(At, 0, 1); PG8_STAGE(PG8_SB(0, 0), b2, voffB); PG8_STAGE(PG8_SB(0, 1), b2 + hstep, voffB); PG8_STAGE(PG8_SA(0, 0), a2, voffA);
            PG8_WAIT_V(8); PG8_WAIT_L(0); PG8_BAR; PG8_MMA(1, 0, At, B0); PG8_MMA(1, 1, At, B1); PG8_BAR; PG8_SCHED;
            PG8_LDB(B0, 1, 0); PG8_LDB(B1, 1, 1); PG8_SCHED; PG8_LDA(At, 1, 0); PG8_STAGE(PG8_SA(0, 1), a2 + hstep, voffA);
            PG8_WAIT_V(8); PG8_WAIT_L(0); PG8_BAR; PG8_MMA(0, 0, At, B0); PG8_MMA(0, 1, At, B1); PG8_BAR; PG8_SCHED;
            PG8_LDA(At, 1, 1); PG8_STAGE(PG8_SB(1, 0), b3, voffB); PG8_STAGE(PG8_SB(1, 1), b3 + hstep, voffB); PG8_STAGE(PG8_SA(1, 0), a3, voffA);
            PG8_WAIT_V(8); PG8_WAIT_L(0); PG8_BAR; PG8_MMA(1, 0, At, B0); PG8_MMA(1, 1, At, B1); PG8_BAR; PG8_SCHED;
            } else {
            PG8_LDB(B0, 0, 0); PG8_SCHED; PG8_LDA(At, 0, 0); PG8_STAGE(PG8_SA(1, 1), a1 + hstep, voffA);
            PG8_WAIT_L(8); PG8_BAR; PG8_WAIT_L(0); PG8_MMA(0, 0, At, B0); PG8_BAR; PG8_SCHED;
            PG8_LDB(B1, 0, 1); PG8_STAGE(PG8_SB(0, 0), b2, voffB);
            PG8_BAR; PG8_WAIT_L(0); PG8_MMA(0, 1, At, B1); PG8_BAR;
            PG8_LDA(At, 0, 1); PG8_STAGE(PG8_SA(0, 0), a2, voffA);
            PG8_BAR; PG8_WAIT_L(0); PG8_MMA(1, 0, At, B0); PG8_BAR; PG8_SCHED;
            PG8_STAGE(PG8_SB(0, 1), b2 + hstep, voffB);
            PG8_WAIT_V(6); PG8_BAR; PG8_MMA(1, 1, At, B1); PG8_BAR;
            PG8_LDB(B0, 1, 0); PG8_SCHED; PG8_LDA(At, 1, 0); PG8_STAGE(PG8_SA(0, 1), a2 + hstep, voffA);
            PG8_WAIT_L(8); PG8_BAR; PG8_WAIT_L(0); PG8_MMA(0, 0, At, B0); PG8_BAR; PG8_SCHED;
            PG8_LDB(B1, 1, 1); PG8_STAGE(PG8_SB(1, 0), b3, voffB);
            PG8_BAR; PG8_WAIT_L(0); PG8_MMA(0, 1, At, B1); PG8_BAR;
            PG8_LDA(At, 1, 1); PG8_STAGE(PG8_SA(1, 0), a3, voffA);
            PG8_BAR; PG8_WAIT_L(0); PG8_MMA(1, 0, At, B0); PG8_BAR; PG8_SCHED;
            PG8_STAGE(PG8_SB(1, 1), b3 + hstep, voffB);
            PG8_WAIT_V(6); PG8_BAR; PG8_MMA(1, 1, At, B1); PG8_BAR;
            }
        }
        if constexpr (ALIGN_EPI) { if (wr == 0) PG8_BAR; }
        if constexpr (!Epi::AFTER_DRAIN) { E(acc, cur, wr, wc, fr, fq); S.done(cur); }
        if (!has_next) break;
#pragma unroll
        for (int a = 0; a < 2; ++a)
#pragma unroll
            for (int b = 0; b < 2; ++b)
#pragma unroll
                for (int m = 0; m < 4; ++m)
#pragma unroll
                    for (int n = 0; n < 2; ++n) acc[a][b][m][n] = (f32x4){0.f, 0.f, 0.f, 0.f};
        cur = nxt; cA = nA; cB = nB; ++ui;
        if constexpr (ALIGN_EPI) { if (wr == 1) PG8_BAR; }
    }
    PG8_WAIT_V(0);
    if constexpr (!ALIGN_EPI) { if (wr == 0) PG8_BAR; }
    PG8_BAR;
    if constexpr (Epi::AFTER_DRAIN) { E.fused(acc, cur, wr, wc, fr, fq, lds, wid, lane); S.done(cur); }
#undef PG8_SA
#undef PG8_SB
#undef PG8_STAGE
#undef PG8_LDA
#undef PG8_LDB
#undef PG8_MMA
#undef PG8_WAIT_V
#undef PG8_WAIT_L
#undef PG8_BAR
#undef PG8_SCHED
}
}
#include <hip/hip_bf16.h>
#include <cmath>
namespace attn_body {
using bf16=__hip_bfloat16;
using bf16x8=__attribute__((ext_vector_type(8)))short;
using s16x4=__attribute__((ext_vector_type(4)))short;
using f32x16=__attribute__((ext_vector_type(16)))float;
using u32x4=__attribute__((ext_vector_type(4)))unsigned;
constexpr int D=64,ZP=2560,OP=1024;
constexpr int NW=8,QBLK=32,QB=QBLK*NW,KVBLK=64;
__device__ __forceinline__ int crow(int r,int hi){return (r&3)+8*(r>>2)+4*hi;}
#define SBAR() __builtin_amdgcn_sched_barrier(0)
__device__ __forceinline__ void cmask(f32x16&p0,f32x16&p1,int jb,int qrel,int hi){
  const float NEG=-INFINITY; int kb=64*jb+4*hi;
  #pragma unroll
  for(int r=0;r<16;++r){int kv=kb+(r&3)+8*(r>>2); if(kv>qrel)p0[r]=NEG; if(kv+32>qrel)p1[r]=NEG;}
}

__device__ __forceinline__ void bandmask(f32x16&p0,f32x16&p1,int ktile0,int qabs,int hi){
  const float NEG=-INFINITY; const int kb=ktile0+4*hi-qabs;
  #pragma unroll
  for(int r=0;r<16;++r){int d=kb+(r&3)+8*(r>>2); if(d>128||d<-128)p0[r]=NEG; if(d+32>128||d+32<-128)p1[r]=NEG;}
}
constexpr int NSLOT=3, SLOTB=8192;
constexpr int LDS_K=0, LDS_V=NSLOT*SLOTB, LDS_WS=2*NSLOT*SLOTB, LDS_OST=LDS_WS+NW*64*4, LDS_BYTES=LDS_OST+NW*4096;
constexpr float C2=0.125f*1.4426950408889634f;
__device__ __forceinline__ void glds16(const void*gsrc,unsigned lds_dst){unsigned keep;
  asm volatile("s_mov_b32 %0, m0\n\ts_mov_b32 m0, %2\n\ts_nop 0\n\tglobal_load_lds_dwordx4 %1, off\n\ts_mov_b32 m0, %0":"=&s"(keep):"v"(gsrc),"s"(lds_dst):"memory");}
__device__ __forceinline__ float max3f(float a,float b,float c){float r;asm("v_max3_f32 %0, %1, %2, %3":"=v"(r):"v"(a),"v"(b),"v"(c));return r;}
__device__ __forceinline__ float max2f(float a,float b){float r;asm("v_max_f32_e32 %0, %1, %2":"=v"(r):"v"(a),"v"(b));return r;}
__device__ __forceinline__ float fadd_s(float a,float b){float r;asm("v_add_f32_e32 %0, %1, %2":"=v"(r):"v"(a),"v"(b));return r;}
__device__ __forceinline__ float fsub_s(float a,float b){float r;asm("v_sub_f32_e32 %0, %1, %2":"=v"(r):"v"(a),"v"(b));return r;}
typedef float f32x2_t __attribute__((ext_vector_type(2))); typedef __bf16 bf16x2_t __attribute__((ext_vector_type(2)));
__device__ __forceinline__ unsigned cvtpk_s(float lo,float hi){f32x2_t v={lo,hi};bf16x2_t b=__builtin_convertvector(v,bf16x2_t);return __builtin_bit_cast(unsigned,b);}
#define WAIT_BAR(N) asm volatile("s_waitcnt vmcnt(" #N ") lgkmcnt(0)\n\ts_barrier":::"memory")

__device__ __forceinline__ void qkt(f32x16&p0,f32x16&p1,const char*Kslot,const bf16x8*qr,const f32x16&negm,int r32,int hi){
  const char*kb=Kslot+hi*1024+r32*16;
  #pragma unroll
  for(int d0=0;d0<4;++d0){
    const bf16x8 b0=*reinterpret_cast<const bf16x8*>(kb+d0*2048);
    const bf16x8 b1=*reinterpret_cast<const bf16x8*>(kb+d0*2048+512);
    if(d0==0){p0=__builtin_amdgcn_mfma_f32_32x32x16_bf16(b0,qr[0],negm,0,0,0);p1=__builtin_amdgcn_mfma_f32_32x32x16_bf16(b1,qr[0],negm,0,0,0);}
    else{p0=__builtin_amdgcn_mfma_f32_32x32x16_bf16(b0,qr[d0],p0,0,0,0);p1=__builtin_amdgcn_mfma_f32_32x32x16_bf16(b1,qr[d0],p1,0,0,0);}}
}
typedef __attribute__((address_space(3))) const char* lds_cptr;
typedef short v4i16_t __attribute__((ext_vector_type(4)));
__device__ __forceinline__ void kload8(bf16x8*kf,lds_cptr kp){
  kf[0]=*(const __attribute__((address_space(3))) bf16x8*)(kp);      kf[1]=*(const __attribute__((address_space(3))) bf16x8*)(kp+512);
  kf[2]=*(const __attribute__((address_space(3))) bf16x8*)(kp+2048); kf[3]=*(const __attribute__((address_space(3))) bf16x8*)(kp+2560);
  kf[4]=*(const __attribute__((address_space(3))) bf16x8*)(kp+4096); kf[5]=*(const __attribute__((address_space(3))) bf16x8*)(kp+4608);
  kf[6]=*(const __attribute__((address_space(3))) bf16x8*)(kp+6144); kf[7]=*(const __attribute__((address_space(3))) bf16x8*)(kp+6656);
}
__device__ __forceinline__ void kload2(bf16x8*kf,lds_cptr kp,int j){ kf[2*j]=*(const __attribute__((address_space(3))) bf16x8*)(kp+j*2048); kf[2*j+1]=*(const __attribute__((address_space(3))) bf16x8*)(kp+j*2048+512); }
__device__ __forceinline__ s16x4 vtr(lds_cptr p){ return __builtin_bit_cast(s16x4,__builtin_amdgcn_ds_read_tr16_b64_v4i16((__attribute__((address_space(3))) v4i16_t*)p)); }
__device__ __forceinline__ float rowmax(const f32x16&p0,const f32x16&p1){
  float a=max3f(p0[0],p0[1],p1[0]),b=max3f(p0[2],p0[3],p1[1]);a=max3f(a,p1[2],p1[3]);
  #pragma unroll
  for(int r=4;r<16;r+=4){a=max3f(a,p0[r],p0[r+1]);b=max3f(b,p0[r+2],p0[r+3]);a=max3f(a,p1[r],p1[r+1]);b=max3f(b,p1[r+2],p1[r+3]);}
  const float m=max2f(a,b);
  auto rr=__builtin_amdgcn_permlane32_swap(__float_as_uint(m),__float_as_uint(m),false,false);
  return max2f(__uint_as_float(rr[0]),__uint_as_float(rr[1]));
}
__device__ __forceinline__ void pv(f32x16*o,int vb,bf16x8 pa0,bf16x8 pa1,bf16x8 pa2,bf16x8 pa3){
  #pragma unroll
  for(int d0=0;d0<2;++d0){s16x4 lo[4],hi[4];
    #pragma unroll
    for(int ks=0;ks<4;++ks){
      asm volatile("ds_read_b64_tr_b16 %0,%1 offset:%c2":"=&v"(lo[ks]):"v"(vb),"i"(d0*4096+ks*1024):"memory");
      asm volatile("ds_read_b64_tr_b16 %0,%1 offset:%c2":"=&v"(hi[ks]):"v"(vb),"i"(d0*4096+ks*1024+512):"memory");}
    asm volatile("s_waitcnt lgkmcnt(0)":::"memory");SBAR();
    #define PK(k) (bf16x8){lo[k][0],lo[k][1],lo[k][2],lo[k][3],hi[k][0],hi[k][1],hi[k][2],hi[k][3]}
    o[d0]=__builtin_amdgcn_mfma_f32_32x32x16_bf16(pa0,PK(0),o[d0],0,0,0);
    o[d0]=__builtin_amdgcn_mfma_f32_32x32x16_bf16(pa1,PK(1),o[d0],0,0,0);
    o[d0]=__builtin_amdgcn_mfma_f32_32x32x16_bf16(pa2,PK(2),o[d0],0,0,0);
    o[d0]=__builtin_amdgcn_mfma_f32_32x32x16_bf16(pa3,PK(3),o[d0],0,0,0);
    #undef PK
  }
}

#ifndef ATTN_STORE16
#define ATTN_STORE16(p,v) (*(u32x4*)(p)=(v))
#endif
template<int THRL,bool BANDED> __device__ __forceinline__ void attn_unit(const bf16*Qrows,const bf16*__restrict__ Kc,const bf16*__restrict__ Kl,const bf16*__restrict__ Vc,const bf16*__restrict__ Vl,bf16*Orows,const int NT,const int qpos0,const int kpos0,const float sink_l2,char*shm){
  int tid_o=threadIdx.x; asm volatile("":"+v"(tid_o)); const int tid=tid_o,lane=tid&63,r32=lane&31,hi=lane>>5; const int wid=__builtin_amdgcn_readfirstlane(tid>>6);
  const bf16*Qw=Qrows+(long)(wid*QBLK)*ZP;
  const unsigned lds0=(unsigned)(uintptr_t)shm;
  float*wsf=(float*)(shm+LDS_WS)+wid*64;
  const long koff=(long)lane*ZP+wid*8, voff=(long)(16*(wid&3)+(lane>>2))*ZP+(wid>>2)*32+(lane&3)*8;
  const bf16*ksrc_c=Kc+koff,*ksrc_l=Kl+koff-(long)4*KVBLK*ZP,*vsrc_c=Vc+voff,*vsrc_l=Vl+voff-(long)4*KVBLK*ZP;
  const unsigned kdst=lds0+LDS_K+wid*1024, vdst=lds0+LDS_V+wid*1024;
  #define DMA_K(t,slot) glds16((((t)<4)?ksrc_c:ksrc_l)+(long)(t)*KVBLK*ZP,(unsigned)__builtin_amdgcn_readfirstlane(kdst+(slot)))
  #define DMA_V(t,slot) glds16((((t)<4)?vsrc_c:vsrc_l)+(long)(t)*KVBLK*ZP,(unsigned)__builtin_amdgcn_readfirstlane(vdst+(slot)))
  const int vb0=(int)(lds0+LDS_V)+((lane>>4)&1)*32+(lane&3)*8+(4*hi+((lane&15)>>2))*64;
  const char*Kbase=shm+LDS_K; bf16x8 kf[8];
  const lds_cptr shm3=(lds_cptr)shm; const lds_cptr kp0=shm3+LDS_K+hi*1024+r32*16; const lds_cptr vp0=shm3+LDS_V+((lane>>4)&1)*32+(lane&3)*8+(4*hi+((lane&15)>>2))*64;
  DMA_K(0,0);DMA_V(0,0);DMA_K(1,SLOTB);
  bf16x8 qr[4];
  #pragma unroll
  for(int d0=0;d0<4;++d0)qr[d0]=*reinterpret_cast<const bf16x8*>(&Qw[(long)r32*ZP+d0*16+hi*8]);
  float mhat=0.f,l_reg=0.f;f32x16 o[2];o[0]=f32x16{};o[1]=f32x16{};f32x16 negm=f32x16{};asm volatile("":"+v"(negm));
  const int qrel=wid*QBLK+r32;
  #define CMASK(P0,P1,t) do{ if(BANDED&&(t)>=4) bandmask(P0,P1,kpos0+64*((t)-4),qpos0+qrel,hi); }while(0)
  bool resc=false;
  #define START(P0,P1) do{ const float rm=rowmax(P0,P1); resc=false; \
    { const float dl=rm; mhat=fadd_s(mhat,dl); \
      _Pragma("unroll") for(int r=0;r<16;++r){P0[r]=fsub_s(P0[r],dl);P1[r]=fsub_s(P1[r],dl);} \
      _Pragma("unroll") for(int r=0;r<16;++r)negm[r]=-mhat; asm volatile("":"+v"(negm)); } \
    _Pragma("unroll") for(int r=0;r<16;++r)P0[r]=__builtin_amdgcn_exp2f(P0[r]); }while(0)
  #define RESC() do{ if(resc){ asm volatile("s_waitcnt lgkmcnt(0)":::"memory"); \
      _Pragma("unroll") for(int d_=0;d_<2;++d_) _Pragma("unroll") for(int r=0;r<16;++r)o[d_][r]*=wsf[crow(r,hi)]; } }while(0)
  f32x16 pA0,pA1,pB0,pB1;
  int sl_prev=0,sl_cur=0,sl_next=SLOTB;
  #define ROT() do{sl_prev=sl_cur;sl_cur=sl_next;sl_next=(sl_next==(NSLOT-1)*SLOTB)?0:sl_next+SLOTB;}while(0)
  DMA_K(2,2*SLOTB);
  WAIT_BAR(3);
  qkt(pA0,pA1,Kbase,qr,negm,r32,hi);asm volatile("s_nop 15\n\ts_nop 7":"+v"(pA0),"+v"(pA1));CMASK(pA0,pA1,0);
  START(pA0,pA1);
  _Pragma("unroll") for(int r=0;r<16;++r)pA1[r]=__builtin_amdgcn_exp2f(pA1[r]);
  WAIT_BAR(0);
  DMA_K(3,0);DMA_V(1,SLOTB);
  ROT();
  kload8(kf,kp0+sl_cur);
  WAIT_BAR(2);
  s16x4 vlo[8],vhi[8]; u32x4 pw0,pw1,pw2,pw3;
  #define PKW(P,B) cvtpk_s(P[B],P[B+1])
  #define PAF(k) __builtin_bit_cast(bf16x8,pw##k)
  #define VFR(i) (bf16x8){vlo[i][0],vlo[i][1],vlo[i][2],vlo[i][3],vhi[i][0],vhi[i][1],vhi[i][2],vhi[i][3]}
  #define PIN(x) asm volatile("":"+v"(x))
  #define MX3(a,b,c) __builtin_fmaxf(__builtin_fmaxf((a),(b)),(c))
  #define GAPA(MF,A0,A1,A2,A3,W0,W1,PW) do{ MF; sacc+=A0; sacc+=A1; sacc+=A2; sacc+=A3; PIN(sacc); W0; W1; PIN(PW); SBAR(); }while(0)
  #define EX(v) __builtin_amdgcn_exp2f(v)
  #define GAPB(MF,X,B) do{ MF; X[B]=EX(X[B]); X[B+1]=EX(X[B+1]); X[B+2]=EX(X[B+2]); X[B+3]=EX(X[B+3]); PIN(X); SBAR(); }while(0)
  #define VRD(i) do{ vlo[i]=vtr(vp_+(((i)>>2)*4096+((i)&3)*1024)); vhi[i]=vtr(vp_+(((i)>>2)*4096+((i)&3)*1024+512)); }while(0)
  #define KRD(G,j) do{ if(G){ kload2(kf,kp0+sl_next,j); SBAR(); } }while(0)
  #define STEP(C0,C1,P0,P1,t,GK,GV,GL) do{ SBAR(); \
    const lds_cptr vp_=vp0+sl_prev; \
    VRD(0); SBAR(); float sacc=(P0[0]+P0[1]); \
    GAPA(C0=__builtin_amdgcn_mfma_f32_32x32x16_bf16(kf[0],qr[0],negm,0,0,0), P0[2],P0[3],P0[4],P0[5],     pw0[0]=PKW(P0,0), pw0[1]=PKW(P0,2), pw0); \
    VRD(4); SBAR(); GAPA(C1=__builtin_amdgcn_mfma_f32_32x32x16_bf16(kf[1],qr[0],negm,0,0,0), P0[6],P0[7],P0[8],P0[9],     pw0[2]=PKW(P0,4), pw0[3]=PKW(P0,6), pw0); \
    VRD(1); SBAR(); GAPA(C0=__builtin_amdgcn_mfma_f32_32x32x16_bf16(kf[2],qr[1],C0,0,0,0),   P0[10],P0[11],P0[12],P0[13], pw1[0]=PKW(P0,8), pw1[1]=PKW(P0,10), pw1); \
    VRD(5); SBAR(); GAPA(C1=__builtin_amdgcn_mfma_f32_32x32x16_bf16(kf[3],qr[1],C1,0,0,0),   P0[14],P0[15],P1[0],P1[1],   pw1[2]=PKW(P0,12),pw1[3]=PKW(P0,14), pw1); \
    VRD(2); SBAR(); GAPA(C0=__builtin_amdgcn_mfma_f32_32x32x16_bf16(kf[4],qr[2],C0,0,0,0),   P1[2],P1[3],P1[4],P1[5],     pw2[0]=PKW(P1,0), pw2[1]=PKW(P1,2), pw2); \
    VRD(6); SBAR(); GAPA(C1=__builtin_amdgcn_mfma_f32_32x32x16_bf16(kf[5],qr[2],C1,0,0,0),   P1[6],P1[7],P1[8],P1[9],     pw2[2]=PKW(P1,4), pw2[3]=PKW(P1,6), pw2); \
    VRD(3); SBAR(); GAPA(C0=__builtin_amdgcn_mfma_f32_32x32x16_bf16(kf[6],qr[3],C0,0,0,0),   P1[10],P1[11],P1[12],P1[13], pw3[0]=PKW(P1,8), pw3[1]=PKW(P1,10), pw3); \
    VRD(7); SBAR(); GAPA(C1=__builtin_amdgcn_mfma_f32_32x32x16_bf16(kf[7],qr[3],C1,0,0,0),   P1[14],P1[15],0.f,0.f,       pw3[2]=PKW(P1,12),pw3[3]=PKW(P1,14), pw3); \
    l_reg+=sacc; \
    if(GK){DMA_K((t)+3,sl_cur);} if(GV){DMA_V((t)+1,sl_next);} \
    CMASK(C0,C1,t); \
    { float a=MX3(C0[0],C0[1],C1[0]),b=MX3(C0[2],C0[3],C1[1]); a=MX3(a,C1[2],C1[3]); \
      _Pragma("unroll") for(int r=4;r<16;r+=4){a=MX3(a,C0[r],C0[r+1]);b=MX3(b,C0[r+2],C0[r+3]);a=MX3(a,C1[r],C1[r+1]);b=MX3(b,C1[r+2],C1[r+3]);} \
      float rm=__builtin_fmaxf(a,b); { auto rr=__builtin_amdgcn_permlane32_swap(__float_as_uint(rm),__float_as_uint(rm),false,false); rm=__builtin_fmaxf(__uint_as_float(rr[0]),__uint_as_float(rr[1])); } \
      resc=false; \
      if(__builtin_expect(__any(rm>(float)THRL),0)){ const float dl=__builtin_fmaxf(rm,0.f); mhat+=dl; \
        _Pragma("unroll") for(int r=0;r<16;++r){C0[r]-=dl;C1[r]-=dl;} \
        _Pragma("unroll") for(int r=0;r<16;++r)negm[r]=-mhat; asm volatile("":"+v"(negm)); \
        const float f=__builtin_amdgcn_exp2f(-dl); l_reg*=f; if(hi==0)wsf[r32]=f; resc=true; } } \
    SBAR(); \
    GAPB(o[0]=__builtin_amdgcn_mfma_f32_32x32x16_bf16(PAF(0),VFR(0),o[0],0,0,0), C0,0); \
    GAPB(o[1]=__builtin_amdgcn_mfma_f32_32x32x16_bf16(PAF(0),VFR(4),o[1],0,0,0), C0,4); \
    KRD(GL,0); GAPB(o[0]=__builtin_amdgcn_mfma_f32_32x32x16_bf16(PAF(1),VFR(1),o[0],0,0,0), C0,8); \
    KRD(GL,1); GAPB(o[1]=__builtin_amdgcn_mfma_f32_32x32x16_bf16(PAF(1),VFR(5),o[1],0,0,0), C0,12); \
    KRD(GL,2); GAPB(o[0]=__builtin_amdgcn_mfma_f32_32x32x16_bf16(PAF(2),VFR(2),o[0],0,0,0), C1,0); \
    KRD(GL,3); GAPB(o[1]=__builtin_amdgcn_mfma_f32_32x32x16_bf16(PAF(2),VFR(6),o[1],0,0,0), C1,4); \
    GAPB(o[0]=__builtin_amdgcn_mfma_f32_32x32x16_bf16(PAF(3),VFR(3),o[0],0,0,0), C1,8); \
    GAPB(o[1]=__builtin_amdgcn_mfma_f32_32x32x16_bf16(PAF(3),VFR(7),o[1],0,0,0), C1,12); \
    }while(0)
  int t=1;
  for(;t+5<NT;t+=2){
    STEP(pB0,pB1,pA0,pA1,t,true,true,true);     WAIT_BAR(2); RESC(); ROT();
    STEP(pA0,pA1,pB0,pB1,t+1,true,true,true);   WAIT_BAR(2); RESC(); ROT();
  }
  #undef CMASK
  #define CMASK(P0,P1,t) do{ if(BANDED&&(t)>=4) bandmask(P0,P1,kpos0+64*((t)-4),qpos0+qrel,hi); }while(0)
  #define ENDW(tt) do{ if((tt)+3<NT){WAIT_BAR(2);} else if((tt)+2<NT){WAIT_BAR(1);} else {WAIT_BAR(0);} }while(0)
  for(;t+1<NT;t+=2){
    STEP(pB0,pB1,pA0,pA1,t,(t+3<NT),(t+1<NT),(t+1<NT));       ENDW(t);   RESC(); ROT();
    STEP(pA0,pA1,pB0,pB1,t+1,(t+4<NT),(t+2<NT),(t+2<NT));     ENDW(t+1); RESC(); ROT();
  }
  STEP(pB0,pB1,pA0,pA1,NT-1,false,false,false); RESC();
  { float sacc=pB0[0]+pB0[1]; _Pragma("unroll") for(int r=2;r<16;++r)sacc+=pB0[r]; _Pragma("unroll") for(int r=0;r<16;++r)sacc+=pB1[r]; l_reg+=sacc;
    pw0=(u32x4){PKW(pB0,0),PKW(pB0,2),PKW(pB0,4),PKW(pB0,6)};pw1=(u32x4){PKW(pB0,8),PKW(pB0,10),PKW(pB0,12),PKW(pB0,14)};pw2=(u32x4){PKW(pB1,0),PKW(pB1,2),PKW(pB1,4),PKW(pB1,6)};pw3=(u32x4){PKW(pB1,8),PKW(pB1,10),PKW(pB1,12),PKW(pB1,14)};
    SBAR(); pv(o,vb0+sl_cur,PAF(0),PAF(1),PAF(2),PAF(3)); }
  #undef PKW
  #undef PAF
  #undef VFR
  #undef PIN
  #undef MX3
  #undef GAPA
  #undef GAPB
  #undef EX
  #undef VRD
  #undef KRD
  #undef STEP
  #undef ENDW
  {auto rr=__builtin_amdgcn_permlane32_swap(__float_as_uint(l_reg),__float_as_uint(l_reg),false,false);l_reg=__uint_as_float(rr[0])+__uint_as_float(rr[1]);}
  if(BANDED) l_reg+=__builtin_amdgcn_exp2f(sink_l2-mhat);
  if(hi==0)wsf[32+r32]=l_reg;asm volatile("s_waitcnt lgkmcnt(0)":::"memory");
  float rli[16];
  #pragma unroll
  for(int r=0;r<16;++r)rli[r]=__builtin_amdgcn_rcpf(wsf[32+crow(r,hi)]);
  bf16*Ow=Orows+(long)(wid*QBLK)*OP;
  { bf16*stg=(bf16*)(shm+LDS_OST)+wid*2048;
    #pragma unroll
    for(int r=0;r<16;++r){const int orow=crow(r,hi);
      #pragma unroll
      for(int d0=0;d0<2;++d0)stg[orow*64+d0*32+r32]=__float2bfloat16(o[d0][r]*rli[r]);}
    asm volatile("s_waitcnt lgkmcnt(0)":::"memory");
    #pragma unroll
    for(int i=0;i<4;++i){const int row=i*8+(lane>>3),ch=lane&7; const u32x4 v=*(const u32x4*)(stg+row*64+ch*8); ATTN_STORE16(Ow+(long)row*OP+ch*8,v);} }
  asm volatile("s_waitcnt lgkmcnt(0)\n\ts_barrier":::"memory");
  #undef DMA_K
  #undef DMA_V
  #undef CMASK
  #undef START
  #undef RESC
  #undef ROT
}
constexpr int ATTN_LDS_BYTES=LDS_BYTES;
#undef SBAR
#undef WAIT_BAR
}

#define LAS __attribute__((address_space(3)))
typedef unsigned short bf16;
typedef unsigned v4u __attribute__((ext_vector_type(4)));
typedef float f32x4 __attribute__((ext_vector_type(4)));

constexpr int DM = 1024, NBATCH = 4, SEQ = 8192, CTXL = 256;
constexpr int ML = NBATCH * SEQ, MC = NBATCH * CTXL, MT = ML + MC;
constexpr int ZW = 2560, FF = 2816, FF2 = 5632, CW = 512, NFFT = 16384;
constexpr int NTHR = 512;
constexpr size_t MiB = 1u << 20;
constexpr size_t WS_MOD = 0;
constexpr size_t WS_TW = 256 * 1024;
constexpr size_t WS_ROPE = 320 * 1024;
constexpr size_t WS_FSUMC = 384 * 1024;
constexpr size_t WS_BAR = 448 * 1024;
constexpr size_t WS_FSUM = 1 * MiB;
constexpr size_t WS_KC = 2 * MiB;
constexpr size_t WS_UC = 3 * MiB;
constexpr size_t WS_WB = 5 * MiB;
constexpr size_t WB_IN = 0, WB_OUT = 5 * MiB, WB_UP = 7 * MiB, WB_DOWN = 18 * MiB, WB_LAYER = 23 * MiB + 512 * 1024;
constexpr size_t WS_XC = 52 * MiB;
constexpr size_t WS_XN = 56 * MiB;
constexpr size_t WS_Z = 122 * MiB;
constexpr size_t WS_OC = 287 * MiB;
constexpr size_t WS_UT = 353 * MiB;
constexpr size_t WS_KF = 417 * MiB;
constexpr size_t WS_AV = 122 * MiB;
constexpr size_t WS_G = 122 * MiB;
constexpr size_t WS_EA = 304 * MiB;
constexpr size_t WS_EV = 327 * MiB;
constexpr size_t WS_END = 481 * MiB;
constexpr int LDS_BYTES = 147456;

__device__ __forceinline__ unsigned f2bf(float f) { unsigned u = __builtin_bit_cast(unsigned, f); return (u + 0x7fffu + ((u >> 16) & 1u)) >> 16; }
__device__ __forceinline__ unsigned pk2(float lo, float hi) { return f2bf(lo) | (f2bf(hi) << 16); }
__device__ __forceinline__ float bflo(unsigned w) { return __builtin_bit_cast(float, w << 16); }
__device__ __forceinline__ float bfhi(unsigned w) { return __builtin_bit_cast(float, w & 0xffff0000u); }
__device__ __forceinline__ void unpack8(const v4u w, float* f) { f[0] = bflo(w.x); f[1] = bfhi(w.x); f[2] = bflo(w.y); f[3] = bfhi(w.y); f[4] = bflo(w.z); f[5] = bfhi(w.z); f[6] = bflo(w.w); f[7] = bfhi(w.w); }
__device__ __forceinline__ v4u pack8(const float* f) { v4u o; o.x = pk2(f[0], f[1]); o.y = pk2(f[2], f[3]); o.z = pk2(f[4], f[5]); o.w = pk2(f[6], f[7]); return o; }
__device__ __forceinline__ float wave_sum(float v) {
#pragma unroll
    for (int o = 1; o < 64; o <<= 1) v += __shfl_xor(v, o);
    return v;
}

struct EpiStoreBf16 {
    static constexpr bool PERM = true, AFTER_DRAIN = false;
    bf16* O; int ldc;
    __device__ __forceinline__ void operator()(const pg8::f32x4 (&acc)[2][2][4][2], const pg8::Unit& u, int wr, int wc, int fr, int fq) const {
        const int row0 = u.pm * 256 + wr * 64 + fr, col0 = u.pn * 256 + wc * 32 + 8 * fq;
#pragma unroll
        for (int ai = 0; ai < 2; ++ai)
#pragma unroll
            for (int m = 0; m < 4; ++m) { bf16* rowp = O + (size_t)(row0 + ai * 128 + m * 16) * ldc + col0;
#pragma unroll
                for (int bj = 0; bj < 2; ++bj) { const pg8::f32x4 v0 = acc[ai][bj][m][0], v1 = acc[ai][bj][m][1]; v4u w;
                    w.x = pg8::cvt_pk_bf16(v0[0], v0[1]); w.y = pg8::cvt_pk_bf16(v0[2], v0[3]); w.z = pg8::cvt_pk_bf16(v1[0], v1[1]); w.w = pg8::cvt_pk_bf16(v1[2], v1[3]);
                    *(v4u*)(rowp + bj * 128) = w; } }
    }
};
struct EpiRes {
    static constexpr bool PERM = true, AFTER_DRAIN = false;
    const float* srcL; float* dstL; const float* srcC; float* dstC; const float* gate; int pm0;
    __device__ __forceinline__ void operator()(const pg8::f32x4 (&acc)[2][2][4][2], const pg8::Unit& u, int wr, int wc, int fr, int fq) const {
        const int pm = u.pm + pm0; const float* src; float* dst; const float* g; int rbase;
        if (pm < 128) { src = srcL; dst = dstL; g = gate + (pm >> 5) * 6144; rbase = pm * 256; } else { src = srcC; dst = dstC; g = gate + 4 * 6144; rbase = (pm - 128) * 256; }
        const int row0 = rbase + wr * 64 + fr, col0 = u.pn * 256 + wc * 32 + 8 * fq;
        f32x4 gv[2][2];
#pragma unroll
        for (int bj = 0; bj < 2; ++bj)
#pragma unroll
            for (int n = 0; n < 2; ++n) gv[bj][n] = *(const f32x4*)(g + col0 + bj * 128 + 4 * n);
#pragma unroll
        for (int ai = 0; ai < 2; ++ai)
#pragma unroll
            for (int m = 0; m < 4; ++m) { const size_t p = (size_t)(row0 + ai * 128 + m * 16) * DM + col0;
#pragma unroll
                for (int bj = 0; bj < 2; ++bj)
#pragma unroll
                    for (int n = 0; n < 2; ++n) { f32x4 v = *(const f32x4*)(src + p + bj * 128 + 4 * n); v = v + gv[bj][n] * acc[ai][bj][m][n]; *(f32x4*)(dst + p + bj * 128 + 4 * n) = v; } }
    }
};

__device__ __forceinline__ float gelu_fast(float x) { const float u = x + 0.044715f * x * x * x; return x * __builtin_amdgcn_rcpf(1.f + __builtin_amdgcn_exp2f(-2.302208198f * u)); }
__device__ __forceinline__ float dpp_ror1(float v) { return __builtin_bit_cast(float, __builtin_amdgcn_update_dpp(0, __builtin_bit_cast(int, v), 0x121, 0xf, 0xf, false)); }
__device__ __forceinline__ float dpp_rol1(float v) { return __builtin_bit_cast(float, __builtin_amdgcn_update_dpp(0, __builtin_bit_cast(int, v), 0x12F, 0xf, 0xf, false)); }
struct EpiGate {
    static constexpr bool PERM = true, AFTER_DRAIN = false;
    bf16* G; float* EA; float* EV; const float* cw; const float* cb;
    __device__ __forceinline__ void operator()(const pg8::f32x4 (&acc)[2][2][4][2], const pg8::Unit& u, int wr, int wc, int fr, int fq) const {
        const int jcol = u.pn * 128 + wc * 32 + 8 * fq;
        f32x4 w0[2], w1[2], w2[2], bb[2];
#pragma unroll
        for (int n = 0; n < 2; ++n) { w0[n] = *(const f32x4*)(cw + jcol + 4 * n); w1[n] = *(const f32x4*)(cw + FF + jcol + 4 * n); w2[n] = *(const f32x4*)(cw + 2 * FF + jcol + 4 * n); bb[n] = *(const f32x4*)(cb + jcol + 4 * n); }
#pragma unroll
        for (int ai = 0; ai < 2; ++ai) {
            const int row_b = u.pm * 256 + ai * 128 + wr * 64, blk = row_b >> 6;
#pragma unroll
            for (int m = 0; m < 4; ++m) {
                float o[8];
#pragma unroll
                for (int n = 0; n < 2; ++n)
#pragma unroll
                    for (int j = 0; j < 4; ++j) {
                        const float cur = acc[ai][0][m][n][j];
                        float up = dpp_ror1(cur), dn = dpp_rol1(cur);
                        if (m > 0) { const float t = dpp_ror1(acc[ai][0][m - 1][n][j]); up = fr == 0 ? t : up; }
                        if (m < 3) { const float t = dpp_rol1(acc[ai][0][m + 1][n][j]); dn = fr == 15 ? t : dn; }
                        o[4 * n + j] = gelu_fast(w0[n][j] * up + w1[n][j] * cur + w2[n][j] * dn + bb[n][j]) * acc[ai][1][m][n][j];
                    }
                const int rb = 16 * m + fr;
                if (rb >= 1 && rb <= 62) *(v4u*)(G + (size_t)(row_b + rb) * FF + jcol) = pack8(o);
                if ((m == 0 && fr < 2) || (m == 3 && fr > 13)) {
                    const int slot = m == 0 ? fr : fr - 12;
                    float* ea = EA + ((size_t)blk * 4 + slot) * FF + jcol;
                    *(f32x4*)ea = acc[ai][0][m][0]; *(f32x4*)(ea + 4) = acc[ai][0][m][1];
                    if (slot == 0 || slot == 3) { float* ev = EV + ((size_t)blk * 2 + (slot == 3 ? 1 : 0)) * FF + jcol; *(f32x4*)ev = acc[ai][1][m][0]; *(f32x4*)(ev + 4) = acc[ai][1][m][1]; }
                }
            }
        }
    }
};
__device__ __forceinline__ void ffn_fixup(bf16* G, const float* EA, const float* EV, const float* cw, const float* cb, int nblk64, int gtid, int gthreads) {
    const int total = nblk64 * 2 * (FF / 4);
    for (int idx = gtid; idx < total; idx += gthreads) {
        const int j = (idx % (FF / 4)) * 4, rs = idx / (FF / 4), sel = rs & 1, kb = rs >> 1;
        const int row = kb * 64 + (sel ? 63 : 0); const bool lat = row < ML; const int tpos = lat ? (row & (SEQ - 1)) : ((row - ML) & (CTXL - 1)); const int slen = lat ? SEQ : CTXL;
        const f32x4 zero = (f32x4){0.f, 0.f, 0.f, 0.f};
        f32x4 up, cur, dn, v;
        if (!sel) { up = tpos > 0 ? *(const f32x4*)(EA + ((size_t)(kb - 1) * 4 + 3) * FF + j) : zero; cur = *(const f32x4*)(EA + ((size_t)kb * 4 + 0) * FF + j); dn = *(const f32x4*)(EA + ((size_t)kb * 4 + 1) * FF + j); v = *(const f32x4*)(EV + ((size_t)kb * 2 + 0) * FF + j); }
        else { up = *(const f32x4*)(EA + ((size_t)kb * 4 + 2) * FF + j); cur = *(const f32x4*)(EA + ((size_t)kb * 4 + 3) * FF + j); dn = tpos < slen - 1 ? *(const f32x4*)(EA + ((size_t)(kb + 1) * 4 + 0) * FF + j) : zero; v = *(const f32x4*)(EV + ((size_t)kb * 2 + 1) * FF + j); }
        const f32x4 w0 = *(const f32x4*)(cw + j), w1 = *(const f32x4*)(cw + FF + j), w2 = *(const f32x4*)(cw + 2 * FF + j), bb = *(const f32x4*)(cb + j);
        float o[4];
#pragma unroll
        for (int i = 0; i < 4; ++i) o[i] = gelu_fast(w0[i] * up[i] + w1[i] * cur[i] + w2[i] * dn[i] + bb[i]) * v[i];
        unsigned long long pk = (unsigned long long)pk2(o[0], o[1]) | ((unsigned long long)pk2(o[2], o[3]) << 32);
        *(unsigned long long*)(G + (size_t)row * FF + j) = pk;
    }
}

__device__ __forceinline__ void transpose_item(const float* W, int K, int N, bf16* WT, int kb, int nb, int rbase, LAS float* scr, int lane) {
    const int k0 = 64 * kb, n0 = 32 * nb;
#pragma unroll 8
    for (int i = 0; i < 32; ++i) { const int kk = 2 * i + (lane >> 5); scr[kk * 33 + (lane & 31)] = W[(size_t)(k0 + kk) * N + n0 + (lane & 31)]; }
    asm volatile("s_waitcnt lgkmcnt(0)" ::: "memory");
    const int c = lane & 7;
#pragma unroll
    for (int j = 0; j < 4; ++j) { const int n = (lane >> 3) + 8 * j; const LAS float* s = scr + (8 * c) * 33 + n;
        v4u o; o.x = pk2(s[0 * 33], s[1 * 33]); o.y = pk2(s[2 * 33], s[3 * 33]); o.z = pk2(s[4 * 33], s[5 * 33]); o.w = pk2(s[6 * 33], s[7 * 33]);
        *(v4u*)(WT + (size_t)(rbase + n) * K + k0 + 8 * c) = o; }
    asm volatile("s_waitcnt lgkmcnt(0)" ::: "memory");
}
constexpr int TI_IN = 16 * 80, TI_OUT = 16 * 32, TI_UP = 16 * 176, TI_DOWN = 44 * 32, TI_LAYER = TI_IN + TI_OUT + TI_UP + TI_DOWN;
__device__ __forceinline__ void p0_weights(const float* w_in, const float* w_out, const float* w_up, const float* w_down, unsigned char* wb, LAS float* scr, int gw, int ngw, int lane) {
    for (int it = gw; it < 2 * TI_LAYER; it += ngw) {
        const int l = it / TI_LAYER; int r = it % TI_LAYER; unsigned char* base = wb + (size_t)l * WB_LAYER;
        if (r < TI_IN) { transpose_item(w_in + (size_t)l * DM * ZW, DM, ZW, (bf16*)(base + WB_IN), r / 80, r % 80, 32 * (r % 80), scr, lane); continue; } r -= TI_IN;
        if (r < TI_OUT) { transpose_item(w_out + (size_t)l * DM * DM, DM, DM, (bf16*)(base + WB_OUT), r / 32, r % 32, 32 * (r % 32), scr, lane); continue; } r -= TI_OUT;
        if (r < TI_UP) { const int nb = r % 176, n0 = 32 * nb; const int m = n0 < FF ? n0 : n0 - FF; const int rb = (m / 128) * 256 + (n0 < FF ? 0 : 128) + (m % 128);
            transpose_item(w_up + (size_t)l * DM * FF2, DM, FF2, (bf16*)(base + WB_UP), r / 176, nb, rb, scr, lane); continue; } r -= TI_UP;
        transpose_item(w_down + (size_t)l * FF * DM, FF, DM, (bf16*)(base + WB_DOWN), r / 32, r % 32, 32 * (r % 32), scr, lane);
    }
}
__device__ __forceinline__ void p0_mod_item(const float* c, const float* c_ctx, const float* ada_w, const float* ada_b, float* mod, LAS float* L, int item, int tid) {
    const int l = item / 96, n0 = (item % 96) * 64, wave = tid >> 6, lane = tid & 63;
    LAS float* sl = L; LAS float* red = L + 5 * 1024;
    for (int i = tid; i < 5 * 1024; i += NTHR) { const int r = i >> 10, k = i & 1023; const float v = r < 4 ? c[r * 1024 + k] : c_ctx[k]; sl[i] = v / (1.f + expf(-v)); }
    __syncthreads();
    float acc[5] = {0.f, 0.f, 0.f, 0.f, 0.f};
    const float* w = ada_w + (size_t)l * DM * 6144 + n0 + lane;
#pragma unroll 8
    for (int k = wave * 128; k < wave * 128 + 128; ++k) { const float wv = w[(size_t)k * 6144];
#pragma unroll
        for (int r = 0; r < 5; ++r) acc[r] += sl[r * 1024 + k] * wv; }
#pragma unroll
    for (int r = 0; r < 5; ++r) red[(wave * 5 + r) * 64 + lane] = acc[r];
    __syncthreads();
    if (tid < 320) { const int r = tid >> 6; float s = 0.f;
#pragma unroll
        for (int w8 = 0; w8 < 8; ++w8) s += red[(w8 * 5 + r) * 64 + lane];
        mod[(size_t)(l * 5 + r) * 6144 + n0 + lane] = s + ada_b[l * 6144 + n0 + lane]; }
    __syncthreads();
}
template <bool CTXF>
__device__ __forceinline__ void p0_filter_item(const float* w1, const float* b1, const float* w2, const float* b2, const float* w3, const float* b3, const float* w4, const float* freq,
                                               float* KT, float* FS, LAS float* L, int chunk, int tid) {
    constexpr int n = CTXF ? 256 : 8192; const int t0 = chunk * 32;
    LAS float* feats = L; LAS float* h1 = L + 32 * 36; LAS float* h2 = h1 + 2048; LAS float* h3 = h2 + 2048; LAS float* T = L + 8192;
    for (int i = tid; i < 32 * 33; i += NTHR) { const int tap = i / 33, e = i % 33, t = t0 + tap; float val;
        if (e == 0) val = (float)t / (float)(n - 1);
        else { const int j = (e - 1) & 15; const float f = 1e-4f + (float)j * ((15.0f - 1e-4f) / 15.0f); float sn, cs; sincospif(f * (2.0f * (float)t / (float)n), &sn, &cs); val = e <= 16 ? cs : -sn; }
        feats[tap * 36 + e] = val; }
    __syncthreads();
    const int tap4 = tid >> 4, jb = tid & 15;
    { float s4[4];
#pragma unroll
      for (int i = 0; i < 4; ++i) s4[i] = b1[jb + 16 * i];
#pragma unroll 3
      for (int e = 0; e < 33; ++e) { const float fv = feats[tap4 * 36 + e];
#pragma unroll
          for (int i = 0; i < 4; ++i) s4[i] += fv * w1[e * 64 + jb + 16 * i]; }
#pragma unroll
      for (int i = 0; i < 4; ++i) h1[tap4 * 64 + jb + 16 * i] = sinf(freq[jb + 16 * i] * s4[i]); }
    __syncthreads();
    { float s4[4];
#pragma unroll
      for (int i = 0; i < 4; ++i) s4[i] = b2[jb + 16 * i];
#pragma unroll 4
      for (int e = 0; e < 64; ++e) { const float fv = h1[tap4 * 64 + e];
#pragma unroll
          for (int i = 0; i < 4; ++i) s4[i] += fv * w2[e * 64 + jb + 16 * i]; }
#pragma unroll
      for (int i = 0; i < 4; ++i) h2[tap4 * 64 + jb + 16 * i] = sinf(freq[jb + 16 * i] * s4[i]); }
    __syncthreads();
    { float s4[4];
#pragma unroll
      for (int i = 0; i < 4; ++i) s4[i] = b3[jb + 16 * i];
#pragma unroll 4
      for (int e = 0; e < 64; ++e) { const float fv = h2[tap4 * 64 + e];
#pragma unroll
          for (int i = 0; i < 4; ++i) s4[i] += fv * w3[e * 64 + jb + 16 * i]; }
#pragma unroll
      for (int i = 0; i < 4; ++i) h3[tap4 * 64 + jb + 16 * i] = sinf(freq[jb + 16 * i] * s4[i]); }
    __syncthreads();
    float af[32], ab[32];
#pragma unroll
    for (int t = 0; t < 32; ++t) { af[t] = 0.f; ab[t] = 0.f; }
#pragma unroll 2
    for (int k = 0; k < 64; ++k) { const float wa = w4[k * 1024 + tid], wb = w4[k * 1024 + 512 + tid];
#pragma unroll
        for (int t = 0; t < 32; ++t) { const float h = h3[t * 64 + k]; af[t] += h * wa; ab[t] += h * wb; } }
    const float delta = 3.0701134573253944f + (float)tid * (12.280453829301577f / 511.f);
    float sf = 0.f, sb = 0.f;
#pragma unroll
    for (int t = 0; t < 32; ++t) { const float t01 = (float)(t0 + t) * (1.0f / (float)(n - 1)); const float win = __expf(-t01 * delta) + 0.05f;
        af[t] *= win; ab[t] *= win; sf += fabsf(af[t]); if (t0 + t > 0) sb += fabsf(ab[t]); }
    FS[chunk * 1024 + tid] = sf; FS[chunk * 1024 + 512 + tid] = sb;
    const int wave = tid >> 6, lane = tid & 63, cc = lane >> 5, tp = lane & 31, tt = t0 + tp;
#pragma unroll
    for (int t = 0; t < 32; ++t) T[tid * 33 + t] = af[t];
    __syncthreads();
#pragma unroll 1
    for (int cp = 0; cp < 32; ++cp) { const int c = wave * 64 + 2 * cp + cc; const float v = T[c * 33 + tp];
        if (CTXF) KT[(size_t)(255 + tt) * 512 + c] = v; else KT[(size_t)c * NFFT + tt] = v; }
    __syncthreads();
#pragma unroll
    for (int t = 0; t < 32; ++t) T[tid * 33 + t] = ab[t];
    __syncthreads();
#pragma unroll 1
    for (int cp = 0; cp < 32; ++cp) { const int c = wave * 64 + 2 * cp + cc; const float v = T[c * 33 + tp];
        if (tt > 0) { if (CTXF) KT[(size_t)(255 - tt) * 512 + c] = v; else KT[(size_t)c * NFFT + NFFT - tt] = v; } }
    if (!CTXF && chunk == 0) KT[(size_t)tid * NFFT + 8192] = 0.f;
    __syncthreads();
}

typedef float f32x2v __attribute__((ext_vector_type(2)));
constexpr int FFT_LDS_ELEMS = NFFT + NFFT / 32;
__device__ __forceinline__ int pidx(int i) { return i + (i >> 5); }
__device__ __forceinline__ f32x2v cmulv(const f32x2v a, const f32x2v b) { return (f32x2v){a.x * b.x - a.y * b.y, a.x * b.y + a.y * b.x}; }
template <int K16> __device__ __forceinline__ f32x2v e16() {
    constexpr float C[8] = {1.0f, 0.92387953251128674f, 0.70710678118654752f, 0.38268343236508977f, 0.0f, -0.38268343236508977f, -0.70710678118654752f, -0.92387953251128674f};
    constexpr float Sn[8] = {0.0f, 0.38268343236508977f, 0.70710678118654752f, 0.92387953251128674f, 1.0f, 0.92387953251128674f, 0.70710678118654752f, 0.38268343236508977f};
    return (f32x2v){C[K16], -Sn[K16]};
}
template <int S, int LOGR, bool INV, int Q, int M>
__device__ __forceinline__ void fft_bfly(f32x2v (&x)[1 << LOGR], const f32x2v (&bq)[LOGR]) {
    constexpr int R = 1 << LOGR, BS = NFFT >> S, STR = BS / R, bit = 1 << (LOGR - 1 - Q);
    if constexpr (M < R) {
        if constexpr (!(M & bit)) {
            constexpr int k16 = ((M & (bit - 1)) << Q) * (16 / R);
            f32x2v w;
            if constexpr (STR == 1) w = e16<k16>(); else if constexpr (k16 == 0) w = bq[Q]; else w = cmulv(bq[Q], e16<k16>());
            const f32x2v a = x[M], b = x[M + bit];
            if constexpr (!INV) { const f32x2v d = a - b; x[M] = a + b; x[M + bit] = cmulv(d, w); }
            else { const f32x2v t = (f32x2v){b.x * w.x + b.y * w.y, b.y * w.x - b.x * w.y}; x[M] = a + t; x[M + bit] = a - t; }
        }
        fft_bfly<S, LOGR, INV, Q, M + 1>(x, bq);
    }
}
template <int S, int LOGR, bool INV, int QQ>
__device__ __forceinline__ void fft_substages(f32x2v (&x)[1 << LOGR], const f32x2v (&bq)[LOGR]) {
    if constexpr (QQ < LOGR) { constexpr int Q = INV ? LOGR - 1 - QQ : QQ; fft_bfly<S, LOGR, INV, Q, 0>(x, bq); fft_substages<S, LOGR, INV, QQ + 1>(x, bq); }
}
template <int S, int LOGR, bool INV>
__device__ __forceinline__ void fft_super(LAS f32x2v* buf, const f32x2v* __restrict__ TW, int tid) {
    constexpr int R = 1 << LOGR, BS = NFFT >> S, STR = BS / R, NG = NFFT / R;
#pragma unroll
    for (int g = tid; g < NG; g += NTHR) {
        const int lo = g % STR, hi = g / STR, base = hi * BS + lo;
        f32x2v x[R], bq[LOGR];
#pragma unroll
        for (int m = 0; m < R; ++m) x[m] = buf[pidx(base + m * STR)];
        if constexpr (STR > 1) { bq[0] = TW[lo << S];
#pragma unroll
            for (int q = 1; q < LOGR; ++q) bq[q] = cmulv(bq[q - 1], bq[q - 1]); }
        else {
#pragma unroll
            for (int q = 0; q < LOGR; ++q) bq[q] = (f32x2v){1.f, 0.f}; }
        fft_substages<S, LOGR, INV, 0>(x, bq);
#pragma unroll
        for (int m = 0; m < R; ++m) buf[pidx(base + m * STR)] = x[m];
    }
    __syncthreads();
}
__device__ __forceinline__ void fft_fwd(LAS f32x2v* buf, const f32x2v* TW, int tid) { fft_super<0, 4, false>(buf, TW, tid); fft_super<4, 4, false>(buf, TW, tid); fft_super<8, 4, false>(buf, TW, tid); fft_super<12, 2, false>(buf, TW, tid); }
__device__ __forceinline__ void fft_inv(LAS f32x2v* buf, const f32x2v* TW, int tid) { fft_super<12, 2, true>(buf, TW, tid); fft_super<8, 4, true>(buf, TW, tid); fft_super<4, 4, true>(buf, TW, tid); fft_super<0, 4, true>(buf, TW, tid); }

__device__ __forceinline__ void filter_fft_item(const float* KT, const float* FS, f32x2v* KF, const f32x2v* TW, LAS f32x2v* buf, LAS float* misc, int c, int tid) {
    const f32x4* src = (const f32x4*)(KT + (size_t)c * NFFT);
    for (int i = tid; i < NFFT / 4; i += NTHR) { const f32x4 v = src[i];
#pragma unroll
        for (int k = 0; k < 4; ++k) buf[pidx(4 * i + k)] = (f32x2v){v[k], 0.f}; }
    if (tid < 64) { float s = 0.f;
#pragma unroll
        for (int k = 0; k < 4; ++k) { const int ch = tid * 4 + k; s += FS[ch * 1024 + c] + FS[ch * 1024 + 512 + c]; }
        s = wave_sum(s); if (tid == 0) misc[0] = 1.f / (s * (float)NFFT); }
    __syncthreads();
    fft_fwd(buf, TW, tid);
    const float sc = misc[0]; f32x2v* dst = KF + (size_t)c * NFFT;
    for (int i = tid; i < NFFT; i += NTHR) dst[i] = buf[pidx(i)] * sc;
    __syncthreads();
}
__device__ __forceinline__ void conv_fft_item(float* UT, const f32x2v* KF, const f32x2v* TW, const float* bias_d, LAS f32x2v* buf, int item, int tid) {
    const int p = item >> 9, c = item & 511;
    f32x4* u0 = (f32x4*)(UT + ((size_t)(2 * p) * CW + c) * SEQ); f32x4* u1 = (f32x4*)(UT + ((size_t)(2 * p + 1) * CW + c) * SEQ);
    for (int i = tid; i < SEQ / 4; i += NTHR) { const f32x4 a = u0[i], b = u1[i];
#pragma unroll
        for (int k = 0; k < 4; ++k) { buf[pidx(4 * i + k)] = (f32x2v){a[k], b[k]}; buf[pidx(SEQ + 4 * i + k)] = (f32x2v){0.f, 0.f}; } }
    __syncthreads();
    fft_fwd(buf, TW, tid);
    const f32x2v* kf = KF + (size_t)c * NFFT;
    for (int i = tid; i < NFFT; i += NTHR) { const f32x2v k = kf[i], v = buf[pidx(i)]; buf[pidx(i)] = (f32x2v){v.x * k.x - v.y * k.y, v.x * k.y + v.y * k.x}; }
    __syncthreads();
    fft_inv(buf, TW, tid);
    const float bd = bias_d[c];
    for (int i = tid; i < SEQ / 4; i += NTHR) { f32x4 a = u0[i], b = u1[i];
#pragma unroll
        for (int k = 0; k < 4; ++k) { const f32x2v y = buf[pidx(4 * i + k)]; a[k] = y.x + a[k] * bd; b[k] = y.y + b[k] * bd; }
        u0[i] = a; u1[i] = b; }
    __syncthreads();
}

__device__ __forceinline__ void modulate_rows(const float* srcL, const float* srcC, const float* g, const float* mod  , int shoff, bf16* XN, int row_lo, int row_hi, int gw, int ngw, int lane) {
    for (int row = row_lo + gw; row < row_hi; row += ngw) {
        const float* src; const float* mr;
        if (row < ML) { src = srcL + (size_t)row * DM; mr = mod + (row >> 13) * 6144; } else { src = srcC + (size_t)(row - ML) * DM; mr = mod + 4 * 6144; }
        const f32x4* xr = (const f32x4*)src + lane; f32x4 v[4]; float ss = 0.f;
#pragma unroll
        for (int j = 0; j < 4; ++j) { v[j] = xr[64 * j]; ss += (v[j].x * v[j].x + v[j].y * v[j].y) + (v[j].z * v[j].z + v[j].w * v[j].w); }
        const float rinv = 1.0f / sqrtf(wave_sum(ss) * (1.f / DM) + 1e-6f);
        unsigned long long* o8 = (unsigned long long*)(XN + (size_t)row * DM) + lane;
#pragma unroll
        for (int j = 0; j < 4; ++j) { const int col = 4 * lane + 256 * j; const f32x4 gg = *(const f32x4*)(g + col), sh = *(const f32x4*)(mr + shoff + col), sc = *(const f32x4*)(mr + shoff + 1024 + col);
            const f32x4 y = v[j] * rinv * gg * (sc + 1.0f) + sh;
            o8[64 * j] = (unsigned long long)pk2(y.x, y.y) | ((unsigned long long)pk2(y.z, y.w) << 32); }
    }
}
__device__ __forceinline__ void qk_norm_rope(bf16* Z, const float* qn, const float* kn, const f32x2v* ROPE, int blk, int nblk, int tid) {
    constexpr float C2 = 0.125f * 1.4426950408889634f;
    const int j = tid & 7;
    for (int it = blk; it < MT * 12 / 64; it += nblk) {
        const int hr = it * 64 + (tid >> 3), row = hr / 12, head = hr % 12;
        bf16* p = Z + (size_t)row * ZW + head * 64 + 8 * j;
        float x[8]; unpack8(*(const v4u*)p, x);
        float ss = 0.f;
#pragma unroll
        for (int i = 0; i < 8; ++i) ss += x[i] * x[i];
        ss += __shfl_xor(ss, 1); ss += __shfl_xor(ss, 2); ss += __shfl_xor(ss, 4);
        const float rinv = 1.0f / sqrtf(ss * (1.f / 64.f) + 1e-6f);
        const float* gn = (head < 8 ? qn : kn) + 8 * j;
#pragma unroll
        for (int i = 0; i < 8; ++i) x[i] = x[i] * rinv * gn[i];
        float other[8];
#pragma unroll
        for (int i = 0; i < 8; ++i) other[i] = __shfl_xor(x[i], 2);
        if (row < ML) {
            const int t = row & (SEQ - 1), pos = (j >> 2) ? (t & 63) : (t >> 6), jj = j & 3, f0 = (jj & 1) * 8; const bool second = (jj >> 1) != 0;
            const f32x2v* rp = ROPE + pos * 16 + f0;
#pragma unroll
            for (int i = 0; i < 8; ++i) { const f32x2v cs = rp[i]; x[i] = second ? (other[i] * cs.y + x[i] * cs.x) : (x[i] * cs.x - other[i] * cs.y); }
        }
        if (head < 8) {
#pragma unroll
            for (int i = 0; i < 8; ++i) x[i] *= C2;
        }
        *(v4u*)p = pack8(x);
    }
}
__device__ __forceinline__ void hyena_pre(const bf16* Z, const float* cw, const float* cb, bf16* OC, float* UT, float* UC, LAS float* T, int blk, int nblk, int tid) {
    const int tt = tid >> 3, cg8 = (tid & 7) * 8;
    constexpr int NIT = (MT / 64) * 8;
    for (int it = blk; it < NIT; it += nblk) {
        const int rt = it >> 3, c0 = (it & 7) * 64, row = rt * 64 + tt, c = c0 + cg8;
        const bool lat = row < ML; const int tpos = lat ? (row & (SEQ - 1)) : ((row - ML) & (CTXL - 1)); const int slen = lat ? SEQ : CTXL;
        float zc[3][8];
#pragma unroll
        for (int gsel = 0; gsel < 3; ++gsel) {
            const int col = gsel * CW + c; const bf16* zp = Z + (size_t)row * ZW + 1024 + col;
            float a[8], b[8], d[8];
            unpack8(*(const v4u*)zp, b);
            if (tpos > 0) unpack8(*(const v4u*)(zp - ZW), a); else { for (int i = 0; i < 8; ++i) a[i] = 0.f; }
            if (tpos < slen - 1) unpack8(*(const v4u*)(zp + ZW), d); else { for (int i = 0; i < 8; ++i) d[i] = 0.f; }
#pragma unroll
            for (int i = 0; i < 8; ++i) zc[gsel][i] = a[i] * cw[col + i] + b[i] * cw[3 * CW + col + i] + d[i] * cw[6 * CW + col + i] + cb[col + i];
        }
        *(v4u*)(OC + (size_t)row * DM + 512 + c) = pack8(zc[0]);
        float u[8];
#pragma unroll
        for (int i = 0; i < 8; ++i) u[i] = zc[2][i] * zc[1][i];
        if (lat) {
#pragma unroll
            for (int i = 0; i < 8; ++i) T[tt * 65 + cg8 + i] = u[i];
            __syncthreads();
            const int cl = tid >> 3, seg = (tid & 7) * 8, b = row >> 13, tb = (rt * 64) & (SEQ - 1);
            f32x4 o0, o1;
#pragma unroll
            for (int i = 0; i < 4; ++i) { o0[i] = T[(seg + i) * 65 + cl]; o1[i] = T[(seg + 4 + i) * 65 + cl]; }
            float* dst = UT + ((size_t)b * CW + c0 + cl) * SEQ + tb + seg;
            *(f32x4*)dst = o0; *(f32x4*)(dst + 4) = o1;
            __syncthreads();
        } else {
            float* dst = UC + (size_t)(row - ML) * CW + c;
            *(f32x4*)dst = (f32x4){u[0], u[1], u[2], u[3]}; *(f32x4*)(dst + 4) = (f32x4){u[4], u[5], u[6], u[7]};
        }
    }
}
__device__ __forceinline__ void ctx_conv_item(const float* KC, const float* FSC, const float* UC, const float* bias_d, bf16* OC, int item, int tid) {
    const int b = item >> 8, t = item & 255, c = tid;
    float s = 0.f;
#pragma unroll
    for (int ch = 0; ch < 8; ++ch) s += FSC[ch * 1024 + c] + FSC[ch * 1024 + 512 + c];
    const float* ub = UC + (size_t)b * CTXL * CW + c; const float* kc = KC + (size_t)(t + 255) * CW + c;
    float acc = 0.f;
#pragma unroll 8
    for (int sidx = 0; sidx < CTXL; ++sidx) acc += kc[-(long)sidx * CW] * ub[(size_t)sidx * CW];
    bf16* op = OC + (size_t)(ML + b * CTXL + t) * DM + 512 + c;
    const float x0 = __builtin_bit_cast(float, (unsigned)(*op) << 16);
    *op = (bf16)f2bf((acc / s + ub[(size_t)t * CW] * bias_d[c]) * x0);
}
__device__ __forceinline__ void hyena_post(const float* UT, bf16* OC, LAS float* T, int blk, int nblk, int tid) {
    constexpr int NIT = (ML / 64) * 8;
    for (int it = blk; it < NIT; it += nblk) {
        const int rt = it >> 3, c0 = (it & 7) * 64, b = (rt * 64) >> 13, tb = (rt * 64) & (SEQ - 1);
        { const int cl = tid >> 3, seg = (tid & 7) * 8; const float* src = UT + ((size_t)b * CW + c0 + cl) * SEQ + tb + seg;
          const f32x4 o0 = *(const f32x4*)src, o1 = *(const f32x4*)(src + 4);
#pragma unroll
          for (int i = 0; i < 4; ++i) { T[(seg + i) * 65 + cl] = o0[i]; T[(seg + 4 + i) * 65 + cl] = o1[i]; } }
        __syncthreads();
        { const int tt = tid >> 3, cg8 = (tid & 7) * 8; bf16* op = OC + (size_t)(rt * 64 + tt) * DM + 512 + c0 + cg8;
          float x0[8]; unpack8(*(const v4u*)op, x0);
#pragma unroll
          for (int i = 0; i < 8; ++i) x0[i] *= T[tt * 65 + cg8 + i];
          *(v4u*)op = pack8(x0); }
        __syncthreads();
    }
}
__device__ __forceinline__ void short_conv(const bf16* Z, const float* cw, bf16* OC, int blk, int nblk, int tid) {
    const int cg8 = (tid & 63) * 8;
    for (int it = blk; it < ML / 8; it += nblk) {
        const int row = it * 8 + (tid >> 6), t = row & (SEQ - 1);
        const bf16* zp = Z + (size_t)row * ZW + 1024 + cg8;
        float bg[8], c1[8], x1[8], acc[8];
        unpack8(*(const v4u*)zp, bg); unpack8(*(const v4u*)(zp + 512), c1); unpack8(*(const v4u*)(zp + 1024), x1);
#pragma unroll
        for (int i = 0; i < 8; ++i) acc[i] = c1[i] * x1[i] * cw[CW + cg8 + i];
        if (t > 0) { unpack8(*(const v4u*)(zp - ZW + 512), c1); unpack8(*(const v4u*)(zp - ZW + 1024), x1);
#pragma unroll
            for (int i = 0; i < 8; ++i) acc[i] += c1[i] * x1[i] * cw[cg8 + i]; }
        if (t < SEQ - 1) { unpack8(*(const v4u*)(zp + ZW + 512), c1); unpack8(*(const v4u*)(zp + ZW + 1024), x1);
#pragma unroll
            for (int i = 0; i < 8; ++i) acc[i] += c1[i] * x1[i] * cw[2 * CW + cg8 + i]; }
#pragma unroll
        for (int i = 0; i < 8; ++i) acc[i] *= bg[i];
        *(v4u*)(OC + (size_t)row * DM + 512 + cg8) = pack8(acc);
    }
}
__device__ __forceinline__ float gelu_tanh(float x) { const float u = 0.7978845608028654f * (x + 0.044715f * x * x * x); const float e = __expf(2.f * u); const float th = 1.f - 2.f / (e + 1.f); return 0.5f * x * (1.f + th); }
__device__ __forceinline__ void ffn_gate(const bf16* AV, bf16* G, const float* cw, const float* cb, int row0, int nrows, int blk, int nblk, int tid) {
    const int rs = tid >> 5, jl = tid & 31;
    for (int it = blk; it < nrows / 64; it += nblk) {
        const int r0 = it * 64 + rs * 4;
        for (int cbk = 0; cbk < 11; ++cbk) {
            const int j = cbk * 256 + jl * 8;
            const int ca = (j >> 7) * 256 + (j & 127);
            float w0[8], w1[8], w2[8], bb[8];
#pragma unroll
            for (int i = 0; i < 8; ++i) { w0[i] = cw[j + i]; w1[i] = cw[FF + j + i]; w2[i] = cw[2 * FF + j + i]; bb[i] = cb[j + i]; }
            float prev[8], cur[8], nxt[8];
            { const int gr = row0 + r0; const bool lat = gr < ML; const int tpos = lat ? (gr & (SEQ - 1)) : ((gr - ML) & (CTXL - 1));
              if (tpos > 0) unpack8(*(const v4u*)(AV + (size_t)(r0 - 1) * FF2 + ca), prev); else { for (int i = 0; i < 8; ++i) prev[i] = 0.f; } }
            unpack8(*(const v4u*)(AV + (size_t)r0 * FF2 + ca), cur);
#pragma unroll
            for (int rr = 0; rr < 4; ++rr) {
                const int lr = r0 + rr, gr = row0 + lr; const bool lat = gr < ML; const int tpos = lat ? (gr & (SEQ - 1)) : ((gr - ML) & (CTXL - 1)); const int slen = lat ? SEQ : CTXL;
                if (tpos < slen - 1) unpack8(*(const v4u*)(AV + (size_t)(lr + 1) * FF2 + ca), nxt); else { for (int i = 0; i < 8; ++i) nxt[i] = 0.f; }
                float vv[8], o[8]; unpack8(*(const v4u*)(AV + (size_t)lr * FF2 + ca + 128), vv);
#pragma unroll
                for (int i = 0; i < 8; ++i) { const float a = prev[i] * w0[i] + cur[i] * w1[i] + nxt[i] * w2[i] + bb[i]; o[i] = gelu_tanh(a) * vv[i]; }
                *(v4u*)(G + (size_t)lr * FF + j) = pack8(o);
#pragma unroll
                for (int i = 0; i < 8; ++i) { prev[i] = cur[i]; cur[i] = nxt[i]; }
            }
        }
    }
}

#define RLX_AGENT __ATOMIC_RELAXED, __HIP_MEMORY_SCOPE_AGENT

#define XB_TMO      128
#define XB_XCNT(j)  (256  + 64 * (j))
#define XB_XSUB(j)  (1280 + 64 * (j))
#define XB_XGEN(j)  (2304 + 64 * (j))
#define XB_TOP      3328
#define XB_TOPGEN   3392
#define XCD_BAR_WORDS 3456
#define XB_SPIN_CAP (1u << 18)

__device__ __forceinline__ unsigned xb_ld(unsigned* p)              { return __hip_atomic_load(p, __ATOMIC_RELAXED, __HIP_MEMORY_SCOPE_AGENT); }
__device__ __forceinline__ unsigned xb_add(unsigned* p, unsigned v) { return __hip_atomic_fetch_add(p, v, __ATOMIC_RELAXED, __HIP_MEMORY_SCOPE_AGENT); }
__device__ __forceinline__ unsigned xb_xcc_id() { return (unsigned)__builtin_amdgcn_s_getreg((3 << 11) | 20) & 0xFu; }
#define XB_SPIN(cond, bar) do { unsigned _sp = 0; while (cond) { __builtin_amdgcn_s_sleep(1); \
    if ((++_sp & 255u) == 0u) { if (xb_ld(&(bar)[XB_TMO])) break; if (_sp > XB_SPIN_CAP) { atomicAdd(&(bar)[XB_TMO], 1u); break; } } } } while (0)

struct XcdBarrier {
    unsigned* bar; unsigned x;
    volatile LAS unsigned* st;
};

__device__ __forceinline__ XcdBarrier xcd_barrier_post(unsigned* bar, volatile LAS unsigned* st) {
    XcdBarrier b; b.bar = bar; b.x = xb_xcc_id(); b.st = st;
    if (threadIdx.x == 0) (void)xb_add(&bar[XB_XCNT(b.x)], 1u);
    return b;
}
__device__ __forceinline__ void xcd_barrier_complete(unsigned* bar, unsigned x, unsigned& nloc, unsigned& nx) {
    const unsigned G = gridDim.x * gridDim.y * gridDim.z;
    unsigned sum, cnt, mine, sp = 0u;
    for (;;) {
        sum = 0u; cnt = 0u; mine = 0u;
#pragma unroll
        for (unsigned j = 0; j < 16; ++j) { const unsigned c = xb_ld(&bar[XB_XCNT(j)]); sum += c; cnt += (c > 0u) ? 1u : 0u; mine = (j == x) ? c : mine; }
        if (sum == G) break;
        __builtin_amdgcn_s_sleep(1);
        if ((++sp & 255u) == 0u) { if (xb_ld(&bar[XB_TMO])) break; if (sp > XB_SPIN_CAP) { atomicAdd(&bar[XB_TMO], 1u); break; } }
    }
    nloc = mine > 0u ? mine : 1u; nx = cnt > 0u ? cnt : 1u;
}

__device__ __forceinline__ void xcd_barrier(const XcdBarrier& b) {
    asm volatile("s_waitcnt vmcnt(0)" ::: "memory");
    __syncthreads();
    if (threadIdx.x == 0) {
        unsigned* bar = b.bar;
        __builtin_amdgcn_s_waitcnt(0);
        unsigned nloc = b.st[0], nx = b.st[1];
        if (nloc == 0u) { xcd_barrier_complete(bar, b.x, nloc, nx); b.st[0] = nloc; b.st[1] = nx; }
        const unsigned old = xb_add(&bar[XB_XSUB(b.x)], 1u);
        const unsigned gen = old / nloc;
        if (old + 1u == (gen + 1u) * nloc) {
            __builtin_amdgcn_fence(__ATOMIC_RELEASE, "agent");
            asm volatile("s_waitcnt vmcnt(0)" ::: "memory");
            const unsigned og = xb_add(&bar[XB_TOP], 1u);
            const unsigned tg = og / nx;
            if (og + 1u == (tg + 1u) * nx) xb_add(&bar[XB_TOPGEN], 1u);
            else XB_SPIN(xb_ld(&bar[XB_TOPGEN]) == tg, bar);
            __builtin_amdgcn_fence(__ATOMIC_ACQUIRE, "agent");
            xb_add(&bar[XB_XGEN(b.x)], 1u);
            asm volatile("s_waitcnt vmcnt(0)" ::: "memory");
        } else {
            XB_SPIN(xb_ld(&bar[XB_XGEN(b.x)]) == gen, bar);
            __builtin_amdgcn_fence(__ATOMIC_ACQUIRE, "agent");
            asm volatile("s_waitcnt vmcnt(0)" ::: "memory");
        }
    }
    __syncthreads();
}


struct Args { const float* in[29]; float* out; unsigned char* ws; };
enum { I_X = 0, I_C, I_CTX, I_CCTX, I_ADAW, I_ADAB, I_NMIX, I_NFFN, I_WIN, I_WOUT, I_QN, I_KN, I_SINK, I_HCW, I_HCB, I_HW1, I_HB1, I_HW2, I_HB2, I_HW3, I_HB3, I_HW4, I_HFREQ, I_HBIASD, I_SCW, I_WUP, I_FCW, I_FCB, I_WDOWN };

#ifndef PHMASK
#define PHMASK 0xffffffffu
#endif
#define PH(n) ((PHMASK >> (n)) & 1u)
#ifndef DBL
#define DBL 0
#endif
#define REP(b) for (int rep_ = 0; rep_ < (((DBL >> (b)) & 1) ? 2 : 1); ++rep_)
#define GSYNC() do { xcd_barrier(xbar); if (DBL & 1) xcd_barrier(xbar); } while (0)
typedef const float* const __attribute__((address_space(4))) * kargp_t;
#define IDS() int tid = threadIdx.x; asm volatile("" : "+v"(tid)); const int lane = tid & 63, wave = __builtin_amdgcn_readfirstlane(tid >> 6); int bx = blockIdx.x; asm volatile("" : "+s"(bx)); \
    const int gw = bx * 8 + wave, G = gridDim.x, ngw = G * 8; (void)lane; (void)gw; (void)wave; (void)ngw; \
    unsigned long long kb_ = (unsigned long long)__builtin_amdgcn_kernarg_segment_ptr(); asm volatile("" : "+s"(kb_)); const kargp_t KA = (kargp_t)kb_; \
    unsigned char* const ws = (unsigned char*)KA[30]; float* const OUT = (float*)KA[29]; (void)ws; (void)OUT; \
    const bool last = layer == 1; (void)last
#define IN(i) (KA[i])
#define P_MOD ((float*)(ws + WS_MOD))
#define P_TW ((f32x2v*)(ws + WS_TW))
#define P_ROPE ((f32x2v*)(ws + WS_ROPE))
#define P_FSUMC ((float*)(ws + WS_FSUMC))
#define P_FSUM ((float*)(ws + WS_FSUM))
#define P_KC ((float*)(ws + WS_KC))
#define P_UC ((float*)(ws + WS_UC))
#define P_XC ((float*)(ws + WS_XC))
#define P_XN ((bf16*)(ws + WS_XN))
#define P_Z ((bf16*)(ws + WS_Z))
#define P_OC ((bf16*)(ws + WS_OC))
#define P_UT ((float*)(ws + WS_UT))
#define P_KF ((f32x2v*)(ws + WS_KF))
#define P_AV ((bf16*)(ws + WS_AV))
#define P_G ((bf16*)(ws + WS_G))
#define P_EA ((float*)(ws + WS_EA))
#define P_EV ((float*)(ws + WS_EV))
#define P_MODL (P_MOD + (size_t)layer * 5 * 6144)
#define P_WB (ws + WS_WB + (size_t)layer * WB_LAYER)
#define RES_L (last ? (const float*)OUT : IN(I_X))
#define RES_C (last ? (const float*)P_XC : IN(I_CTX))
__global__ void __launch_bounds__(NTHR, 2) hfb_fwd(Args a) {
    extern __shared__ __attribute__((aligned(16))) unsigned char lds[];
    cg::grid_group grid = cg::this_grid();
    LAS unsigned char* L = (LAS unsigned char*)lds;
    (void)a;
    volatile LAS unsigned* xst = (volatile LAS unsigned*)(L + LDS_BYTES - 64);
    if (threadIdx.x < 2) xst[threadIdx.x] = 0u;
    __syncthreads();
    XcdBarrier xbar;
    { unsigned long long kb0 = (unsigned long long)__builtin_amdgcn_kernarg_segment_ptr(); unsigned char* ws0 = (unsigned char*)((kargp_t)kb0)[30]; xbar = xcd_barrier_post((unsigned*)(ws0 + WS_BAR), xst); }
    { const int layer = 0; IDS(); if (PH(0)) p0_weights(IN(I_WIN), IN(I_WOUT), IN(I_WUP), IN(I_WDOWN), ws + WS_WB, (LAS float*)(L + wave * 16384), gw, ngw, lane);
      __syncthreads(); }
    { const int layer = 0; IDS(); if (PH(1)) for (int it = bx; it < 192 + 20 + 264; it += G) {
        if (it < 192) p0_mod_item(IN(I_C), IN(I_CCTX), IN(I_ADAW), IN(I_ADAB), P_MOD, (LAS float*)L, it, tid);
        else if (it < 208) { const int k = (it - 192) * NTHR + tid; float s, c; sincospif(2.0f * (float)k / (float)NFFT, &s, &c); P_TW[k] = (f32x2v){c, -s}; }
        else if (it < 212) { const int e = (it - 208) * NTHR + tid, pos = e >> 4, f = e & 15; const float inv_pi = exp2f(-(float)f * 0.8304820237218406f) * 0.3183098861837907f; float sn, cs; sincospif((float)pos * inv_pi, &sn, &cs); P_ROPE[e] = (f32x2v){cs, sn}; }
        else if (it < 212 + 256) p0_filter_item<false>(IN(I_HW1), IN(I_HB1), IN(I_HW2), IN(I_HB2), IN(I_HW3), IN(I_HB3), IN(I_HW4), IN(I_HFREQ), P_UT, P_FSUM, (LAS float*)L, it - 212, tid);
        else p0_filter_item<true>(IN(I_HW1), IN(I_HB1), IN(I_HW2), IN(I_HB2), IN(I_HW3), IN(I_HB3), IN(I_HW4), IN(I_HFREQ), P_KC, P_FSUMC, (LAS float*)L, it - 468, tid);
    } }
    grid.sync();

#pragma unroll 1
    for (int layer = 0; layer < 2; ++layer) {
        { IDS(); if (PH(2)) if (!last) REP(2) for (int c = bx; c < CW; c += G) filter_fft_item(P_UT, P_FSUM, P_KF, P_TW, (LAS f32x2v*)L, (LAS float*)(L + FFT_LDS_ELEMS * 8), c, tid);
          if (PH(3)) REP(3) modulate_rows(RES_L, RES_C, IN(I_NMIX) + layer * DM, P_MODL, 0, P_XN, 0, MT, gw, ngw, lane); }
        GSYNC();
        { IDS(); if (PH(4)) REP(6) { pg8::Gemm g{P_XN, (const bf16*)(P_WB + WB_IN), MT, ZW, DM}; pg8::StaticOrder S; S.init(MT, ZW, G, bx); EpiStoreBf16 E{P_Z, ZW};
          pg8::gemm_phase<EpiStoreBf16, pg8::StaticOrder, true, true>(L, g, S, E); } }
        GSYNC();
        { IDS(); if (PH(5)) qk_norm_rope(P_Z, IN(I_QN) + layer * 64, IN(I_KN) + layer * 64, P_ROPE, bx, G, tid);
          if (PH(6)) { if (!last) hyena_pre(P_Z, IN(I_HCW), IN(I_HCB), P_OC, P_UT, P_UC, (LAS float*)L, bx, G, tid);
                       else short_conv(P_Z, IN(I_SCW), P_OC, bx, G, tid); } }
        GSYNC();
        if (layer == 0) {
            { IDS(); if (PH(7)) for (int it = bx; it < 1024; it += G) conv_fft_item(P_UT, P_KF, P_TW, IN(I_HBIASD), (LAS f32x2v*)L, it, tid);
              if (PH(8)) for (int it = bx; it < 1024; it += G) ctx_conv_item(P_KC, P_FSUMC, P_UC, IN(I_HBIASD), P_OC, it, tid);
              __syncthreads(); }
            { IDS(); const int vcu = (G % 8 == 0) ? (bx % 8) * (G / 8) + bx / 8 : bx;
              if (PH(9)) REP(1) for (int i = 0; i < 5; ++i) {
                const int u = i * 256 + vcu; if (i == 4 && vcu >= 32) break;
                const attn_body::bf16* Zb = (const attn_body::bf16*)P_Z; attn_body::bf16* Ob = (attn_body::bf16*)P_OC;
                int b, h, NT; size_t qrow, lrow;
                if (i < 4) { const int bh = u >> 5, qb = u & 31; b = bh >> 3; h = bh & 7; qrow = (size_t)b * SEQ + qb * 256; lrow = (size_t)b * SEQ; NT = 4 + SEQ / 64; }
                else { b = vcu >> 3; h = vcu & 7; qrow = (size_t)ML + b * CTXL; lrow = qrow; NT = 4; }
                const int kvh = h >> 1; const size_t crow = (size_t)ML + b * CTXL;
                attn_body::attn_unit<8, false>(Zb + qrow * ZW + h * 64, Zb + crow * ZW + 512 + kvh * 64, Zb + lrow * ZW + 512 + kvh * 64, Zb + crow * ZW + 768 + kvh * 64, Zb + lrow * ZW + 768 + kvh * 64,
                                               Ob + qrow * DM + h * 64, NT, 0, 0, 0.f, (char*)lds);
              } }
        } else {
            { IDS(); const int vcu = (G % 8 == 0) ? (bx % 8) * (G / 8) + bx / 8 : bx;
              if (PH(10)) for (int i = 0; i < 4; ++i) {
                const int u = i * 256 + vcu, bh = u >> 5, qb = u & 31, b = bh >> 3, h = bh & 7, kvh = h >> 1;
                const int q0 = qb * 256, klo = q0 - 128 < 0 ? 0 : q0 - 128, khi = q0 + 384 > SEQ ? SEQ : q0 + 384;
                const size_t qrow = (size_t)b * SEQ + q0, crow = (size_t)ML + b * CTXL, lrow = (size_t)b * SEQ + klo;
                const attn_body::bf16* Zb = (const attn_body::bf16*)P_Z; attn_body::bf16* Ob = (attn_body::bf16*)P_OC;
                attn_body::attn_unit<8, true>(Zb + qrow * ZW + h * 64, Zb + crow * ZW + 512 + kvh * 64, Zb + lrow * ZW + 512 + kvh * 64, Zb + crow * ZW + 768 + kvh * 64, Zb + lrow * ZW + 768 + kvh * 64,
                                              Ob + qrow * DM + h * 64, 4 + (khi - klo) / 64, q0, klo, IN(I_SINK)[h] * 1.4426950408889634f, (char*)lds);
              } }
        }
        GSYNC();
        if (layer == 0) { { IDS(); if (PH(11)) hyena_post(P_UT, P_OC, (LAS float*)L, bx, G, tid); } GSYNC(); }
        { IDS(); const int mrows = last ? ML : MT;
          if (PH(12)) { pg8::Gemm g{P_OC, (const bf16*)(P_WB + WB_OUT), mrows, DM, DM}; pg8::StaticOrder S; S.init(mrows, DM, G, bx);
          EpiRes E{RES_L, OUT, RES_C, P_XC, P_MODL + 2 * 1024, 0};
          pg8::gemm_phase<EpiRes, pg8::StaticOrder, true, true>(L, g, S, E); } }
        GSYNC();
        { IDS(); const int mrows = last ? ML : MT; if (PH(13)) REP(3) modulate_rows(OUT, P_XC, IN(I_NFFN) + layer * DM, P_MODL, 3 * 1024, P_XN, 0, mrows, gw, ngw, lane); }
        GSYNC();
        { IDS(); const int mrows = last ? ML : MT;
          if (PH(14)) REP(4) { pg8::Gemm g{P_XN, (const bf16*)(P_WB + WB_UP), mrows, FF2, DM}; pg8::StaticOrder S; S.init(mrows, FF2, G, bx);
            EpiGate E{P_G, P_EA, P_EV, IN(I_FCW) + (size_t)layer * 3 * FF, IN(I_FCB) + (size_t)layer * FF};
            pg8::gemm_phase<EpiGate, pg8::StaticOrder, true, true>(L, g, S, E); } }
        GSYNC();
        { IDS(); const int mrows = last ? ML : MT; if (PH(15)) ffn_fixup(P_G, P_EA, P_EV, IN(I_FCW) + (size_t)layer * 3 * FF, IN(I_FCB) + (size_t)layer * FF, mrows / 64, bx * NTHR + tid, G * NTHR); }
        GSYNC();
        { IDS(); const int mrows = last ? ML : MT;
          if (PH(16)) { pg8::Gemm g{P_G, (const bf16*)(P_WB + WB_DOWN), mrows, DM, FF}; pg8::StaticOrder S; S.init(mrows, DM, G, bx);
            EpiRes E{OUT, OUT, P_XC, P_XC, P_MODL + 5 * 1024, 0};
            pg8::gemm_phase<EpiRes, pg8::StaticOrder, true, true>(L, g, S, E); } }
        if (layer == 0) GSYNC();
    }
}

extern "C" void kernel_launch(void* const* d_in, const int* in_sizes, int n_in, void* d_out, int out_size, void* d_ws, size_t ws_size, hipStream_t stream) {
    static int grid = 0;
    if (grid == 0) {
        if (n_in != 29 || out_size != ML * DM || ws_size < WS_END) { fprintf(stderr, "kernel_launch: unexpected shapes (n_in %d, out %d, ws %zu < %zu)\n", n_in, out_size, ws_size, (size_t)WS_END); grid = -1; return; }
        int dev = 0, cus = 0, per_cu = 0;
        hipGetDevice(&dev); hipDeviceGetAttribute(&cus, hipDeviceAttributeMultiprocessorCount, dev);
        if (hipFuncSetAttribute((const void*)hfb_fwd, hipFuncAttributeMaxDynamicSharedMemorySize, LDS_BYTES) != hipSuccess) { fprintf(stderr, "kernel_launch: hipFuncSetAttribute failed\n"); grid = -1; return; }
        if (hipOccupancyMaxActiveBlocksPerMultiprocessor(&per_cu, (const void*)hfb_fwd, NTHR, LDS_BYTES) != hipSuccess || per_cu < 1) { fprintf(stderr, "kernel_launch: occupancy query says %d\n", per_cu); per_cu = 1; }
        (void)hipGetLastError();
        grid = cus;
    }
    if (grid < 0) return;
    if (hipMemsetAsync((char*)d_ws + WS_BAR, 0, XCD_BAR_WORDS * 4, stream) != hipSuccess) { fprintf(stderr, "kernel_launch: memset of the barrier words failed\n"); return; }
    Args a{};
    for (int i = 0; i < 29; ++i) a.in[i] = (const float*)d_in[i];
    a.out = (float*)d_out; a.ws = (unsigned char*)d_ws;
    void* args[] = {&a};
    hipError_t e = hipLaunchCooperativeKernel((const void*)hfb_fwd, dim3(grid), dim3(NTHR), args, LDS_BYTES, stream);
    if (e != hipSuccess) fprintf(stderr, "cooperative launch failed: %s (grid %d)\n", hipGetErrorString(e), grid);
}
```

```cpp
#include <hip/hip_runtime.h>
#include <hip/hip_cooperative_groups.h>
#include <hip/hip_bf16.h>
#include <cstdio>
#include <cstdint>
#include <cmath>
namespace cg = cooperative_groups;
namespace pg8 {
#define PG8_LAS __attribute__((address_space(3)))
typedef unsigned short bf16_t;
typedef short bf16x8 __attribute__((ext_vector_type(8)));
typedef float f32x4 __attribute__((ext_vector_type(4)));
typedef unsigned u32x4 __attribute__((ext_vector_type(4)));
constexpr int BM = 256, BK = 64, HALF = 128, HTB = HALF * BK * 2  , STAGE_BYTES = 8 * HTB, NXCD = 8, WGM = 8;

__host__ __device__ __forceinline__ int lds_byte(int r, int c) { const int st = (r >> 4) * 2 + (c >> 5), rr = r & 15, cc = c & 31, ob = rr * 64 + cc * 2; return st * 1024 + (ob ^ (((ob >> 9) & 1) << 5)); }
__host__ __device__ __forceinline__ void stage_rc(int b, int& R, int& C) { const int st = b / 1024, sb = b % 1024, swz = sb ^ (((sb >> 9) & 1) << 5); R = (st >> 1) * 16 + swz / 64; C = (st & 1) * 32 + (swz % 64) / 2; }
__host__ __device__ __forceinline__ int perm32(int rho) { const int n = rho >> 4, i = rho & 15; return 8 * (i >> 2) + 4 * n + (i & 3); }

struct Unit { int pm, pn; };
struct Gemm { const bf16_t* A; const bf16_t* Bt; int M, N, K, ld; };

struct StaticOrder {
    int nM, nN, nwg, G, c;
    __host__ __device__ void init(int M, int N, int G_, int c_) { nM = M / BM; nN = N / BM; nwg = nM * nN; G = G_; c = c_; }
    __host__ __device__ bool next(int i, Unit& u) const {
        const long L = (long)i * G + c; if (L >= nwg) return false;
        int wgid = (int)L; { const int q = nwg / NXCD, r = nwg % NXCD, xcd = wgid % NXCD, off = wgid / NXCD; wgid = (xcd < r ? xcd * (q + 1) : r * (q + 1) + (xcd - r) * q) + off; }
        const int nig = WGM * nN, gid = wgid / nig, fm = gid * WGM, gsz = (nM - fm) < WGM ? (nM - fm) : WGM;
        u.pm = fm + ((wgid % nig) % gsz); u.pn = (wgid % nig) / gsz; return true;
    }
    __device__ __forceinline__ void a_ready(const Unit&) const {}
    __device__ __forceinline__ void done(const Unit&) const {}
};

__device__ __forceinline__ unsigned cvt_pk_bf16(float lo, float hi) { unsigned r; asm volatile("v_cvt_pk_bf16_f32 %0, %1, %2" : "=v"(r) : "v"(lo), "v"(hi)); return r; }
template <class Epi, class Sched, bool ALIGN_EPI = false, bool SP2 = false>
__device__ __forceinline__ void gemm_phase(PG8_LAS unsigned char* lds, const Gemm g, const Sched& S, const Epi& E) {
    int tid_o = threadIdx.x; asm volatile("" : "+v"(tid_o));
    const int tid = tid_o, wid = __builtin_amdgcn_readfirstlane(tid >> 6), lane = tid & 63, wr = wid >> 2, wc = wid & 3, fr = lane & 15, fq = lane >> 4;
    const int K = g.K, nt = K / BK, LD = g.ld ? g.ld : g.K;
    unsigned voffA[2], voffB[2];
#pragma unroll
    for (int i = 0; i < 2; ++i) { int R, C; stage_rc(tid * 16 + i * 8192, R, C); const int Rb = Epi::PERM ? ((R & ~31) + perm32(R & 31)) : R;
        voffA[i] = (unsigned)(R * LD + C) * 2u; voffB[i] = (unsigned)(Rb * LD + C) * 2u; }
    const size_t kstep = (size_t)(BK * 2);
    const size_t hstep = (size_t)HALF * LD * 2;
    const size_t tstep = 2 * hstep;
    const unsigned ldsw = (unsigned)wid * 1024u;
    const int aoff = lds_byte(wr * 64 + fr, fq * 8), boff = lds_byte(wc * 32 + fr, fq * 8);
#define PG8_SA(b, h) (((b) * 2 + (h)) * HTB)
#define PG8_SB(b, h) ((4 + (b) * 2 + (h)) * HTB)
#define PG8_STAGE(bufoff, gbase, voff) do { _Pragma("unroll") for (int _i = 0; _i < 2; ++_i) \
        __builtin_amdgcn_global_load_lds((const unsigned*)((const char*)(gbase) + (voff)[_i]), (PG8_LAS unsigned*)(lds + (bufoff) + ldsw + _i * 8192), 16, 0, 0); } while (0)
#define PG8_LDA(dst, b, h) do { _Pragma("unroll") for (int m = 0; m < 4; ++m) _Pragma("unroll") for (int k = 0; k < 2; ++k) dst[m][k] = *(const PG8_LAS bf16x8*)(lds + PG8_SA(b, h) + aoff + m * 2048 + k * 1024); } while (0)
#define PG8_LDB(dst, b, h) do { _Pragma("unroll") for (int n = 0; n < 2; ++n) _Pragma("unroll") for (int k = 0; k < 2; ++k) dst[n][k] = *(const PG8_LAS bf16x8*)(lds + PG8_SB(b, h) + boff + n * 2048 + k * 1024); } while (0)
#define PG8_MMA(ai, bj, At, Bt) do { __builtin_amdgcn_s_setprio(1); _Pragma("unroll") for (int m = 0; m < 4; ++m) _Pragma("unroll") for (int n = 0; n < 2; ++n) _Pragma("unroll") for (int k = 0; k < 2; ++k) \
        acc[ai][bj][m][n] = __builtin_amdgcn_mfma_f32_16x16x32_bf16(Bt[n][k], At[m][k], acc[ai][bj][m][n], 0, 0, 0); __builtin_amdgcn_s_setprio(0); } while (0)
#define PG8_WAIT_V(n) asm volatile("s_waitcnt vmcnt(" #n ")" ::: "memory")
#define PG8_WAIT_L(n) asm volatile("s_waitcnt lgkmcnt(" #n ")" ::: "memory")
#define PG8_BAR __builtin_amdgcn_s_barrier()
#define PG8_SCHED __builtin_amdgcn_sched_barrier(0)
    Unit cur, nxt; int ui = 0;
    if (!S.next(0, cur)) return;
    f32x4 acc[2][2][4][2];
#pragma unroll
    for (int a = 0; a < 2; ++a)
#pragma unroll
        for (int b = 0; b < 2; ++b)
#pragma unroll
            for (int m = 0; m < 4; ++m)
#pragma unroll
                for (int n = 0; n < 2; ++n) acc[a][b][m][n] = (f32x4){0.f, 0.f, 0.f, 0.f};
    bf16x8 At[4][2], B0[2][2], B1[2][2];
    const char* cA = (const char*)g.A + (size_t)cur.pm * tstep; const char* cB = (const char*)g.Bt + (size_t)cur.pn * tstep;
    S.a_ready(cur);
    if constexpr (SP2) {
        PG8_STAGE(PG8_SB(0, 0), cB, voffB); PG8_STAGE(PG8_SB(0, 1), cB + hstep, voffB); PG8_STAGE(PG8_SA(0, 0), cA, voffA); PG8_STAGE(PG8_SA(0, 1), cA + hstep, voffA);
        if (wr == 1) PG8_BAR;
        PG8_WAIT_V(2); PG8_BAR;
        PG8_STAGE(PG8_SB(1, 0), cB + kstep, voffB); PG8_STAGE(PG8_SA(1, 0), cA + kstep, voffA); PG8_STAGE(PG8_SB(1, 1), cB + hstep + kstep, voffB);
        PG8_WAIT_V(6); PG8_BAR;
    } else {
        PG8_STAGE(PG8_SB(0, 0), cB, voffB); PG8_STAGE(PG8_SA(0, 0), cA, voffA); PG8_STAGE(PG8_SB(0, 1), cB + hstep, voffB); PG8_STAGE(PG8_SA(0, 1), cA + hstep, voffA);
        if (wr == 1) PG8_BAR;
        PG8_WAIT_V(4); PG8_BAR;
        PG8_STAGE(PG8_SB(1, 0), cB + kstep, voffB); PG8_STAGE(PG8_SA(1, 0), cA + kstep, voffA); PG8_STAGE(PG8_SB(1, 1), cB + hstep + kstep, voffB);
        PG8_WAIT_V(6); PG8_BAR;
    }
    for (;;) {
        const bool has_next = S.next(ui + 1, nxt);
        const char* nA = has_next ? (const char*)g.A + (size_t)nxt.pm * tstep : cA; const char* nB = has_next ? (const char*)g.Bt + (size_t)nxt.pn * tstep : cB;
        for (int t = 0; t < nt; t += 2) {
            const bool last = (t == nt - 2);
            const char* a1 = cA + (size_t)(t + 1) * kstep;
            const char* a2 = last ? nA : cA + (size_t)(t + 2) * kstep; const char* b2 = last ? nB : cB + (size_t)(t + 2) * kstep;
            const char* a3 = a2 + kstep; const char* b3 = b2 + kstep;
            if (last && has_next) S.a_ready(nxt);
            if constexpr (SP2) {
            PG8_LDB(B0, 0, 0); PG8_LDB(B1, 0, 1); PG8_SCHED; PG8_LDA(At, 0, 0); PG8_STAGE(PG8_SA(1, 1), a1 + hstep, voffA);
            PG8_WAIT_V(8); PG8_WAIT_L(0); PG8_BAR; PG8_MMA(0, 0, At, B0); PG8_MMA(0, 1, At, B1); PG8_BAR; PG8_SCHED;
            PG8_LDA(At, 0, 1); PG8_STAGE(PG8_SB(0, 0), b2, voffB); PG8_STAGE(PG8_SB(0, 1), b2 + hstep, voffB); PG8_STAGE(PG8_SA(0, 0), a2, voffA);
            PG8_WAIT_V(8); PG8_WAIT_L(0); PG8_BAR; PG8_MMA(1, 0, At, B0); PG8_MMA(1, 1, At, B1); PG8_BAR; PG8_SCHED;
            PG8_LDB(B0, 1, 0); PG8_LDB(B1, 1, 1); PG8_SCHED; PG8_LDA(At, 1, 0); PG8_STAGE(PG8_SA(0, 1), a2 + hstep, voffA);
            PG8_WAIT_V(8); PG8_WAIT_L(0); PG8_BAR; PG8_MMA(0, 0, At, B0); PG8_MMA(0, 1, At, B1); PG8_BAR; PG8_SCHED;
            PG8_LDA(At, 1, 1); PG8_STAGE(PG8_SB(1, 0), b3, voffB); PG8_STAGE(PG8_SB(1, 1), b3 + hstep, voffB); PG8_STAGE(PG8_SA(1, 0), a3, voffA);
            PG8_WAIT_V(8); PG8_WAIT_L(0); PG8_BAR; PG8_MMA(1, 0, At, B0); PG8_MMA(1, 1, At, B1); PG8_BAR; PG8_SCHED;
            } else {
            PG8_LDB(B0, 0, 0); PG8_SCHED; PG8_LDA(At, 0, 0); PG8_STAGE(PG8_SA(1, 1), a1 + hstep, voffA);
            PG8_WAIT_L(8); PG8_BAR; PG8_WAIT_L(0); PG8_MMA(0, 0, At, B0); PG8_BAR; PG8_SCHED;
            PG8_LDB(B1, 0, 1); PG8_STAGE(PG8_SB(0, 0), b2, voffB);
            PG8_BAR; PG8_WAIT_L(0); PG8_MMA(0, 1, At, B1); PG8_BAR;
            PG8_LDA(At, 0, 1); PG8_STAGE(PG8_SA(0, 0), a2, voffA);
            PG8_BAR; PG8_WAIT_L(0); PG8_MMA(1, 0, At, B0); PG8_BAR; PG8_SCHED;
            PG8_STAGE(PG8_SB(0, 1), b2 + hstep, voffB);
            PG8_WAIT_V(6); PG8_BAR; PG8_MMA(1, 1, At, B1); PG8_BAR;
            PG8_LDB(B0, 1, 0); PG8_SCHED; PG8_LDA(At, 1, 0); PG8_STAGE(PG8_SA(0, 1), a2 + hstep, voffA);
            PG8_WAIT_L(8); PG8_BAR; PG8_WAIT_L(0); PG8_MMA(0, 0, At, B0); PG8_BAR; PG8_SCHED;
            PG8_LDB(B1, 1, 1); PG8_STAGE(PG8_SB(1, 0), b3, voffB);
            PG8_BAR; PG8_WAIT_L(0); PG8_MMA(0, 1, At, B1); PG8_BAR;
            PG8_LDA(At, 1, 1); PG8_STAGE(PG8_SA(1, 0), a3, voffA);
            PG8_BAR; PG8_WAIT_L(0); PG8_MMA(1, 0, At, B0); PG8_BAR; PG8_SCHED;
            PG8_STAGE(PG8_SB(1, 1), b3 + hstep, voffB);
            PG8_WAIT_V(6); PG8_BAR; PG8_MMA(1, 1, At, B1); PG8_BAR;
            }
        }
        if constexpr (ALIGN_EPI) { if (wr == 0) PG8_BAR; }
        if constexpr (!Epi::AFTER_DRAIN) { E(acc, cur, wr, wc, fr, fq); S.done(cur); }
        if (!has_next) break;
#pragma unroll
        for (int a = 0; a < 2; ++a)
#pragma unroll
            for (int b = 0; b < 2; ++b)
#pragma unroll
                for (int m = 0; m < 4; ++m)
#pragma unroll
                    for (int n = 0; n < 2; ++n) acc[a][b][m][n] = (f32x4){0.f, 0.f, 0.f, 0.f};
        cur = nxt; cA = nA; cB = nB; ++ui;
        if constexpr (ALIGN_EPI) { if (wr == 1) PG8_BAR; }
    }
    PG8_WAIT_V(0);
    if constexpr (!ALIGN_EPI) { if (wr == 0) PG8_BAR; }
    PG8_BAR;
    if constexpr (Epi::AFTER_DRAIN) { E.fused(acc, cur, wr, wc, fr, fq, lds, wid, lane); S.done(cur); }
#undef PG8_SA
#undef PG8_SB
#undef PG8_STAGE
#undef PG8_LDA
#undef PG8_LDB
#undef PG8_MMA
#undef PG8_WAIT_V
#undef PG8_WAIT_L
#undef PG8_BAR
#undef PG8_SCHED
}
}
#include <hip/hip_bf16.h>
#include <cmath>
namespace attn_body {
using bf16=__hip_bfloat16;
using bf16x8=__attribute__((ext_vector_type(8)))short;
using s16x4=__attribute__((ext_vector_type(4)))short;
using f32x16=__attribute__((ext_vector_type(16)))float;
using u32x4=__attribute__((ext_vector_type(4)))unsigned;
constexpr int D=64,ZP=2560,OP=1024;
constexpr int NW=8,QBLK=32,QB=QBLK*NW,KVBLK=64;
__device__ __forceinline__ int crow(int r,int hi){return (r&3)+8*(r>>2)+4*hi;}
#define SBAR() __builtin_amdgcn_sched_barrier(0)
__device__ __forceinline__ void cmask(f32x16&p0,f32x16&p1,int jb,int qrel,int hi){
  const float NEG=-INFINITY; int kb=64*jb+4*hi;
  #pragma unroll
  for(int r=0;r<16;++r){int kv=kb+(r&3)+8*(r>>2); if(kv>qrel)p0[r]=NEG; if(kv+32>qrel)p1[r]=NEG;}
}

__device__ __forceinline__ void bandmask(f32x16&p0,f32x16&p1,int ktile0,int qabs,int hi){
  const float NEG=-INFINITY; const int kb=ktile0+4*hi-qabs;
  #pragma unroll
  for(int r=0;r<16;++r){int d=kb+(r&3)+8*(r>>2); if(d>128||d<-128)p0[r]=NEG; if(d+32>128||d+32<-128)p1[r]=NEG;}
}
constexpr int NSLOT=3, SLOTB=8192;
constexpr int LDS_K=0, LDS_V=NSLOT*SLOTB, LDS_WS=2*NSLOT*SLOTB, LDS_OST=LDS_WS+NW*64*4, LDS_BYTES=LDS_OST+NW*4096;
constexpr float C2=0.125f*1.4426950408889634f;
__device__ __forceinline__ void glds16(const void*gsrc,unsigned lds_dst){unsigned keep;
  asm volatile("s_mov_b32 %0, m0\n\ts_mov_b32 m0, %2\n\ts_nop 0\n\tglobal_load_lds_dwordx4 %1, off\n\ts_mov_b32 m0, %0":"=&s"(keep):"v"(gsrc),"s"(lds_dst):"memory");}
__device__ __forceinline__ float max3f(float a,float b,float c){float r;asm("v_max3_f32 %0, %1, %2, %3":"=v"(r):"v"(a),"v"(b),"v"(c));return r;}
__device__ __forceinline__ float max2f(float a,float b){float r;asm("v_max_f32_e32 %0, %1, %2":"=v"(r):"v"(a),"v"(b));return r;}
__device__ __forceinline__ float fadd_s(float a,float b){float r;asm("v_add_f32_e32 %0, %1, %2":"=v"(r):"v"(a),"v"(b));return r;}
__device__ __forceinline__ float fsub_s(float a,float b){float r;asm("v_sub_f32_e32 %0, %1, %2":"=v"(r):"v"(a),"v"(b));return r;}
typedef float f32x2_t __attribute__((ext_vector_type(2))); typedef __bf16 bf16x2_t __attribute__((ext_vector_type(2)));
__device__ __forceinline__ unsigned cvtpk_s(float lo,float hi){f32x2_t v={lo,hi};bf16x2_t b=__builtin_convertvector(v,bf16x2_t);return __builtin_bit_cast(unsigned,b);}
#define WAIT_BAR(N) asm volatile("s_waitcnt vmcnt(" #N ") lgkmcnt(0)\n\ts_barrier":::"memory")

__device__ __forceinline__ void qkt(f32x16&p0,f32x16&p1,const char*Kslot,const bf16x8*qr,const f32x16&negm,int r32,int hi){
  const char*kb=Kslot+hi*1024+r32*16;
  #pragma unroll
  for(int d0=0;d0<4;++d0){
    const bf16x8 b0=*reinterpret_cast<const bf16x8*>(kb+d0*2048);
    const bf16x8 b1=*reinterpret_cast<const bf16x8*>(kb+d0*2048+512);
    if(d0==0){p0=__builtin_amdgcn_mfma_f32_32x32x16_bf16(b0,qr[0],negm,0,0,0);p1=__builtin_amdgcn_mfma_f32_32x32x16_bf16(b1,qr[0],negm,0,0,0);}
    else{p0=__builtin_amdgcn_mfma_f32_32x32x16_bf16(b0,qr[d0],p0,0,0,0);p1=__builtin_amdgcn_mfma_f32_32x32x16_bf16(b1,qr[d0],p1,0,0,0);}}
}
typedef __attribute__((address_space(3))) const char* lds_cptr;
typedef short v4i16_t __attribute__((ext_vector_type(4)));
__device__ __forceinline__ void kload8(bf16x8*kf,lds_cptr kp){
  kf[0]=*(const __attribute__((address_space(3))) bf16x8*)(kp);      kf[1]=*(const __attribute__((address_space(3))) bf16x8*)(kp+512);
  kf[2]=*(const __attribute__((address_space(3))) bf16x8*)(kp+2048); kf[3]=*(const __attribute__((address_space(3))) bf16x8*)(kp+2560);
  kf[4]=*(const __attribute__((address_space(3))) bf16x8*)(kp+4096); kf[5]=*(const __attribute__((address_space(3))) bf16x8*)(kp+4608);
  kf[6]=*(const __attribute__((address_space(3))) bf16x8*)(kp+6144); kf[7]=*(const __attribute__((address_space(3))) bf16x8*)(kp+6656);
}
__device__ __forceinline__ void kload2(bf16x8*kf,lds_cptr kp,int j){ kf[2*j]=*(const __attribute__((address_space(3))) bf16x8*)(kp+j*2048); kf[2*j+1]=*(const __attribute__((address_space(3))) bf16x8*)(kp+j*2048+512); }
__device__ __forceinline__ s16x4 vtr(lds_cptr p){ return __builtin_bit_cast(s16x4,__builtin_amdgcn_ds_read_tr16_b64_v4i16((__attribute__((address_space(3))) v4i16_t*)p)); }
__device__ __forceinline__ float rowmax(const f32x16&p0,const f32x16&p1){
  float a=max3f(p0[0],p0[1],p1[0]),b=max3f(p0[2],p0[3],p1[1]);a=max3f(a,p1[2],p1[3]);
  #pragma unroll
  for(int r=4;r<16;r+=4){a=max3f(a,p0[r],p0[r+1]);b=max3f(b,p0[r+2],p0[r+3]);a=max3f(a,p1[r],p1[r+1]);b=max3f(b,p1[r+2],p1[r+3]);}
  const float m=max2f(a,b);
  auto rr=__builtin_amdgcn_permlane32_swap(__float_as_uint(m),__float_as_uint(m),false,false);
  return max2f(__uint_as_float(rr[0]),__uint_as_float(rr[1]));
}
__device__ __forceinline__ void pv(f32x16*o,int vb,bf16x8 pa0,bf16x8 pa1,bf16x8 pa2,bf16x8 pa3){
  #pragma unroll
  for(int d0=0;d0<2;++d0){s16x4 lo[4],hi[4];
    #pragma unroll
    for(int ks=0;ks<4;++ks){
      asm volatile("ds_read_b64_tr_b16 %0,%1 offset:%c2":"=&v"(lo[ks]):"v"(vb),"i"(d0*4096+ks*1024):"memory");
      asm volatile("ds_read_b64_tr_b16 %0,%1 offset:%c2":"=&v"(hi[ks]):"v"(vb),"i"(d0*4096+ks*1024+512):"memory");}
    asm volatile("s_waitcnt lgkmcnt(0)":::"memory");SBAR();
    #define PK(k) (bf16x8){lo[k][0],lo[k][1],lo[k][2],lo[k][3],hi[k][0],hi[k][1],hi[k][2],hi[k][3]}
    o[d0]=__builtin_amdgcn_mfma_f32_32x32x16_bf16(pa0,PK(0),o[d0],0,0,0);
    o[d0]=__builtin_amdgcn_mfma_f32_32x32x16_bf16(pa1,PK(1),o[d0],0,0,0);
    o[d0]=__builtin_amdgcn_mfma_f32_32x32x16_bf16(pa2,PK(2),o[d0],0,0,0);
    o[d0]=__builtin_amdgcn_mfma_f32_32x32x16_bf16(pa3,PK(3),o[d0],0,0,0);
    #undef PK
  }
}

#ifndef ATTN_STORE16
#define ATTN_STORE16(p,v) (*(u32x4*)(p)=(v))
#endif
template<int THRL,bool BANDED> __device__ __forceinline__ void attn_unit(const bf16*Qrows,const bf16*__restrict__ Kc,const bf16*__restrict__ Kl,const bf16*__restrict__ Vc,const bf16*__restrict__ Vl,bf16*Orows,const int NT,const int qpos0,const int kpos0,const float sink_l2,char*shm){
  int tid_o=threadIdx.x; asm volatile("":"+v"(tid_o)); const int tid=tid_o,lane=tid&63,r32=lane&31,hi=lane>>5; const int wid=__builtin_amdgcn_readfirstlane(tid>>6);
  const bf16*Qw=Qrows+(long)(wid*QBLK)*ZP;
  const unsigned lds0=(unsigned)(uintptr_t)shm;
  float*wsf=(float*)(shm+LDS_WS)+wid*64;
  const long koff=(long)lane*ZP+wid*8, voff=(long)(16*(wid&3)+(lane>>2))*ZP+(wid>>2)*32+(lane&3)*8;
  const bf16*ksrc_c=Kc+koff,*ksrc_l=Kl+koff-(long)4*KVBLK*ZP,*vsrc_c=Vc+voff,*vsrc_l=Vl+voff-(long)4*KVBLK*ZP;
  const unsigned kdst=lds0+LDS_K+wid*1024, vdst=lds0+LDS_V+wid*1024;
  #define DMA_K(t,slot) glds16((((t)<4)?ksrc_c:ksrc_l)+(long)(t)*KVBLK*ZP,(unsigned)__builtin_amdgcn_readfirstlane(kdst+(slot)))
  #define DMA_V(t,slot) glds16((((t)<4)?vsrc_c:vsrc_l)+(long)(t)*KVBLK*ZP,(unsigned)__builtin_amdgcn_readfirstlane(vdst+(slot)))
  const int vb0=(int)(lds0+LDS_V)+((lane>>4)&1)*32+(lane&3)*8+(4*hi+((lane&15)>>2))*64;
  const char*Kbase=shm+LDS_K; bf16x8 kf[8];
  const lds_cptr shm3=(lds_cptr)shm; const lds_cptr kp0=shm3+LDS_K+hi*1024+r32*16; const lds_cptr vp0=shm3+LDS_V+((lane>>4)&1)*32+(lane&3)*8+(4*hi+((lane&15)>>2))*64;
  DMA_K(0,0);DMA_V(0,0);DMA_K(1,SLOTB);
  bf16x8 qr[4];
  #pragma unroll
  for(int d0=0;d0<4;++d0)qr[d0]=*reinterpret_cast<const bf16x8*>(&Qw[(long)r32*ZP+d0*16+hi*8]);
  float mhat=0.f,l_reg=0.f;f32x16 o[2];o[0]=f32x16{};o[1]=f32x16{};f32x16 negm=f32x16{};asm volatile("":"+v"(negm));
  const int qrel=wid*QBLK+r32;
  #define CMASK(P0,P1,t) do{ if(BANDED&&(t)>=4) bandmask(P0,P1,kpos0+64*((t)-4),qpos0+qrel,hi); }while(0)
  bool resc=false;
  #define START(P0,P1) do{ const float rm=rowmax(P0,P1); resc=false; \
    { const float dl=rm; mhat=fadd_s(mhat,dl); \
      _Pragma("unroll") for(int r=0;r<16;++r){P0[r]=fsub_s(P0[r],dl);P1[r]=fsub_s(P1[r],dl);} \
      _Pragma("unroll") for(int r=0;r<16;++r)negm[r]=-mhat; asm volatile("":"+v"(negm)); } \
    _Pragma("unroll") for(int r=0;r<16;++r)P0[r]=__builtin_amdgcn_exp2f(P0[r]); }while(0)
  #define RESC() do{ if(resc){ asm volatile("s_waitcnt lgkmcnt(0)":::"memory"); \
      _Pragma("unroll") for(int d_=0;d_<2;++d_) _Pragma("unroll") for(int r=0;r<16;++r)o[d_][r]*=wsf[crow(r,hi)]; } }while(0)
  f32x16 pA0,pA1,pB0,pB1;
  int sl_prev=0,sl_cur=0,sl_next=SLOTB;
  #define ROT() do{sl_prev=sl_cur;sl_cur=sl_next;sl_next=(sl_next==(NSLOT-1)*SLOTB)?0:sl_next+SLOTB;}while(0)
  DMA_K(2,2*SLOTB);
  WAIT_BAR(3);
  qkt(pA0,pA1,Kbase,qr,negm,r32,hi);asm volatile("s_nop 15\n\ts_nop 7":"+v"(pA0),"+v"(pA1));CMASK(pA0,pA1,0);
  START(pA0,pA1);
  _Pragma("unroll") for(int r=0;r<16;++r)pA1[r]=__builtin_amdgcn_exp2f(pA1[r]);
  WAIT_BAR(0);
  DMA_K(3,0);DMA_V(1,SLOTB);
  ROT();
  kload8(kf,kp0+sl_cur);
  WAIT_BAR(2);
  s16x4 vlo[8],vhi[8]; u32x4 pw0,pw1,pw2,pw3;
  #define PKW(P,B) cvtpk_s(P[B],P[B+1])
  #define PAF(k) __builtin_bit_cast(bf16x8,pw##k)
  #define VFR(i) (bf16x8){vlo[i][0],vlo[i][1],vlo[i][2],vlo[i][3],vhi[i][0],vhi[i][1],vhi[i][2],vhi[i][3]}
  #define PIN(x) asm volatile("":"+v"(x))
  #define MX3(a,b,c) __builtin_fmaxf(__builtin_fmaxf((a),(b)),(c))
  #define GAPA(MF,A0,A1,A2,A3,W0,W1,PW) do{ MF; sacc+=A0; sacc+=A1; sacc+=A2; sacc+=A3; PIN(sacc); W0; W1; PIN(PW); SBAR(); }while(0)
  #define EX(v) __builtin_amdgcn_exp2f(v)
  #define GAPB(MF,X,B) do{ MF; X[B]=EX(X[B]); X[B+1]=EX(X[B+1]); X[B+2]=EX(X[B+2]); X[B+3]=EX(X[B+3]); PIN(X); SBAR(); }while(0)
  #define VRD(i) do{ vlo[i]=vtr(vp_+(((i)>>2)*4096+((i)&3)*1024)); vhi[i]=vtr(vp_+(((i)>>2)*4096+((i)&3)*1024+512)); }while(0)
  #define KRD(G,j) do{ if(G){ kload2(kf,kp0+sl_next,j); SBAR(); } }while(0)
  #define STEP(C0,C1,P0,P1,t,GK,GV,GL) do{ SBAR(); \
    const lds_cptr vp_=vp0+sl_prev; \
    VRD(0); SBAR(); float sacc=(P0[0]+P0[1]); \
    GAPA(C0=__builtin_amdgcn_mfma_f32_32x32x16_bf16(kf[0],qr[0],negm,0,0,0), P0[2],P0[3],P0[4],P0[5],     pw0[0]=PKW(P0,0), pw0[1]=PKW(P0,2), pw0); \
    VRD(4); SBAR(); GAPA(C1=__builtin_amdgcn_mfma_f32_32x32x16_bf16(kf[1],qr[0],negm,0,0,0), P0[6],P0[7],P0[8],P0[9],     pw0[2]=PKW(P0,4), pw0[3]=PKW(P0,6), pw0); \
    VRD(1); SBAR(); GAPA(C0=__builtin_amdgcn_mfma_f32_32x32x16_bf16(kf[2],qr[1],C0,0,0,0),   P0[10],P0[11],P0[12],P0[13], pw1[0]=PKW(P0,8), pw1[1]=PKW(P0,10), pw1); \
    VRD(5); SBAR(); GAPA(C1=__builtin_amdgcn_mfma_f32_32x32x16_bf16(kf[3],qr[1],C1,0,0,0),   P0[14],P0[15],P1[0],P1[1],   pw1[2]=PKW(P0,12),pw1[3]=PKW(P0,14), pw1); \
    VRD(2); SBAR(); GAPA(C0=__builtin_amdgcn_mfma_f32_32x32x16_bf16(kf[4],qr[2],C0,0,0,0),   P1[2],P1[3],P1[4],P1[5],     pw2[0]=PKW(P1,0), pw2[1]=PKW(P1,2), pw2); \
    VRD(6); SBAR(); GAPA(C1=__builtin_amdgcn_mfma_f32_32x32x16_bf16(kf[5],qr[2],C1,0,0,0),   P1[6],P1[7],P1[8],P1[9],     pw2[2]=PKW(P1,4), pw2[3]=PKW(P1,6), pw2); \
    VRD(3); SBAR(); GAPA(C0=__builtin_amdgcn_mfma_f32_32x32x16_bf16(kf[6],qr[3],C0,0,0,0),   P1[10],P1[11],P1[12],P1[13], pw3[0]=PKW(P1,8), pw3[1]=PKW(P1,10), pw3); \
    VRD(7); SBAR(); GAPA(C1=__builtin_amdgcn_mfma_f32_32x32x16_bf16(kf[7],qr[3],C1,0,0,0),   P1[14],P1[15],0.f,0.f,       pw3[2]=PKW(P1,12),pw3[3]=PKW(P1,14), pw3); \
    l_reg+=sacc; \
    if(GK){DMA_K((t)+3,sl_cur);} if(GV){DMA_V((t)+1,sl_next);} \
    CMASK(C0,C1,t); \
    { float a=MX3(C0[0],C0[1],C1[0]),b=MX3(C0[2],C0[3],C1[1]); a=MX3(a,C1[2],C1[3]); \
      _Pragma("unroll") for(int r=4;r<16;r+=4){a=MX3(a,C0[r],C0[r+1]);b=MX3(b,C0[r+2],C0[r+3]);a=MX3(a,C1[r],C1[r+1]);b=MX3(b,C1[r+2],C1[r+3]);} \
      float rm=__builtin_fmaxf(a,b); { auto rr=__builtin_amdgcn_permlane32_swap(__float_as_uint(rm),__float_as_uint(rm),false,false); rm=__builtin_fmaxf(__uint_as_float(rr[0]),__uint_as_float(rr[1])); } \
      resc=false; \
      if(__builtin_expect(__any(rm>(float)THRL),0)){ const float dl=__builtin_fmaxf(rm,0.f); mhat+=dl; \
        _Pragma("unroll") for(int r=0;r<16;++r){C0[r]-=dl;C1[r]-=dl;} \
        _Pragma("unroll") for(int r=0;r<16;++r)negm[r]=-mhat; asm volatile("":"+v"(negm)); \
        const float f=__builtin_amdgcn_exp2f(-dl); l_reg*=f; if(hi==0)wsf[r32]=f; resc=true; } } \
    SBAR(); \
    GAPB(o[0]=__builtin_amdgcn_mfma_f32_32x32x16_bf16(PAF(0),VFR(0),o[0],0,0,0), C0,0); \
    GAPB(o[1]=__builtin_amdgcn_mfma_f32_32x32x16_bf16(PAF(0),VFR(4),o[1],0,0,0), C0,4); \
    KRD(GL,0); GAPB(o[0]=__builtin_amdgcn_mfma_f32_32x32x16_bf16(PAF(1),VFR(1),o[0],0,0,0), C0,8); \
    KRD(GL,1); GAPB(o[1]=__builtin_amdgcn_mfma_f32_32x32x16_bf16(PAF(1),VFR(5),o[1],0,0,0), C0,12); \
    KRD(GL,2); GAPB(o[0]=__builtin_amdgcn_mfma_f32_32x32x16_bf16(PAF(2),VFR(2),o[0],0,0,0), C1,0); \
    KRD(GL,3); GAPB(o[1]=__builtin_amdgcn_mfma_f32_32x32x16_bf16(PAF(2),VFR(6),o[1],0,0,0), C1,4); \
    GAPB(o[0]=__builtin_amdgcn_mfma_f32_32x32x16_bf16(PAF(3),VFR(3),o[0],0,0,0), C1,8); \
    GAPB(o[1]=__builtin_amdgcn_mfma_f32_32x32x16_bf16(PAF(3),VFR(7),o[1],0,0,0), C1,12); \
    }while(0)
  int t=1;
  for(;t+5<NT;t+=2){
    STEP(pB0,pB1,pA0,pA1,t,true,true,true);     WAIT_BAR(2); RESC(); ROT();
    STEP(pA0,pA1,pB0,pB1,t+1,true,true,true);   WAIT_BAR(2); RESC(); ROT();
  }
  #undef CMASK
  #define CMASK(P0,P1,t) do{ if(BANDED&&(t)>=4) bandmask(P0,P1,kpos0+64*((t)-4),qpos0+qrel,hi); }while(0)
  #define ENDW(tt) do{ if((tt)+3<NT){WAIT_BAR(2);} else if((tt)+2<NT){WAIT_BAR(1);} else {WAIT_BAR(0);} }while(0)
  for(;t+1<NT;t+=2){
    STEP(pB0,pB1,pA0,pA1,t,(t+3<NT),(t+1<NT),(t+1<NT));       ENDW(t);   RESC(); ROT();
    STEP(pA0,pA1,pB0,pB1,t+1,(t+4<NT),(t+2<NT),(t+2<NT));     ENDW(t+1); RESC(); ROT();
  }
  STEP(pB0,pB1,pA0,pA1,NT-1,false,false,false); RESC();
  { float sacc=pB0[0]+pB0[1]; _Pragma("unroll") for(int r=2;r<16;++r)sacc+=pB0[r]; _Pragma("unroll") for(int r=0;r<16;++r)sacc+=pB1[r]; l_reg+=sacc;
    pw0=(u32x4){PKW(pB0,0),PKW(pB0,2),PKW(pB0,4),PKW(pB0,6)};pw1=(u32x4){PKW(pB0,8),PKW(pB0,10),PKW(pB0,12),PKW(pB0,14)};pw2=(u32x4){PKW(pB1,0),PKW(pB1,2),PKW(pB1,4),PKW(pB1,6)};pw3=(u32x4){PKW(pB1,8),PKW(pB1,10),PKW(pB1,12),PKW(pB1,14)};
    SBAR(); pv(o,vb0+sl_cur,PAF(0),PAF(1),PAF(2),PAF(3)); }
  #undef PKW
  #undef PAF
  #undef VFR
  #undef PIN
  #undef MX3
  #undef GAPA
  #undef GAPB
  #undef EX
  #undef VRD
  #undef KRD
  #undef STEP
  #undef ENDW
  {auto rr=__builtin_amdgcn_permlane32_swap(__float_as_uint(l_reg),__float_as_uint(l_reg),false,false);l_reg=__uint_as_float(rr[0])+__uint_as_float(rr[1]);}
  if(BANDED) l_reg+=__builtin_amdgcn_exp2f(sink_l2-mhat);
  if(hi==0)wsf[32+r32]=l_reg;asm volatile("s_waitcnt lgkmcnt(0)":::"memory");
  float rli[16];
  #pragma unroll
  for(int r=0;r<16;++r)rli[r]=__builtin_amdgcn_rcpf(wsf[32+crow(r,hi)]);
  bf16*Ow=Orows+(long)(wid*QBLK)*OP;
  { bf16*stg=(bf16*)(shm+LDS_OST)+wid*2048;
    #pragma unroll
    for(int r=0;r<16;++r){const int orow=crow(r,hi);
      #pragma unroll
      for(int d0=0;d0<2;++d0)stg[orow*64+d0*32+r32]=__float2bfloat16(o[d0][r]*rli[r]);}
    asm volatile("s_waitcnt lgkmcnt(0)":::"memory");
    #pragma unroll
    for(int i=0;i<4;++i){const int row=i*8+(lane>>3),ch=lane&7; const u32x4 v=*(const u32x4*)(stg+row*64+ch*8); ATTN_STORE16(Ow+(long)row*OP+ch*8,v);} }
  asm volatile("s_waitcnt lgkmcnt(0)\n\ts_barrier":::"memory");
  #undef DMA_K
  #undef DMA_V
  #undef CMASK
  #undef START
  #undef RESC
  #undef ROT
}
constexpr int ATTN_LDS_BYTES=LDS_BYTES;
#undef SBAR
#undef WAIT_BAR
}

#define LAS __attribute__((address_space(3)))
typedef unsigned short bf16;
typedef unsigned v4u __attribute__((ext_vector_type(4)));
typedef float f32x4 __attribute__((ext_vector_type(4)));
typedef float f32x2v __attribute__((ext_vector_type(2)));

constexpr int DM = 1024, NBATCH = 4, SEQ = 8192, CTXL = 256;
constexpr int ML = NBATCH * SEQ, MC = NBATCH * CTXL, MT = ML + MC;
constexpr int ZW = 2560, FF = 2816, FF2 = 5632, CW = 512, NFFT = 16384;
constexpr int NTHR = 512;
constexpr size_t MiB = 1u << 20;
constexpr size_t WS_MOD = 0;
constexpr size_t WS_TW = 256 * 1024;
constexpr size_t WS_ROPE = 320 * 1024;
constexpr size_t WS_FSUMC = 384 * 1024;
constexpr size_t WS_BAR = 448 * 1024;
constexpr size_t WS_FSUM = 1 * MiB;
constexpr size_t WS_KC = 2 * MiB;
constexpr size_t WS_UC = 3 * MiB;
constexpr size_t WS_WB = 5 * MiB;
constexpr size_t WB_IN = 0, WB_OUT = 5 * MiB, WB_UP = 7 * MiB, WB_DOWN = 18 * MiB, WB_LAYER = 23 * MiB + 512 * 1024;
constexpr size_t WS_XC = 52 * MiB;
constexpr size_t WS_XN = 56 * MiB;
constexpr size_t WS_Z = 122 * MiB;
constexpr size_t WS_OC = 287 * MiB;
constexpr size_t WS_PART = 340 * MiB;
constexpr size_t WS_UT = 353 * MiB;
constexpr size_t WS_XR = 353 * MiB;
constexpr size_t WS_KF = 417 * MiB;
constexpr size_t WS_AV = 122 * MiB;
constexpr size_t WS_G = 122 * MiB;
constexpr size_t WS_EA = 304 * MiB;
constexpr size_t WS_EV = 327 * MiB;
constexpr size_t WS_END = 481 * MiB;
constexpr int LDS_BYTES = 147456;

__device__ __forceinline__ unsigned f2bf(float f) { unsigned u = __builtin_bit_cast(unsigned, f); return (u + 0x7fffu + ((u >> 16) & 1u)) >> 16; }
__device__ __forceinline__ unsigned pk2(float lo, float hi) { return f2bf(lo) | (f2bf(hi) << 16); }
__device__ __forceinline__ float bflo(unsigned w) { return __builtin_bit_cast(float, w << 16); }
__device__ __forceinline__ float bfhi(unsigned w) { return __builtin_bit_cast(float, w & 0xffff0000u); }
__device__ __forceinline__ void unpack8(const v4u w, float* f) { f[0] = bflo(w.x); f[1] = bfhi(w.x); f[2] = bflo(w.y); f[3] = bfhi(w.y); f[4] = bflo(w.z); f[5] = bfhi(w.z); f[6] = bflo(w.w); f[7] = bfhi(w.w); }
__device__ __forceinline__ v4u pack8(const float* f) { v4u o; o.x = pk2(f[0], f[1]); o.y = pk2(f[2], f[3]); o.z = pk2(f[4], f[5]); o.w = pk2(f[6], f[7]); return o; }
__device__ __forceinline__ float wave_sum(float v) {
#pragma unroll
    for (int o = 1; o < 64; o <<= 1) v += __shfl_xor(v, o);
    return v;
}

struct EpiStoreBf16 {
    static constexpr bool PERM = true, AFTER_DRAIN = false;
    bf16* O; int ldc; const float* qn; const float* kn; const f32x2v* rope; int pm0, pn0;
    __device__ __forceinline__ void operator()(const pg8::f32x4 (&acc)[2][2][4][2], const pg8::Unit& u, int wr, int wc, int fr, int fq) const {
        const int row0 = u.pm * 256 + wr * 64 + fr, gpn = u.pn + pn0;
        if (qn && gpn < 3) {
            constexpr float C2 = 0.125f * 1.4426950408889634f;
            const bool isq = gpn < 2, lat = (u.pm + pm0) < 128, second = fq >= 2; const float* gn = isq ? qn : kn;
            f32x4 g4[2][2];
#pragma unroll
            for (int bj = 0; bj < 2; ++bj)
#pragma unroll
                for (int n = 0; n < 2; ++n) g4[bj][n] = *(const f32x4*)(gn + 32 * bj + 8 * fq + 4 * n);
#pragma unroll
            for (int ai = 0; ai < 2; ++ai)
#pragma unroll
                for (int m = 0; m < 4; ++m) { const int lrow = row0 + ai * 128 + m * 16, t = ((u.pm + pm0) * 256 + wr * 64 + fr + ai * 128 + m * 16) & (SEQ - 1);
                    float sq = 0.f;
#pragma unroll
                    for (int bj = 0; bj < 2; ++bj)
#pragma unroll
                        for (int n = 0; n < 2; ++n) { const pg8::f32x4 v = acc[ai][bj][m][n]; sq += (v[0] * v[0] + v[1] * v[1]) + (v[2] * v[2] + v[3] * v[3]); }
                    sq += __shfl_xor(sq, 16); sq += __shfl_xor(sq, 32);
                    const float rinv = 1.0f / sqrtf(sq * (1.f / 64.f) + 1e-6f);
#pragma unroll
                    for (int bj = 0; bj < 2; ++bj) { float y[8];
#pragma unroll
                        for (int n = 0; n < 2; ++n)
#pragma unroll
                            for (int jx = 0; jx < 4; ++jx) y[4 * n + jx] = acc[ai][bj][m][n][jx] * rinv * g4[bj][n][jx];
                        float other[8];
#pragma unroll
                        for (int i = 0; i < 8; ++i) other[i] = __shfl_xor(y[i], 32);
                        if (lat) { const int pos = bj ? (t & 63) : (t >> 6); const f32x4* rp = (const f32x4*)(rope + pos * 16 + 8 * (fq & 1));
#pragma unroll
                            for (int h2 = 0; h2 < 4; ++h2) { const f32x4 cs = rp[h2];
                                y[2 * h2] = second ? (other[2 * h2] * cs.y + y[2 * h2] * cs.x) : (y[2 * h2] * cs.x - other[2 * h2] * cs.y);
                                y[2 * h2 + 1] = second ? (other[2 * h2 + 1] * cs.w + y[2 * h2 + 1] * cs.z) : (y[2 * h2 + 1] * cs.z - other[2 * h2 + 1] * cs.w); } }
                        if (isq) {
#pragma unroll
                            for (int i = 0; i < 8; ++i) y[i] *= C2; }
                        v4u w; w.x = pg8::cvt_pk_bf16(y[0], y[1]); w.y = pg8::cvt_pk_bf16(y[2], y[3]); w.z = pg8::cvt_pk_bf16(y[4], y[5]); w.w = pg8::cvt_pk_bf16(y[6], y[7]);
                        *(v4u*)(O + (size_t)lrow * ldc + u.pn * 256 + 64 * wc + 32 * bj + 8 * fq) = w; } }
            return;
        }
        const int col0 = u.pn * 256 + wc * 32 + 8 * fq;
#pragma unroll
        for (int ai = 0; ai < 2; ++ai)
#pragma unroll
            for (int m = 0; m < 4; ++m) { bf16* rowp = O + (size_t)(row0 + ai * 128 + m * 16) * ldc + col0;
#pragma unroll
                for (int bj = 0; bj < 2; ++bj) { const pg8::f32x4 v0 = acc[ai][bj][m][0], v1 = acc[ai][bj][m][1]; v4u w;
                    w.x = pg8::cvt_pk_bf16(v0[0], v0[1]); w.y = pg8::cvt_pk_bf16(v0[2], v0[3]); w.z = pg8::cvt_pk_bf16(v1[0], v1[1]); w.w = pg8::cvt_pk_bf16(v1[2], v1[3]);
                    *(v4u*)(rowp + bj * 128) = w; } }
    }
};
struct EpiRes {
    static constexpr bool PERM = true, AFTER_DRAIN = false;
    const float* srcL; const float* srcC; bf16* XR; float* outF; const float* gate; int src_bf, dst_bf, pm0;
    __device__ __forceinline__ void operator()(const pg8::f32x4 (&acc)[2][2][4][2], const pg8::Unit& u, int wr, int wc, int fr, int fq) const {
        const int pm = u.pm + pm0; const float* g = gate + (pm < 128 ? (pm >> 5) : 4) * 6144;
        const int grow0 = pm * 256 + wr * 64 + fr, col0 = u.pn * 256 + wc * 32 + 8 * fq;
        f32x4 gv[2][2];
#pragma unroll
        for (int bj = 0; bj < 2; ++bj)
#pragma unroll
            for (int n = 0; n < 2; ++n) gv[bj][n] = *(const f32x4*)(g + col0 + bj * 128 + 4 * n);
#pragma unroll
        for (int ai = 0; ai < 2; ++ai)
#pragma unroll
            for (int mh = 0; mh < 2; ++mh) {
                v4u raw[2][2]; f32x4 xf[2][2][2];
#pragma unroll
                for (int mm = 0; mm < 2; ++mm)
#pragma unroll
                    for (int bj = 0; bj < 2; ++bj) { const size_t p = (size_t)(grow0 + ai * 128 + (2 * mh + mm) * 16) * DM + col0 + bj * 128;
                        if (src_bf) raw[mm][bj] = *(const v4u*)(XR + p);
                        else { const float* sp = pm < 128 ? srcL + p : srcC + (p - (size_t)ML * DM); xf[mm][bj][0] = *(const f32x4*)sp; xf[mm][bj][1] = *(const f32x4*)(sp + 4); } }
#pragma unroll
                for (int mm = 0; mm < 2; ++mm)
#pragma unroll
                    for (int bj = 0; bj < 2; ++bj) { const int m = 2 * mh + mm; const size_t p = (size_t)(grow0 + ai * 128 + m * 16) * DM + col0 + bj * 128;
                        f32x4 v0, v1;
                        if (src_bf) { float x[8]; unpack8(raw[mm][bj], x); v0 = (f32x4){x[0], x[1], x[2], x[3]}; v1 = (f32x4){x[4], x[5], x[6], x[7]}; } else { v0 = xf[mm][bj][0]; v1 = xf[mm][bj][1]; }
                        v0 = v0 + gv[bj][0] * acc[ai][bj][m][0]; v1 = v1 + gv[bj][1] * acc[ai][bj][m][1];
                        if (dst_bf) { v4u w; w.x = pg8::cvt_pk_bf16(v0[0], v0[1]); w.y = pg8::cvt_pk_bf16(v0[2], v0[3]); w.z = pg8::cvt_pk_bf16(v1[0], v1[1]); w.w = pg8::cvt_pk_bf16(v1[2], v1[3]); *(v4u*)(XR + p) = w; }
                        else { float* dp = outF + p; *(f32x4*)dp = v0; *(f32x4*)(dp + 4) = v1; } }
            }
    }
};
struct EpiPartial {
    static constexpr bool PERM = true, AFTER_DRAIN = false;
    float* P;
    __device__ __forceinline__ void operator()(const pg8::f32x4 (&acc)[2][2][4][2], const pg8::Unit& u, int wr, int wc, int fr, int fq) const {
        const int row0 = u.pm * 256 + wr * 64 + fr, col0 = u.pn * 256 + wc * 32 + 8 * fq;
#pragma unroll
        for (int ai = 0; ai < 2; ++ai)
#pragma unroll
            for (int m = 0; m < 4; ++m) { float* rp = P + (size_t)(row0 + ai * 128 + m * 16) * DM + col0;
#pragma unroll
                for (int bj = 0; bj < 2; ++bj) { *(f32x4*)(rp + bj * 128) = acc[ai][bj][m][0]; *(f32x4*)(rp + bj * 128 + 4) = acc[ai][bj][m][1]; } }
    }
};
__device__ __forceinline__ float gelu_fast(float x) { const float u = x + 0.044715f * x * x * x; return x * __builtin_amdgcn_rcpf(1.f + __builtin_amdgcn_exp2f(-2.302208198f * u)); }
__device__ __forceinline__ float dpp_ror1(float v) { return __builtin_bit_cast(float, __builtin_amdgcn_update_dpp(0, __builtin_bit_cast(int, v), 0x121, 0xf, 0xf, false)); }
__device__ __forceinline__ float dpp_rol1(float v) { return __builtin_bit_cast(float, __builtin_amdgcn_update_dpp(0, __builtin_bit_cast(int, v), 0x12F, 0xf, 0xf, false)); }
struct EpiGate {
    static constexpr bool PERM = true, AFTER_DRAIN = false;
    bf16* G; float* EA; float* EV; const float* cw; const float* cb; int pm0;
    __device__ __forceinline__ void operator()(const pg8::f32x4 (&acc)[2][2][4][2], const pg8::Unit& u, int wr, int wc, int fr, int fq) const {
        const int jcol = u.pn * 128 + wc * 32 + 8 * fq;
        f32x4 w0[2], w1[2], w2[2], bb[2];
#pragma unroll
        for (int n = 0; n < 2; ++n) { w0[n] = *(const f32x4*)(cw + jcol + 4 * n); w1[n] = *(const f32x4*)(cw + FF + jcol + 4 * n); w2[n] = *(const f32x4*)(cw + 2 * FF + jcol + 4 * n); bb[n] = *(const f32x4*)(cb + jcol + 4 * n); }
        typedef float f32x2 __attribute__((ext_vector_type(2)));
        const bool l15 = fr == 15, l0 = fr == 0;
#pragma unroll
        for (int ai = 0; ai < 2; ++ai) {
            const int row_b = (u.pm + pm0) * 256 + ai * 128 + wr * 64, blk = row_b >> 6;
#pragma unroll
            for (int m = 0; m < 4; ++m) {
                float o[8];
#pragma unroll
                for (int n = 0; n < 2; ++n)
#pragma unroll
                    for (int jp = 0; jp < 2; ++jp) {
                        const f32x2 cur = (f32x2){acc[ai][0][m][n][2 * jp], acc[ai][0][m][n][2 * jp + 1]};
                        f32x2 su = cur, sd = cur;
                        if (m > 0) { su.x = l15 ? acc[ai][0][m - 1][n][2 * jp] : cur.x; su.y = l15 ? acc[ai][0][m - 1][n][2 * jp + 1] : cur.y; }
                        if (m < 3) { sd.x = l0 ? acc[ai][0][m + 1][n][2 * jp] : cur.x; sd.y = l0 ? acc[ai][0][m + 1][n][2 * jp + 1] : cur.y; }
                        const f32x2 up = (f32x2){dpp_ror1(su.x), dpp_ror1(su.y)}, dn = (f32x2){dpp_rol1(sd.x), dpp_rol1(sd.y)};
                        const f32x2 c0 = (f32x2){w0[n][2 * jp], w0[n][2 * jp + 1]}, c1 = (f32x2){w1[n][2 * jp], w1[n][2 * jp + 1]}, c2 = (f32x2){w2[n][2 * jp], w2[n][2 * jp + 1]}, cbv = (f32x2){bb[n][2 * jp], bb[n][2 * jp + 1]};
                        const f32x2 a2 = c0 * up + (c1 * cur + (c2 * dn + cbv));
                        const f32x2 u2 = a2 * (a2 * a2 * 0.044715f + 1.0f) * (-2.302208198f);
                        const f32x2 den = (f32x2){1.f + __builtin_amdgcn_exp2f(u2.x), 1.f + __builtin_amdgcn_exp2f(u2.y)};
                        const f32x2 vv = (f32x2){acc[ai][1][m][n][2 * jp], acc[ai][1][m][n][2 * jp + 1]};
                        const f32x2 g2 = a2 * vv * (f32x2){__builtin_amdgcn_rcpf(den.x), __builtin_amdgcn_rcpf(den.y)};
                        o[4 * n + 2 * jp] = g2.x; o[4 * n + 2 * jp + 1] = g2.y;
                    }
                const int rb = 16 * m + fr;
                if (rb >= 1 && rb <= 62) { v4u w; w.x = pg8::cvt_pk_bf16(o[0], o[1]); w.y = pg8::cvt_pk_bf16(o[2], o[3]); w.z = pg8::cvt_pk_bf16(o[4], o[5]); w.w = pg8::cvt_pk_bf16(o[6], o[7]); *(v4u*)(G + (size_t)(row_b + rb) * FF + jcol) = w; }
                if ((m == 0 && fr < 2) || (m == 3 && fr > 13)) {
                    const int slot = m == 0 ? fr : fr - 12;
                    float* ea = EA + ((size_t)blk * 4 + slot) * FF + jcol;
                    *(f32x4*)ea = acc[ai][0][m][0]; *(f32x4*)(ea + 4) = acc[ai][0][m][1];
                    if (slot == 0 || slot == 3) { float* ev = EV + ((size_t)blk * 2 + (slot == 3 ? 1 : 0)) * FF + jcol; *(f32x4*)ev = acc[ai][1][m][0]; *(f32x4*)(ev + 4) = acc[ai][1][m][1]; }
                }
            }
        }
    }
};
__device__ __forceinline__ void ffn_fixup(bf16* G, const float* EA, const float* EV, const float* cw, const float* cb, int kb_lo, int kb_hi, int gtid, int gthreads) {
    const int idx_hi = kb_hi * 2 * (FF / 4);
    for (int idxa = kb_lo * 2 * (FF / 4) + gtid; idxa < idx_hi; idxa += 2 * gthreads) {
        f32x4 up[2], cur[2], dn[2], v[2]; int rowq[2], jq[2];
#pragma unroll
        for (int q = 0; q < 2; ++q) { const int idx = idxa + q * gthreads < idx_hi ? idxa + q * gthreads : idxa;
            const int j = (idx % (FF / 4)) * 4, rs = idx / (FF / 4), sel = rs & 1, kb = rs >> 1;
            const int row = kb * 64 + (sel ? 63 : 0); const bool lat = row < ML; const int tpos = lat ? (row & (SEQ - 1)) : ((row - ML) & (CTXL - 1)); const int slen = lat ? SEQ : CTXL;
            const f32x4 zero = (f32x4){0.f, 0.f, 0.f, 0.f}; rowq[q] = row; jq[q] = j;
            if (!sel) { up[q] = tpos > 0 ? *(const f32x4*)(EA + ((size_t)(kb - 1) * 4 + 3) * FF + j) : zero; cur[q] = *(const f32x4*)(EA + ((size_t)kb * 4 + 0) * FF + j); dn[q] = *(const f32x4*)(EA + ((size_t)kb * 4 + 1) * FF + j); v[q] = *(const f32x4*)(EV + ((size_t)kb * 2 + 0) * FF + j); }
            else { up[q] = *(const f32x4*)(EA + ((size_t)kb * 4 + 2) * FF + j); cur[q] = *(const f32x4*)(EA + ((size_t)kb * 4 + 3) * FF + j); dn[q] = tpos < slen - 1 ? *(const f32x4*)(EA + ((size_t)(kb + 1) * 4 + 0) * FF + j) : zero; v[q] = *(const f32x4*)(EV + ((size_t)kb * 2 + 1) * FF + j); } }
#pragma unroll
        for (int q = 0; q < 2; ++q) { if (idxa + q * gthreads >= idx_hi) continue; const int j = jq[q];
            const f32x4 w0 = *(const f32x4*)(cw + j), w1 = *(const f32x4*)(cw + FF + j), w2 = *(const f32x4*)(cw + 2 * FF + j), bb = *(const f32x4*)(cb + j);
            float o[4];
#pragma unroll
            for (int i = 0; i < 4; ++i) o[i] = gelu_fast(w0[i] * up[q][i] + w1[i] * cur[q][i] + w2[i] * dn[q][i] + bb[i]) * v[q][i];
            const unsigned long long pk = (unsigned long long)pk2(o[0], o[1]) | ((unsigned long long)pk2(o[2], o[3]) << 32);
            *(unsigned long long*)(G + (size_t)rowq[q] * FF + j) = pk; }
    }
}

__device__ __forceinline__ void transpose_item(const float* W, int K, int N, bf16* WT, int kb, int nb, int rbase, LAS float* scr, int lane) {
    const int k0 = 64 * kb, n0 = 32 * nb;
    float tv[32];
#pragma unroll
    for (int i = 0; i < 32; ++i) tv[i] = W[(size_t)(k0 + 2 * i + (lane >> 5)) * N + n0 + (lane & 31)];
#pragma unroll
    for (int i = 0; i < 32; ++i) scr[(2 * i + (lane >> 5)) * 33 + (lane & 31)] = tv[i];
    asm volatile("s_waitcnt lgkmcnt(0)" ::: "memory");
    const int c = lane & 7;
#pragma unroll
    for (int j = 0; j < 4; ++j) { const int n = (lane >> 3) + 8 * j; const LAS float* s = scr + (8 * c) * 33 + n;
        v4u o; o.x = pk2(s[0 * 33], s[1 * 33]); o.y = pk2(s[2 * 33], s[3 * 33]); o.z = pk2(s[4 * 33], s[5 * 33]); o.w = pk2(s[6 * 33], s[7 * 33]);
        *(v4u*)(WT + (size_t)(rbase + n) * K + k0 + 8 * c) = o; }
    asm volatile("s_waitcnt lgkmcnt(0)" ::: "memory");
}
constexpr int TI_IN = 16 * 80, TI_OUT = 16 * 32, TI_UP = 16 * 176, TI_DOWN = 44 * 32, TI_LAYER = TI_IN + TI_OUT + TI_UP + TI_DOWN;
__device__ __forceinline__ void p0_weights(const float* w_in, const float* w_out, const float* w_up, const float* w_down, unsigned char* wb, LAS float* scr, int it0, int it1, int gw, int ngw, int lane) {
    for (int it = it0 + gw; it < it1; it += ngw) {
        const int l = it / TI_LAYER; int r = it % TI_LAYER; unsigned char* base = wb + (size_t)l * WB_LAYER;
        if (r < TI_IN) { const int nb = r % 80, n0 = 32 * nb; int rb = n0;
            if (n0 < 768) { const int o = n0 & 255; rb = (n0 & ~255) + 128 * ((o & 63) >> 5) + 32 * (o >> 6); }
            transpose_item(w_in + (size_t)l * DM * ZW, DM, ZW, (bf16*)(base + WB_IN), r / 80, nb, rb, scr, lane); continue; } r -= TI_IN;
        if (r < TI_OUT) { transpose_item(w_out + (size_t)l * DM * DM, DM, DM, (bf16*)(base + WB_OUT), r / 32, r % 32, 32 * (r % 32), scr, lane); continue; } r -= TI_OUT;
        if (r < TI_UP) { const int nb = r % 176, n0 = 32 * nb; const int m = n0 < FF ? n0 : n0 - FF; const int rb = (m / 128) * 256 + (n0 < FF ? 0 : 128) + (m % 128);
            transpose_item(w_up + (size_t)l * DM * FF2, DM, FF2, (bf16*)(base + WB_UP), r / 176, nb, rb, scr, lane); continue; } r -= TI_UP;
        transpose_item(w_down + (size_t)l * FF * DM, FF, DM, (bf16*)(base + WB_DOWN), r / 32, r % 32, 32 * (r % 32), scr, lane);
    }
}
__device__ __forceinline__ void p0_mod_item(const float* c, const float* c_ctx, const float* ada_w, const float* ada_b, float* mod, LAS float* L, int item, int tid) {
    const int l = item / 96, n0 = (item % 96) * 64, wave = tid >> 6, lane = tid & 63;
    LAS float* sl = L; LAS float* red = L + 5 * 1024;
    const float* w = ada_w + (size_t)l * DM * 6144 + n0 + lane + (size_t)(wave * 128) * 6144;
    float wv[32];
#pragma unroll
    for (int i = 0; i < 32; ++i) wv[i] = w[(size_t)i * 6144];
    for (int i = tid; i < 5 * 1024; i += NTHR) { const int r = i >> 10, k = i & 1023; const float v = r < 4 ? c[r * 1024 + k] : c_ctx[k]; sl[i] = v / (1.f + __expf(-v)); }
    __syncthreads();
    float acc[5] = {0.f, 0.f, 0.f, 0.f, 0.f};
#pragma unroll 1
    for (int kb = 0; kb < 128; kb += 32) {
        float wn[32];
        if (kb + 32 < 128) {
#pragma unroll
            for (int i = 0; i < 32; ++i) wn[i] = w[(size_t)(kb + 32 + i) * 6144]; }
#pragma unroll
        for (int i = 0; i < 32; ++i) { const int k = wave * 128 + kb + i;
#pragma unroll
            for (int r = 0; r < 5; ++r) acc[r] += sl[r * 1024 + k] * wv[i]; }
#pragma unroll
        for (int i = 0; i < 32; ++i) wv[i] = wn[i];
    }
#pragma unroll
    for (int r = 0; r < 5; ++r) red[(wave * 5 + r) * 64 + lane] = acc[r];
    __syncthreads();
    if (tid < 320) { const int r = tid >> 6; float s = 0.f;
#pragma unroll
        for (int w8 = 0; w8 < 8; ++w8) s += red[(w8 * 5 + r) * 64 + lane];
        mod[(size_t)(l * 5 + r) * 6144 + n0 + lane] = s + ada_b[l * 6144 + n0 + lane]; }
    __syncthreads();
}
template <bool CTXF, int HALF = -1>
__device__ __forceinline__ void p0_filter_item(const float* w1, const float* b1, const float* w2, const float* b2, const float* w3, const float* b3, const float* w4, const float* freq,
                                               float* KT, float* FS, LAS float* L, int chunk, int tid) {
    constexpr int n = CTXF ? 256 : 8192; const int t0 = chunk * 32;
    LAS float* feats = L; LAS float* h1 = L + 32 * 36; LAS float* h2 = h1 + 2048; LAS float* h3 = h2 + 2048;
    LAS float* W1 = L + 7296; LAS float* W2 = W1 + 2112; LAS float* W3 = W2 + 4096; LAS float* T = L + 17664;
    float bq1[4], bq2[4], bq3[4], fq4[4];
#pragma unroll
    for (int i = 0; i < 4; ++i) { const int jx = 4 * (tid & 15) + i; bq1[i] = b1[jx]; bq2[i] = b2[jx]; bq3[i] = b3[jx]; fq4[i] = freq[jx]; }
    for (int i = tid; i < 528; i += NTHR) *(LAS f32x4*)(W1 + 4 * i) = *(const f32x4*)(w1 + 4 * i);
    for (int i = tid; i < 1024; i += NTHR) { *(LAS f32x4*)(W2 + 4 * i) = *(const f32x4*)(w2 + 4 * i); *(LAS f32x4*)(W3 + 4 * i) = *(const f32x4*)(w3 + 4 * i); }
    for (int i = tid; i < 32 * 33; i += NTHR) { const int tap = i / 33, e = i % 33, t = t0 + tap; float val;
        if (e == 0) val = (float)t / (float)(n - 1);
        else { const int j = (e - 1) & 15; const float f = 1e-4f + (float)j * ((15.0f - 1e-4f) / 15.0f); float sn, cs; sincospif(f * (2.0f * (float)t / (float)n), &sn, &cs); val = e <= 16 ? cs : -sn; }
        feats[tap * 36 + e] = val; }
    __syncthreads();
    const int tap4 = tid >> 4, jb = tid & 15;
    { float s4[4];
#pragma unroll
      for (int i = 0; i < 4; ++i) s4[i] = bq1[i];
#pragma unroll 3
      for (int e = 0; e < 33; ++e) { const float fv = feats[tap4 * 36 + e]; const f32x4 wq = *(const LAS f32x4*)(W1 + e * 64 + 4 * jb);
#pragma unroll
          for (int i = 0; i < 4; ++i) s4[i] += fv * wq[i]; }
      *(LAS f32x4*)(h1 + tap4 * 64 + 4 * jb) = (f32x4){__sinf(fq4[0] * s4[0]), __sinf(fq4[1] * s4[1]), __sinf(fq4[2] * s4[2]), __sinf(fq4[3] * s4[3])}; }
    __syncthreads();
    { float s4[4];
#pragma unroll
      for (int i = 0; i < 4; ++i) s4[i] = bq2[i];
#pragma unroll 4
      for (int e = 0; e < 64; ++e) { const float fv = h1[tap4 * 64 + e]; const f32x4 wq = *(const LAS f32x4*)(W2 + e * 64 + 4 * jb);
#pragma unroll
          for (int i = 0; i < 4; ++i) s4[i] += fv * wq[i]; }
      *(LAS f32x4*)(h2 + tap4 * 64 + 4 * jb) = (f32x4){__sinf(fq4[0] * s4[0]), __sinf(fq4[1] * s4[1]), __sinf(fq4[2] * s4[2]), __sinf(fq4[3] * s4[3])}; }
    __syncthreads();
    { float s4[4];
#pragma unroll
      for (int i = 0; i < 4; ++i) s4[i] = bq3[i];
#pragma unroll 4
      for (int e = 0; e < 64; ++e) { const float fv = h2[tap4 * 64 + e]; const f32x4 wq = *(const LAS f32x4*)(W3 + e * 64 + 4 * jb);
#pragma unroll
          for (int i = 0; i < 4; ++i) s4[i] += fv * wq[i]; }
      *(LAS f32x4*)(h3 + tap4 * 64 + 4 * jb) = (f32x4){__sinf(fq4[0] * s4[0]), __sinf(fq4[1] * s4[1]), __sinf(fq4[2] * s4[2]), __sinf(fq4[3] * s4[3])}; }
    __syncthreads();
    typedef short fbf16x8 __attribute__((ext_vector_type(8)));
    typedef float ff32x16 __attribute__((ext_vector_type(16)));
    const int wave = tid >> 6, lane = tid & 63, r32 = lane & 31, hi = lane >> 5;
    constexpr int NB = HALF < 0 ? 4 : 2;
    const int col0 = HALF < 0 ? 128 * wave : (HALF == 0 ? 64 * wave : 512 + 64 * wave);
    fbf16x8 afr[4];
#pragma unroll
    for (int ks = 0; ks < 4; ++ks) { const LAS float* hp = h3 + r32 * 64 + 16 * ks + 8 * hi; const f32x4 a = *(const LAS f32x4*)hp, b = *(const LAS f32x4*)(hp + 4);
        v4u w; w.x = pk2(a.x, a.y); w.y = pk2(a.z, a.w); w.z = pk2(b.x, b.y); w.w = pk2(b.z, b.w); afr[ks] = __builtin_bit_cast(fbf16x8, w); }
    ff32x16 acc[NB];
    float wv[4][8], wn[4][8];
    { const float* wp = w4 + col0 + r32 + (size_t)(8 * hi) * 1024;
#pragma unroll
      for (int ks = 0; ks < 4; ++ks)
#pragma unroll
          for (int e = 0; e < 8; ++e) wv[ks][e] = wp[(size_t)(16 * ks + e) * 1024]; }
#pragma unroll
    for (int nb = 0; nb < NB; ++nb) {
        if (nb + 1 < NB) { const float* wp = w4 + col0 + 32 * (nb + 1) + r32 + (size_t)(8 * hi) * 1024;
#pragma unroll
            for (int ks = 0; ks < 4; ++ks)
#pragma unroll
                for (int e = 0; e < 8; ++e) wn[ks][e] = wp[(size_t)(16 * ks + e) * 1024]; }
#pragma unroll
        for (int r = 0; r < 16; ++r) acc[nb][r] = 0.f;
#pragma unroll
        for (int ks = 0; ks < 4; ++ks) { v4u w; w.x = pk2(wv[ks][0], wv[ks][1]); w.y = pk2(wv[ks][2], wv[ks][3]); w.z = pk2(wv[ks][4], wv[ks][5]); w.w = pk2(wv[ks][6], wv[ks][7]);
            acc[nb] = __builtin_amdgcn_mfma_f32_32x32x16_bf16(afr[ks], __builtin_bit_cast(fbf16x8, w), acc[nb], 0, 0, 0); }
#pragma unroll
        for (int ks = 0; ks < 4; ++ks)
#pragma unroll
            for (int e = 0; e < 8; ++e) wv[ks][e] = wn[ks][e];
    }
#pragma unroll
    for (int nb = 0; nb < NB; ++nb) { const int col = col0 + 32 * nb + r32, c = col & 511; const bool bwd = col >= 512;
        const float delta = 3.0701134573253944f + (float)c * (12.280453829301577f / 511.f); float sa = 0.f;
#pragma unroll
        for (int r = 0; r < 16; ++r) { const int t = t0 + (r & 3) + 8 * (r >> 2) + 4 * hi; const float t01 = (float)t * (1.0f / (float)(n - 1)); const float v = acc[nb][r] * (__expf(-t01 * delta) + 0.05f);
            acc[nb][r] = v; if (!bwd || t > 0) sa += fabsf(v); }
        sa += __shfl_xor(sa, 32); if (hi == 0) FS[chunk * 1024 + col] = sa; }
    const int cc = lane >> 5, tp = lane & 31, tt = t0 + tp;
    if constexpr (HALF != 1) {
    if (HALF == 0 || wave < 4) {
#pragma unroll
        for (int nb = 0; nb < NB; ++nb) { const int c = (col0 + 32 * nb + r32) & 511;
#pragma unroll
            for (int r = 0; r < 16; ++r) T[c * 33 + (r & 3) + 8 * (r >> 2) + 4 * hi] = acc[nb][r]; } }
    __syncthreads();
#pragma unroll 1
    for (int cp = 0; cp < 32; ++cp) { const int c = wave * 64 + 2 * cp + cc; const float v = T[c * 33 + tp];
        if (CTXF) KT[(size_t)(255 + tt) * 512 + c] = v; else KT[(size_t)c * NFFT + tt] = v; }
    __syncthreads(); }
    if constexpr (HALF != 0) {
    if (HALF == 1 || wave >= 4) {
#pragma unroll
        for (int nb = 0; nb < NB; ++nb) { const int c = (col0 + 32 * nb + r32) & 511;
#pragma unroll
            for (int r = 0; r < 16; ++r) T[c * 33 + (r & 3) + 8 * (r >> 2) + 4 * hi] = acc[nb][r]; } }
    __syncthreads();
#pragma unroll 1
    for (int cp = 0; cp < 32; ++cp) { const int c = wave * 64 + 2 * cp + cc; const float v = T[c * 33 + tp];
        if (tt > 0) { if (CTXF) KT[(size_t)(255 - tt) * 512 + c] = v; else KT[(size_t)c * NFFT + NFFT - tt] = v; } } }
    if (!CTXF && chunk == 0) KT[(size_t)tid * NFFT + 8192] = 0.f;
    __syncthreads();
}

constexpr int FFT_LDS_ELEMS = NFFT + NFFT / 32;
__device__ __forceinline__ int pidx(int i) { return i + (i >> 5); }
__device__ __forceinline__ f32x2v cmulv(const f32x2v a, const f32x2v b) { return (f32x2v){a.x * b.x - a.y * b.y, a.x * b.y + a.y * b.x}; }
template <int K32> __device__ __forceinline__ f32x2v e32() {
    constexpr float C[16] = {1.0f, 0.98078528040323043f, 0.92387953251128674f, 0.83146961230254524f, 0.70710678118654752f, 0.55557023301960218f, 0.38268343236508977f, 0.19509032201612825f,
                             0.0f, -0.19509032201612825f, -0.38268343236508977f, -0.55557023301960218f, -0.70710678118654752f, -0.83146961230254524f, -0.92387953251128674f, -0.98078528040323043f};
    constexpr float Sn[16] = {0.0f, 0.19509032201612825f, 0.38268343236508977f, 0.55557023301960218f, 0.70710678118654752f, 0.83146961230254524f, 0.92387953251128674f, 0.98078528040323043f,
                              1.0f, 0.98078528040323043f, 0.92387953251128674f, 0.83146961230254524f, 0.70710678118654752f, 0.55557023301960218f, 0.38268343236508977f, 0.19509032201612825f};
    return (f32x2v){C[K32], -Sn[K32]};
}
template <int S, int LOGR, bool INV, int Q, int M>
__device__ __forceinline__ void fft_bfly(f32x2v (&x)[1 << LOGR], const f32x2v (&bq)[LOGR]) {
    constexpr int R = 1 << LOGR, BS = NFFT >> S, STR = BS / R, bit = 1 << (LOGR - 1 - Q);
    if constexpr (M < R) {
        if constexpr (!(M & bit)) {
            constexpr int k32 = ((M & (bit - 1)) << Q) * (32 / R);
            f32x2v w;
            if constexpr (STR == 1) w = e32<k32>(); else if constexpr (k32 == 0) w = bq[Q]; else w = cmulv(bq[Q], e32<k32>());
            const f32x2v a = x[M], b = x[M + bit];
            if constexpr (!INV) { const f32x2v d = a - b; x[M] = a + b; x[M + bit] = cmulv(d, w); }
            else { const f32x2v t = (f32x2v){b.x * w.x + b.y * w.y, b.y * w.x - b.x * w.y}; x[M] = a + t; x[M + bit] = a - t; }
        }
        fft_bfly<S, LOGR, INV, Q, M + 1>(x, bq);
    }
}
template <int S, int LOGR, bool INV, int QQ, int QEND = LOGR>
__device__ __forceinline__ void fft_substages(f32x2v (&x)[1 << LOGR], const f32x2v (&bq)[LOGR]) {
    if constexpr (QQ < QEND) { constexpr int Q = INV ? LOGR - 1 - QQ : QQ; fft_bfly<S, LOGR, INV, Q, 0>(x, bq); fft_substages<S, LOGR, INV, QQ + 1, QEND>(x, bq); }
}
template <int M> __device__ __forceinline__ void fft_zhi_stage(f32x2v (&x)[16], const f32x2v b0) {
    if constexpr (M < 8) { x[M + 8] = cmulv(x[M], M == 0 ? b0 : cmulv(b0, e32<2 * M>())); fft_zhi_stage<M + 1>(x, b0); }
}
template <int M> __device__ __forceinline__ void fft_half_stage(f32x2v (&x)[16], const f32x2v b0) {
    if constexpr (M < 8) { const f32x2v w = M == 0 ? b0 : cmulv(b0, e32<2 * M>()), b = x[M + 8]; x[M] = x[M] + (f32x2v){b.x * w.x + b.y * w.y, b.y * w.x - b.x * w.y}; fft_half_stage<M + 1>(x, b0); }
}
template <bool INV>
__device__ __forceinline__ void fft_super0_half(LAS f32x2v* buf, const f32x2v* __restrict__ TW, int tid) {
#pragma unroll
    for (int g = tid; g < NFFT / 16; g += NTHR) {
        f32x2v x[16], bq[4];
#pragma unroll
        for (int m = 0; m < (INV ? 16 : 8); ++m) x[m] = buf[pidx(g + m * 1024)];
        bq[0] = TW[g];
#pragma unroll
        for (int q = 1; q < 4; ++q) bq[q] = cmulv(bq[q - 1], bq[q - 1]);
        if constexpr (!INV) { fft_zhi_stage<0>(x, bq[0]); fft_substages<0, 4, false, 1>(x, bq); }
        else { fft_substages<0, 4, true, 0, 3>(x, bq); fft_half_stage<0>(x, bq[0]); }
#pragma unroll
        for (int m = 0; m < (INV ? 8 : 16); ++m) buf[pidx(g + m * 1024)] = x[m];
    }
    __syncthreads();
}
template <int S, int LOGR, bool INV>
__device__ __forceinline__ void fft_super(LAS f32x2v* buf, const f32x2v* __restrict__ TW, int tid) {
    constexpr int R = 1 << LOGR, BS = NFFT >> S, STR = BS / R, NG = NFFT / R;
#pragma unroll
    for (int g = tid; g < NG; g += NTHR) {
        const int lo = g % STR, hi = g / STR, base = hi * BS + lo;
        f32x2v x[R], bq[LOGR];
#pragma unroll
        for (int m = 0; m < R; ++m) x[m] = buf[pidx(base + m * STR)];
        if constexpr (STR > 1) { bq[0] = TW[lo << S];
#pragma unroll
            for (int q = 1; q < LOGR; ++q) bq[q] = cmulv(bq[q - 1], bq[q - 1]); }
        else {
#pragma unroll
            for (int q = 0; q < LOGR; ++q) bq[q] = (f32x2v){1.f, 0.f}; }
        fft_substages<S, LOGR, INV, 0>(x, bq);
#pragma unroll
        for (int m = 0; m < R; ++m) buf[pidx(base + m * STR)] = x[m];
    }
    __syncthreads();
}
__device__ __forceinline__ void fft_fwd(LAS f32x2v* buf, const f32x2v* TW, int tid) { fft_super<0, 4, false>(buf, TW, tid); fft_super<4, 5, false>(buf, TW, tid); fft_super<9, 5, false>(buf, TW, tid); }
__device__ __forceinline__ void fft_mid_mul(LAS f32x2v* buf, const f32x4 (&kq)[16], int tid) {
    f32x2v x[32], bq[5];
#pragma unroll
    for (int m = 0; m < 32; ++m) x[m] = buf[pidx(32 * tid + m)];
#pragma unroll
    for (int q = 0; q < 5; ++q) bq[q] = (f32x2v){1.f, 0.f};
    fft_substages<9, 5, false, 0>(x, bq);
#pragma unroll
    for (int m = 0; m < 16; ++m) { x[2 * m] = cmulv(x[2 * m], (f32x2v){kq[m].x, kq[m].y}); x[2 * m + 1] = cmulv(x[2 * m + 1], (f32x2v){kq[m].z, kq[m].w}); }
    fft_substages<9, 5, true, 0>(x, bq);
#pragma unroll
    for (int m = 0; m < 32; ++m) buf[pidx(32 * tid + m)] = x[m];
    __syncthreads();
}
__device__ __forceinline__ void fft_inv(LAS f32x2v* buf, const f32x2v* TW, int tid) { fft_super<12, 2, true>(buf, TW, tid); fft_super<8, 4, true>(buf, TW, tid); fft_super<4, 4, true>(buf, TW, tid); fft_super<0, 4, true>(buf, TW, tid); }

__device__ __forceinline__ void filter_fft_item(const float* KT, const float* FS, const float* bias_d, f32x2v* KF, const f32x2v* TW, LAS f32x2v* buf, LAS float* misc, int cp, int tid) {
    const int c1 = 2 * cp, c2 = c1 + 1;
    const f32x4* s1 = (const f32x4*)(KT + (size_t)c1 * NFFT); const f32x4* s2 = (const f32x4*)(KT + (size_t)c2 * NFFT);
    for (int i = tid; i < NFFT / 4; i += NTHR) { const f32x4 v = s1[i], w = s2[i];
#pragma unroll
        for (int k = 0; k < 4; ++k) buf[pidx(4 * i + k)] = (f32x2v){v[k], w[k]}; }
    if (tid < 128) { const int c = c1 + (tid >> 6), ln = tid & 63; float s = 0.f;
#pragma unroll
        for (int k = 0; k < 4; ++k) { const int ch = ln * 4 + k; s += FS[ch * 1024 + c] + FS[ch * 1024 + 512 + c]; }
        s = wave_sum(s); if (ln == 0) misc[tid >> 6] = 0.5f / (s * (float)NFFT); }
    __syncthreads();
    fft_fwd(buf, TW, tid);
    const float sc1 = misc[0], sc2 = misc[1]; f32x2v* d1 = KF + (size_t)c1 * NFFT; f32x2v* d2 = KF + (size_t)c2 * NFFT;
    const float bd1 = bias_d[c1] * (1.f / (float)NFFT), bd2 = bias_d[c2] * (1.f / (float)NFFT);
    for (int i = tid; i < NFFT; i += NTHR) {
        const int f = (int)(__brev((unsigned)i) >> 18), j = (int)(__brev((unsigned)((NFFT - f) & (NFFT - 1))) >> 18);
        const f32x2v zf = buf[pidx(i)], zm = buf[pidx(j)];
        d1[i] = (f32x2v){(zf.x + zm.x) * sc1 + bd1, (zf.y - zm.y) * sc1};
        d2[i] = (f32x2v){(zf.y + zm.y) * sc2 + bd2, (zm.x - zf.x) * sc2};
    }
    __syncthreads();
}
__device__ __forceinline__ void conv_fft_items(float* UT, const f32x2v* KF, const f32x2v* TW, LAS f32x2v* buf, int first, int step, int n_items, int tid) {
    f32x4 ua[4], ub[4];
#define CV_ROWS(item_) f32x4* u0 = (f32x4*)(UT + ((size_t)(2 * ((item_) >> 9)) * CW + ((item_) & 511)) * SEQ); f32x4* u1 = u0 + (size_t)CW * SEQ / 4
    if (first < n_items) { CV_ROWS(first);
#pragma unroll
        for (int q = 0; q < 4; ++q) { ua[q] = u0[tid + NTHR * q]; ub[q] = u1[tid + NTHR * q]; } }
    for (int item = first; item < n_items; item += step) {
        CV_ROWS(item);
#pragma unroll
        for (int q = 0; q < 4; ++q) { const int i = tid + NTHR * q;
#pragma unroll
            for (int k = 0; k < 4; ++k) buf[pidx(4 * i + k)] = (f32x2v){ua[q][k], ub[q][k]}; }
        __syncthreads();
        fft_super0_half<false>(buf, TW, tid);
        fft_super<4, 5, false>(buf, TW, tid);
        { f32x4 kq[16]; const f32x4* kf = (const f32x4*)(KF + (size_t)(item & 511) * NFFT) + 16 * tid;
#pragma unroll
          for (int m = 0; m < 16; ++m) kq[m] = kf[m];
          fft_mid_mul(buf, kq, tid); }
        fft_super<4, 5, true>(buf, TW, tid);
        if (item + step < n_items) { const int nx = item + step; f32x4* v0 = (f32x4*)(UT + ((size_t)(2 * (nx >> 9)) * CW + (nx & 511)) * SEQ); f32x4* v1 = v0 + (size_t)CW * SEQ / 4;
#pragma unroll
            for (int q = 0; q < 4; ++q) { ua[q] = v0[tid + NTHR * q]; ub[q] = v1[tid + NTHR * q]; } }
        fft_super0_half<true>(buf, TW, tid);
#pragma unroll
        for (int q = 0; q < 4; ++q) { const int i = tid + NTHR * q; f32x4 a, b;
#pragma unroll
            for (int k = 0; k < 4; ++k) { const f32x2v y = buf[pidx(4 * i + k)]; a[k] = y.x; b[k] = y.y; }
            u0[i] = a; u1[i] = b; }
        __syncthreads();
    }
#undef CV_ROWS
}

__device__ __forceinline__ void modulate_rows(const float* srcL, const float* srcC, const bf16* XR  , const float* g, const float* mod  , int shoff, bf16* XN, int row_lo, int row_hi, int gw, int ngw, int lane, const float* part = nullptr  , const float* pgate = nullptr) {
    for (int rowa = row_lo + gw; rowa < row_hi; rowa += 2 * ngw) {
        f32x4 v[2][4]; float ss[2];
#pragma unroll
        for (int q = 0; q < 2; ++q) { const int row = rowa + q * ngw;
            if (row < row_hi) {
                if (XR) { const unsigned long long* xr = (const unsigned long long*)(XR + (size_t)row * DM) + lane;
#pragma unroll
                    for (int j = 0; j < 4; ++j) { const unsigned long long w = xr[64 * j]; const unsigned lo = (unsigned)w, hi = (unsigned)(w >> 32); v[q][j] = (f32x4){bflo(lo), bfhi(lo), bflo(hi), bfhi(hi)}; }
                    if (part) { const float* p0 = part + (size_t)(row - ML) * DM + 4 * lane;
#pragma unroll
                        for (int j = 0; j < 4; ++j) v[q][j] = v[q][j] + *(const f32x4*)(pgate + 4 * lane + 256 * j) * (*(const f32x4*)(p0 + 256 * j) + *(const f32x4*)(p0 + (size_t)MC * DM + 256 * j)); } }
                else { const f32x4* xr = (const f32x4*)(row < ML ? srcL + (size_t)row * DM : srcC + (size_t)(row - ML) * DM) + lane;
#pragma unroll
                    for (int j = 0; j < 4; ++j) v[q][j] = xr[64 * j]; } }
            else {
#pragma unroll
                for (int j = 0; j < 4; ++j) v[q][j] = (f32x4){0.f, 0.f, 0.f, 0.f}; } }
#pragma unroll
        for (int q = 0; q < 2; ++q) { ss[q] = 0.f;
#pragma unroll
            for (int j = 0; j < 4; ++j) ss[q] += (v[q][j].x * v[q][j].x + v[q][j].y * v[q][j].y) + (v[q][j].z * v[q][j].z + v[q][j].w * v[q][j].w); }
#pragma unroll
        for (int o = 1; o < 64; o <<= 1) { ss[0] += __shfl_xor(ss[0], o); ss[1] += __shfl_xor(ss[1], o); }
#pragma unroll
        for (int q = 0; q < 2; ++q) { const int row = rowa + q * ngw; if (row >= row_hi) continue;
            const float* mr = mod + (row < ML ? (row >> 13) : 4) * 6144;
            const float rinv = 1.0f / sqrtf(ss[q] * (1.f / DM) + 1e-6f);
            unsigned long long* o8 = (unsigned long long*)(XN + (size_t)row * DM) + lane;
#pragma unroll
            for (int j = 0; j < 4; ++j) { const int col = 4 * lane + 256 * j; const f32x4 gg = *(const f32x4*)(g + col), sh = *(const f32x4*)(mr + shoff + col), sc = *(const f32x4*)(mr + shoff + 1024 + col);
                const f32x4 y = v[q][j] * rinv * gg * (sc + 1.0f) + sh;
                o8[64 * j] = (unsigned long long)pk2(y.x, y.y) | ((unsigned long long)pk2(y.z, y.w) << 32); } }
    }
}
__device__ __forceinline__ void qk_norm_rope(bf16* Z, const float* qn, const float* kn, const f32x2v* ROPE, int it_lo, int it_hi, int blk, int nblk, int tid) {
    constexpr float C2 = 0.125f * 1.4426950408889634f;
    const int j = tid & 7;
    for (int ita = it_lo + blk; ita < it_hi; ita += 4 * nblk) {
        v4u raw[4];
#pragma unroll
        for (int q = 0; q < 4; ++q) { const int it = ita + q * nblk; if (it < it_hi) { const int hr = it * 64 + (tid >> 3); raw[q] = *(const v4u*)(Z + (size_t)(hr / 12) * ZW + (hr % 12) * 64 + 8 * j); } else raw[q] = (v4u){0u, 0u, 0u, 0u}; }
#pragma unroll
        for (int q = 0; q < 4; ++q) { const int it = ita + q * nblk; if (it >= it_hi) continue;
            const int hr = it * 64 + (tid >> 3), row = hr / 12, head = hr % 12;
            bf16* p = Z + (size_t)row * ZW + head * 64 + 8 * j;
            float x[8]; unpack8(raw[q], x);
            float ss = 0.f;
#pragma unroll
            for (int i = 0; i < 8; ++i) ss += x[i] * x[i];
            ss += __shfl_xor(ss, 1); ss += __shfl_xor(ss, 2); ss += __shfl_xor(ss, 4);
            const float rinv = 1.0f / sqrtf(ss * (1.f / 64.f) + 1e-6f);
            const float* gn = (head < 8 ? qn : kn) + 8 * j;
#pragma unroll
            for (int i = 0; i < 8; ++i) x[i] = x[i] * rinv * gn[i];
            float other[8];
#pragma unroll
            for (int i = 0; i < 8; ++i) other[i] = __shfl_xor(x[i], 2);
            if (row < ML) {
                const int t = row & (SEQ - 1), pos = (j >> 2) ? (t & 63) : (t >> 6), jj = j & 3, f0 = (jj & 1) * 8; const bool second = (jj >> 1) != 0;
                const f32x2v* rp = ROPE + pos * 16 + f0;
#pragma unroll
                for (int i = 0; i < 8; ++i) { const f32x2v cs = rp[i]; x[i] = second ? (other[i] * cs.y + x[i] * cs.x) : (x[i] * cs.x - other[i] * cs.y); }
            }
            if (head < 8) {
#pragma unroll
                for (int i = 0; i < 8; ++i) x[i] *= C2;
            }
            *(v4u*)p = pack8(x);
        }
    }
}
__device__ __forceinline__ void hyena_pre(const bf16* Z, const float* cw, const float* cb, bf16* OC, float* UT, float* UC, LAS float* T, int it_lo, int it_hi, int blk, int nblk, int tid) {
    const int tt = tid >> 3, cg8 = (tid & 7) * 8, c0 = (blk & 7) * 64, c = c0 + cg8;
    float w[3][4][8];
#pragma unroll
    for (int gsel = 0; gsel < 3; ++gsel)
#pragma unroll
        for (int i = 0; i < 8; ++i) { const int col = gsel * CW + c + i; w[gsel][0][i] = cw[col]; w[gsel][1][i] = cw[3 * CW + col]; w[gsel][2][i] = cw[6 * CW + col]; w[gsel][3][i] = cb[col]; }
    const v4u zero = (v4u){0u, 0u, 0u, 0u};
    const int rt_hi = it_hi >> 3, rstep = nblk >> 3;
    v4u cur[9], nxt[9];
#define HP_LOAD(dst, rt_) do { const int row_ = (rt_) * 64 + tt; const bool lat_ = row_ < ML; const int tp_ = lat_ ? (row_ & (SEQ - 1)) : ((row_ - ML) & (CTXL - 1)); const int sl_ = lat_ ? SEQ : CTXL; \
        _Pragma("unroll") for (int g_ = 0; g_ < 3; ++g_) { const bf16* zp_ = Z + (size_t)row_ * ZW + 1024 + g_ * CW + c; dst[3 * g_ + 1] = *(const v4u*)zp_; \
            dst[3 * g_] = tp_ > 0 ? *(const v4u*)(zp_ - ZW) : zero; dst[3 * g_ + 2] = tp_ < sl_ - 1 ? *(const v4u*)(zp_ + ZW) : zero; } } while (0)
    int rt = (it_lo >> 3) + (blk >> 3);
    if (rt < rt_hi) HP_LOAD(cur, rt);
    for (; rt < rt_hi; rt += rstep) {
        const int row = rt * 64 + tt; const bool lat = row < ML;
        if (rt + rstep < rt_hi) HP_LOAD(nxt, rt + rstep);
        float zc[3][8];
#pragma unroll
        for (int gsel = 0; gsel < 3; ++gsel) { float a[8], b[8], d[8]; unpack8(cur[3 * gsel], a); unpack8(cur[3 * gsel + 1], b); unpack8(cur[3 * gsel + 2], d);
#pragma unroll
            for (int i = 0; i < 8; ++i) zc[gsel][i] = a[i] * w[gsel][0][i] + b[i] * w[gsel][1][i] + d[i] * w[gsel][2][i] + w[gsel][3][i]; }
        *(v4u*)(OC + (size_t)row * DM + 512 + c) = pack8(zc[0]);
        float u[8];
#pragma unroll
        for (int i = 0; i < 8; ++i) u[i] = zc[2][i] * zc[1][i];
        if (lat) {
#pragma unroll
            for (int i = 0; i < 8; ++i) T[tt * 65 + cg8 + i] = u[i];
            __syncthreads();
            const int cl = tid >> 3, seg = (tid & 7) * 8, b = row >> 13, tb = (rt * 64) & (SEQ - 1);
            f32x4 o0, o1;
#pragma unroll
            for (int i = 0; i < 4; ++i) { o0[i] = T[(seg + i) * 65 + cl]; o1[i] = T[(seg + 4 + i) * 65 + cl]; }
            float* dst = UT + ((size_t)b * CW + c0 + cl) * SEQ + tb + seg;
            *(f32x4*)dst = o0; *(f32x4*)(dst + 4) = o1;
            __syncthreads();
        } else {
            float* dst = UC + (size_t)(row - ML) * CW + c;
            *(f32x4*)dst = (f32x4){u[0], u[1], u[2], u[3]}; *(f32x4*)(dst + 4) = (f32x4){u[4], u[5], u[6], u[7]};
        }
#pragma unroll
        for (int k = 0; k < 9; ++k) cur[k] = nxt[k];
    }
#undef HP_LOAD
}
__device__ __forceinline__ void ctx_conv_item(const float* KC, const float* FSC, const float* UC, const float* bias_d, bf16* OC, LAS float* L, int item, int tid) {
    const int b = item >> 5, c0 = (item & 31) * 16, cl = tid & 15, tg = tid >> 4, c = c0 + cl;
    LAS float* Ks = L; LAS float* Us = L + 512 * 16;
    for (int i = tid; i < 511 * 4; i += NTHR) { const int r = i >> 2, q = (i & 3) * 4; *(LAS f32x4*)(Ks + r * 16 + q) = *(const f32x4*)(KC + (size_t)r * CW + c0 + q); }
    for (int i = tid; i < 256 * 4; i += NTHR) { const int r = i >> 2, q = (i & 3) * 4; *(LAS f32x4*)(Us + r * 16 + q) = *(const f32x4*)(UC + ((size_t)b * CTXL + r) * CW + c0 + q); }
    __syncthreads();
    float acc[8];
#pragma unroll
    for (int i = 0; i < 8; ++i) acc[i] = 0.f;
    const int T0 = 8 * tg;
#pragma unroll 1
    for (int s0 = 0; s0 < CTXL; s0 += 8) {
        float kw[15], uu[8];
#pragma unroll
        for (int d = 0; d < 15; ++d) { const int idx = T0 + 255 - s0 + (d - 7); kw[d] = (idx >= 0 && idx < 511) ? Ks[idx * 16 + cl] : 0.f; }
#pragma unroll
        for (int j = 0; j < 8; ++j) uu[j] = Us[(s0 + j) * 16 + cl];
#pragma unroll
        for (int j = 0; j < 8; ++j)
#pragma unroll
            for (int i = 0; i < 8; ++i) acc[i] += kw[i - j + 7] * uu[j];
    }
    float sn = 0.f;
#pragma unroll
    for (int ch = 0; ch < 8; ++ch) sn += FSC[ch * 1024 + c] + FSC[ch * 1024 + 512 + c];
    const float rs = 1.f / sn, bd = bias_d[c];
#pragma unroll
    for (int i = 0; i < 8; ++i) { const int t = T0 + i; bf16* op = OC + (size_t)(ML + b * CTXL + t) * DM + 512 + c;
        const float x0 = __builtin_bit_cast(float, (unsigned)(*op) << 16);
        *op = (bf16)f2bf((acc[i] * rs + Us[t * 16 + cl] * bd) * x0); }
    __syncthreads();
}
__device__ __forceinline__ void hyena_post(const float* UT, bf16* OC, LAS float* T, int blk, int nblk, int tid) {
    const int c0 = (blk & 7) * 64, rstep = nblk >> 3, cl = tid >> 3, seg = (tid & 7) * 8, tt = tid >> 3, cg8 = (tid & 7) * 8;
    f32x4 a0, a1, n0, n1; v4u xc, xn;
#define HQ_LOAD(o0_, o1_, x_, rt_) do { const int b_ = ((rt_) * 64) >> 13, tb_ = ((rt_) * 64) & (SEQ - 1); const float* src_ = UT + ((size_t)b_ * CW + c0 + cl) * SEQ + tb_ + seg; \
        o0_ = *(const f32x4*)src_; o1_ = *(const f32x4*)(src_ + 4); x_ = *(const v4u*)(OC + (size_t)((rt_) * 64 + tt) * DM + 512 + c0 + cg8); } while (0)
    int rt = blk >> 3;
    if (rt < ML / 64) HQ_LOAD(a0, a1, xc, rt);
    for (; rt < ML / 64; rt += rstep) {
        if (rt + rstep < ML / 64) HQ_LOAD(n0, n1, xn, rt + rstep);
#pragma unroll
        for (int i = 0; i < 4; ++i) { T[(seg + i) * 65 + cl] = a0[i]; T[(seg + 4 + i) * 65 + cl] = a1[i]; }
        __syncthreads();
        { float x0[8]; unpack8(xc, x0);
#pragma unroll
          for (int i = 0; i < 8; ++i) x0[i] *= T[tt * 65 + cg8 + i];
          *(v4u*)(OC + (size_t)(rt * 64 + tt) * DM + 512 + c0 + cg8) = pack8(x0); }
        __syncthreads();
        a0 = n0; a1 = n1; xc = xn;
    }
#undef HQ_LOAD
}
__device__ __forceinline__ void short_conv(const bf16* Z, const float* cw, bf16* OC, int blk, int nblk, int tid) {
    const int cg8 = (tid & 63) * 8;
    float w0[8], w1[8], w2[8];
#pragma unroll
    for (int i = 0; i < 8; ++i) { w0[i] = cw[cg8 + i]; w1[i] = cw[CW + cg8 + i]; w2[i] = cw[2 * CW + cg8 + i]; }
    const v4u zero = (v4u){0u, 0u, 0u, 0u};
    for (int ita = blk; ita < ML / 8; ita += 4 * nblk) {
        v4u r[4][7];
#pragma unroll
        for (int q = 0; q < 4; ++q) { const int it = ita + q * nblk; const bool ok = it < ML / 8; const int row = (ok ? it : ita) * 8 + (tid >> 6), t = row & (SEQ - 1);
            const bf16* zp = Z + (size_t)row * ZW + 1024 + cg8;
            r[q][0] = *(const v4u*)zp; r[q][1] = *(const v4u*)(zp + 512); r[q][2] = *(const v4u*)(zp + 1024);
            r[q][3] = t > 0 ? *(const v4u*)(zp - ZW + 512) : zero; r[q][4] = t > 0 ? *(const v4u*)(zp - ZW + 1024) : zero;
            r[q][5] = t < SEQ - 1 ? *(const v4u*)(zp + ZW + 512) : zero; r[q][6] = t < SEQ - 1 ? *(const v4u*)(zp + ZW + 1024) : zero; }
#pragma unroll
        for (int q = 0; q < 4; ++q) { const int it = ita + q * nblk; if (it >= ML / 8) continue; const int row = it * 8 + (tid >> 6);
            float bg[8], c1[8], x1[8], acc[8];
            unpack8(r[q][0], bg); unpack8(r[q][1], c1); unpack8(r[q][2], x1);
#pragma unroll
            for (int i = 0; i < 8; ++i) acc[i] = c1[i] * x1[i] * w1[i];
            unpack8(r[q][3], c1); unpack8(r[q][4], x1);
#pragma unroll
            for (int i = 0; i < 8; ++i) acc[i] += c1[i] * x1[i] * w0[i];
            unpack8(r[q][5], c1); unpack8(r[q][6], x1);
#pragma unroll
            for (int i = 0; i < 8; ++i) acc[i] += c1[i] * x1[i] * w2[i];
#pragma unroll
            for (int i = 0; i < 8; ++i) acc[i] *= bg[i];
            *(v4u*)(OC + (size_t)row * DM + 512 + cg8) = pack8(acc); }
    }
}
__device__ __forceinline__ float gelu_tanh(float x) { const float u = 0.7978845608028654f * (x + 0.044715f * x * x * x); const float e = __expf(2.f * u); const float th = 1.f - 2.f / (e + 1.f); return 0.5f * x * (1.f + th); }
__device__ __forceinline__ void ffn_gate(const bf16* AV, bf16* G, const float* cw, const float* cb, int row0, int nrows, int blk, int nblk, int tid) {
    const int rs = tid >> 5, jl = tid & 31;
    for (int it = blk; it < nrows / 64; it += nblk) {
        const int r0 = it * 64 + rs * 4;
        for (int cbk = 0; cbk < 11; ++cbk) {
            const int j = cbk * 256 + jl * 8;
            const int ca = (j >> 7) * 256 + (j & 127);
            float w0[8], w1[8], w2[8], bb[8];
#pragma unroll
            for (int i = 0; i < 8; ++i) { w0[i] = cw[j + i]; w1[i] = cw[FF + j + i]; w2[i] = cw[2 * FF + j + i]; bb[i] = cb[j + i]; }
            float prev[8], cur[8], nxt[8];
            { const int gr = row0 + r0; const bool lat = gr < ML; const int tpos = lat ? (gr & (SEQ - 1)) : ((gr - ML) & (CTXL - 1));
              if (tpos > 0) unpack8(*(const v4u*)(AV + (size_t)(r0 - 1) * FF2 + ca), prev); else { for (int i = 0; i < 8; ++i) prev[i] = 0.f; } }
            unpack8(*(const v4u*)(AV + (size_t)r0 * FF2 + ca), cur);
#pragma unroll
            for (int rr = 0; rr < 4; ++rr) {
                const int lr = r0 + rr, gr = row0 + lr; const bool lat = gr < ML; const int tpos = lat ? (gr & (SEQ - 1)) : ((gr - ML) & (CTXL - 1)); const int slen = lat ? SEQ : CTXL;
                if (tpos < slen - 1) unpack8(*(const v4u*)(AV + (size_t)(lr + 1) * FF2 + ca), nxt); else { for (int i = 0; i < 8; ++i) nxt[i] = 0.f; }
                float vv[8], o[8]; unpack8(*(const v4u*)(AV + (size_t)lr * FF2 + ca + 128), vv);
#pragma unroll
                for (int i = 0; i < 8; ++i) { const float a = prev[i] * w0[i] + cur[i] * w1[i] + nxt[i] * w2[i] + bb[i]; o[i] = gelu_tanh(a) * vv[i]; }
                *(v4u*)(G + (size_t)lr * FF + j) = pack8(o);
#pragma unroll
                for (int i = 0; i < 8; ++i) { prev[i] = cur[i]; cur[i] = nxt[i]; }
            }
        }
    }
}

#define RLX_AGENT __ATOMIC_RELAXED, __HIP_MEMORY_SCOPE_AGENT

#define XB_TMO      128
#define XB_XCNT(j)  (256  + 64 * (j))
#define XB_XSUB(j)  (1280 + 64 * (j))
#define XB_XGEN(j)  (2304 + 64 * (j))
#define XB_TOP      3328
#define XB_TOPGEN   3392
#define XCD_BAR_WORDS 3456
#define XB_SPIN_CAP (1u << 18)

__device__ __forceinline__ unsigned xb_ld(unsigned* p)              { return __hip_atomic_load(p, __ATOMIC_RELAXED, __HIP_MEMORY_SCOPE_AGENT); }
__device__ __forceinline__ unsigned xb_add(unsigned* p, unsigned v) { return __hip_atomic_fetch_add(p, v, __ATOMIC_RELAXED, __HIP_MEMORY_SCOPE_AGENT); }
__device__ __forceinline__ unsigned xb_xcc_id() { return (unsigned)__builtin_amdgcn_s_getreg((3 << 11) | 20) & 0xFu; }
#define XB_SPIN(cond, bar) do { unsigned _sp = 0; while (cond) { __builtin_amdgcn_s_sleep(1); \
    if ((++_sp & 255u) == 0u) { if (xb_ld(&(bar)[XB_TMO])) break; if (_sp > XB_SPIN_CAP) { atomicAdd(&(bar)[XB_TMO], 1u); break; } } } } while (0)

struct XcdBarrier {
    unsigned* bar; unsigned x;
    volatile LAS unsigned* st;
};

__device__ __forceinline__ XcdBarrier xcd_barrier_post(unsigned* bar, volatile LAS unsigned* st) {
    XcdBarrier b; b.bar = bar; b.x = xb_xcc_id(); b.st = st;
    if (threadIdx.x == 0) (void)xb_add(&bar[XB_XCNT(b.x)], 1u);
    return b;
}
__device__ __forceinline__ void xcd_barrier_complete(unsigned* bar, unsigned x, unsigned& nloc, unsigned& nx) {
    const unsigned G = gridDim.x * gridDim.y * gridDim.z;
    unsigned sum, cnt, mine, sp = 0u;
    for (;;) {
        sum = 0u; cnt = 0u; mine = 0u;
#pragma unroll
        for (unsigned j = 0; j < 16; ++j) { const unsigned c = xb_ld(&bar[XB_XCNT(j)]); sum += c; cnt += (c > 0u) ? 1u : 0u; mine = (j == x) ? c : mine; }
        if (sum == G) break;
        __builtin_amdgcn_s_sleep(1);
        if ((++sp & 255u) == 0u) { if (xb_ld(&bar[XB_TMO])) break; if (sp > XB_SPIN_CAP) { atomicAdd(&bar[XB_TMO], 1u); break; } }
    }
    nloc = mine > 0u ? mine : 1u; nx = cnt > 0u ? cnt : 1u;
}

__device__ __forceinline__ void xcd_barrier(const XcdBarrier& b) {
    asm volatile("s_waitcnt vmcnt(0)" ::: "memory");
    __syncthreads();
    if (threadIdx.x == 0) {
        unsigned* bar = b.bar;
        __builtin_amdgcn_s_waitcnt(0);
        unsigned nloc = b.st[0], nx = b.st[1];
        if (nloc == 0u) { xcd_barrier_complete(bar, b.x, nloc, nx); b.st[0] = nloc; b.st[1] = nx; }
        const unsigned old = xb_add(&bar[XB_XSUB(b.x)], 1u);
        const unsigned gen = old / nloc;
        if (old + 1u == (gen + 1u) * nloc) {
            __builtin_amdgcn_fence(__ATOMIC_RELEASE, "agent");
            asm volatile("s_waitcnt vmcnt(0)" ::: "memory");
            const unsigned og = xb_add(&bar[XB_TOP], 1u);
            const unsigned tg = og / nx;
            if (og + 1u == (tg + 1u) * nx) xb_add(&bar[XB_TOPGEN], 1u);
            else XB_SPIN(xb_ld(&bar[XB_TOPGEN]) == tg, bar);
            __builtin_amdgcn_fence(__ATOMIC_ACQUIRE, "agent");
            xb_add(&bar[XB_XGEN(b.x)], 1u);
            asm volatile("s_waitcnt vmcnt(0)" ::: "memory");
        } else {
            XB_SPIN(xb_ld(&bar[XB_XGEN(b.x)]) == gen, bar);
            __builtin_amdgcn_fence(__ATOMIC_ACQUIRE, "agent");
            asm volatile("s_waitcnt vmcnt(0)" ::: "memory");
        }
    }
    __syncthreads();
}


constexpr int SEAM_STRIDE = 1152, N_SEAMS = 10;
__device__ __forceinline__ void seam_arrive(unsigned* sw, const XcdBarrier& b) {
    asm volatile("s_waitcnt vmcnt(0)" ::: "memory");
    __syncthreads();
    if (threadIdx.x == 0) { const unsigned nloc = b.st[0]; const unsigned old = xb_add(&sw[64 * (1 + b.x)], 1u);
        if (old + 1u == nloc) { __builtin_amdgcn_fence(__ATOMIC_RELEASE, "agent"); asm volatile("s_waitcnt vmcnt(0)" ::: "memory"); (void)xb_add(&sw[0], 1u); } }
}
__device__ __forceinline__ void seam_wait(unsigned* sw, const XcdBarrier& b) {
    if (threadIdx.x == 0) { const unsigned nx = b.st[1]; unsigned sp = 0u; while (xb_ld(&sw[0]) < nx) { __builtin_amdgcn_s_sleep(4); if (++sp > (1u << 22)) break; }
        __builtin_amdgcn_fence(__ATOMIC_ACQUIRE, "agent"); asm volatile("s_waitcnt vmcnt(0)" ::: "memory"); }
    __syncthreads();
}
constexpr int SEAM_WORDS = N_SEAMS * SEAM_STRIDE;

struct Args { const float* in[29]; float* out; unsigned char* ws; };
enum { I_X = 0, I_C, I_CTX, I_CCTX, I_ADAW, I_ADAB, I_NMIX, I_NFFN, I_WIN, I_WOUT, I_QN, I_KN, I_SINK, I_HCW, I_HCB, I_HW1, I_HB1, I_HW2, I_HB2, I_HW3, I_HB3, I_HW4, I_HFREQ, I_HBIASD, I_SCW, I_WUP, I_FCW, I_FCB, I_WDOWN };

#ifndef PHMASK
#define PHMASK 0xffffffffu
#endif
#define PH(n) ((PHMASK >> (n)) & 1u)
#ifndef DBL
#define DBL 0
#endif
#define REP(b) for (int rep_ = 0; rep_ < (((DBL >> (b)) & 1) ? 2 : 1); ++rep_)
#define TBEG(b) unsigned long long t0_ = 0; if ((DBL >> (b)) & 1) t0_ = __builtin_amdgcn_s_memrealtime()
#define TEND(b) do { if ((DBL >> (b)) & 1) { const unsigned long long t1_ = __builtin_amdgcn_s_memrealtime(), d_ = t1_ - t0_; while (__builtin_amdgcn_s_memrealtime() - t1_ < d_) __builtin_amdgcn_s_sleep(8); } } while (0)
#define GSYNC() do { xcd_barrier(xbar); if (DBL & 1) xcd_barrier(xbar); } while (0)
typedef const float* const __attribute__((address_space(4))) * kargp_t;
#define IDS() int tid = threadIdx.x; asm volatile("" : "+v"(tid)); const int lane = tid & 63, wave = __builtin_amdgcn_readfirstlane(tid >> 6); int bx = blockIdx.x; asm volatile("" : "+s"(bx)); \
    const int gw = bx * 8 + wave, G = gridDim.x, ngw = G * 8; (void)lane; (void)gw; (void)wave; (void)ngw; \
    unsigned long long kb_ = (unsigned long long)__builtin_amdgcn_kernarg_segment_ptr(); asm volatile("" : "+s"(kb_)); const kargp_t KA = (kargp_t)kb_; \
    unsigned char* const ws = (unsigned char*)KA[30]; float* const OUT = (float*)KA[29]; (void)ws; (void)OUT; \
    const bool last = layer == 1; (void)last
#define IN(i) (KA[i])
#define P_MOD ((float*)(ws + WS_MOD))
#define P_TW ((f32x2v*)(ws + WS_TW))
#define P_ROPE ((f32x2v*)(ws + WS_ROPE))
#define P_FSUMC ((float*)(ws + WS_FSUMC))
#define P_FSUM ((float*)(ws + WS_FSUM))
#define P_KC ((float*)(ws + WS_KC))
#define P_UC ((float*)(ws + WS_UC))
#define P_XC ((float*)(ws + WS_XC))
#define P_XR ((bf16*)(ws + WS_XR))
#define P_PART ((float*)(ws + WS_PART))
#define P_XN ((bf16*)(ws + WS_XN))
#define P_Z ((bf16*)(ws + WS_Z))
#define P_OC ((bf16*)(ws + WS_OC))
#define P_UT ((float*)(ws + WS_UT))
#define P_KF ((f32x2v*)(ws + WS_KF))
#define P_AV ((bf16*)(ws + WS_AV))
#define P_G ((bf16*)(ws + WS_G))
#define P_EA ((float*)(ws + WS_EA))
#define P_EV ((float*)(ws + WS_EV))
#define P_MODL (P_MOD + (size_t)layer * 5 * 6144)
#define P_WB (ws + WS_WB + (size_t)layer * WB_LAYER)
#define RES_L (last ? (const float*)OUT : IN(I_X))
#define RES_C (last ? (const float*)P_XC : IN(I_CTX))
__global__ void __launch_bounds__(NTHR, 2) hfb_fwd(Args a) {
    extern __shared__ __attribute__((aligned(16))) unsigned char lds[];
    cg::grid_group grid = cg::this_grid();
    LAS unsigned char* L = (LAS unsigned char*)lds;
    (void)a;
    volatile LAS unsigned* xst = (volatile LAS unsigned*)(L + LDS_BYTES - 64);
    if (threadIdx.x < 2) xst[threadIdx.x] = 0u;
    __syncthreads();
    XcdBarrier xbar;
    { unsigned long long kb0 = (unsigned long long)__builtin_amdgcn_kernarg_segment_ptr(); unsigned char* ws0 = (unsigned char*)((kargp_t)kb0)[30];
      if (blockIdx.x == 0) { unsigned* bw = (unsigned*)(ws0 + WS_BAR); for (int i = threadIdx.x; i < XCD_BAR_WORDS + SEAM_WORDS; i += NTHR) bw[i] = 0u; __threadfence(); } }
    { TBEG(7);
    { const int layer = 0; IDS(); if (PH(0)) p0_weights(IN(I_WIN), IN(I_WOUT), IN(I_WUP), IN(I_WDOWN), ws + WS_WB, (LAS float*)(L + wave * 16384), 0, TI_IN, gw, ngw, lane);
      __syncthreads(); }
    { const int layer = 0; IDS(); if (PH(1)) for (int lt = bx; lt < 512; lt += G) {
        int it; if (lt < 256) it = lt; else { const int j = lt - 256; if (j < 212) it = 272 + j; else if (j < 240) continue; else it = 256 + (j - 240); }
        if (it < 256) { TBEG(18); p0_filter_item<false>(IN(I_HW1), IN(I_HB1), IN(I_HW2), IN(I_HB2), IN(I_HW3), IN(I_HB3), IN(I_HW4), IN(I_HFREQ), P_UT, P_FSUM, (LAS float*)L, it, tid); TEND(18); }
        else if (it < 264) p0_filter_item<true, 0>(IN(I_HW1), IN(I_HB1), IN(I_HW2), IN(I_HB2), IN(I_HW3), IN(I_HB3), IN(I_HW4), IN(I_HFREQ), P_KC, P_FSUMC, (LAS float*)L, it - 256, tid);
        else if (it < 272) p0_filter_item<true, 1>(IN(I_HW1), IN(I_HB1), IN(I_HW2), IN(I_HB2), IN(I_HW3), IN(I_HB3), IN(I_HW4), IN(I_HFREQ), P_KC, P_FSUMC, (LAS float*)L, it - 264, tid);
        else if (it < 464) { TBEG(20); p0_mod_item(IN(I_C), IN(I_CCTX), IN(I_ADAW), IN(I_ADAB), P_MOD, (LAS float*)L, it - 272, tid); TEND(20); }
        else if (it < 480) { const int k = (it - 464) * NTHR + tid; float s, c; sincospif(2.0f * (float)k / (float)NFFT, &s, &c); P_TW[k] = (f32x2v){c, -s}; }
        else { const int e = (it - 480) * NTHR + tid, pos = e >> 4, f = e & 15; const float inv_pi = exp2f(-(float)f * 0.8304820237218406f) * 0.3183098861837907f; float sn, cs; sincospif((float)pos * inv_pi, &sn, &cs); P_ROPE[e] = (f32x2v){cs, sn}; }
    } }
    TEND(7); }
    grid.sync();
    { unsigned long long kb0 = (unsigned long long)__builtin_amdgcn_kernarg_segment_ptr(); unsigned char* ws0 = (unsigned char*)((kargp_t)kb0)[30]; xbar = xcd_barrier_post((unsigned*)(ws0 + WS_BAR), xst); }

#define SEAM(k) ((unsigned*)(ws + WS_BAR) + XCD_BAR_WORDS + SEAM_STRIDE * (k))
#define GEMM_CALL(EpiT) pg8::gemm_phase<EpiT, pg8::StaticOrder, true, true>(L, g, S, E)
#pragma unroll 1
    for (int layer = 0; layer < 2; ++layer) {
        { IDS(); if (!last) { for (int c = bx; c < CW / 2; c += G) filter_fft_item(P_UT, P_FSUM, IN(I_HBIASD), P_KF, P_TW, (LAS f32x2v*)L, (LAS float*)(L + FFT_LDS_ELEMS * 8), c, tid);
                              modulate_rows(IN(I_X), IN(I_CTX), nullptr, IN(I_NMIX), P_MODL, 0, P_XN, 0, MT, gw, ngw, lane); }
                   else modulate_rows(nullptr, nullptr, P_XR, IN(I_NMIX) + DM, P_MODL, 0, P_XN, ML, MT, gw, ngw, lane, P_PART, P_MOD + (size_t)4 * 6144 + 5 * 1024); }
        if (layer == 0) GSYNC(); else { IDS(); seam_arrive(SEAM(9), xbar); }
        { IDS(); const int nctx = last ? 8 : 40;
#pragma unroll 1
          for (int part = 0; part < 2; ++part) {
              if (part == 1) { seam_arrive(SEAM(last ? 4 : 0), xbar); if (bx >= nctx) break; if (last) seam_wait(SEAM(9), xbar); }
              const bool kv = part == 1 && last;
              pg8::Gemm g{P_XN + (part ? (size_t)ML * DM : 0), (const bf16*)(P_WB + WB_IN) + (kv ? (size_t)512 * DM : 0), part ? MC : ML, kv ? 512 : ZW, DM};
              pg8::StaticOrder S; S.init(g.M, g.N, G, bx); EpiStoreBf16 E{P_Z + (part ? (size_t)ML * ZW : 0) + (kv ? 512 : 0), ZW, IN(I_QN) + layer * 64, IN(I_KN) + layer * 64, P_ROPE, part ? 128 : 0, kv ? 2 : 0};
              GEMM_CALL(EpiStoreBf16); }
          if (bx >= nctx) { seam_wait(SEAM(last ? 4 : 0), xbar); const int rk = bx - nctx, nr = G - nctx;
              if (!last) hyena_pre(P_Z, IN(I_HCW), IN(I_HCB), P_OC, P_UT, P_UC, (LAS float*)L, 0, (ML / 64) * 8, rk, nr, tid);
              else short_conv(P_Z, IN(I_SCW), P_OC, rk, nr, tid); } }
        GSYNC();
        if (layer == 0) { { IDS(); hyena_pre(P_Z, IN(I_HCW), IN(I_HCB), P_OC, P_UT, P_UC, (LAS float*)L, (ML / 64) * 8, (MT / 64) * 8, bx, G, tid); }
                          { IDS(); seam_arrive(SEAM(5), xbar); } }
        if (layer == 0) {
            { IDS(); p0_weights(IN(I_WIN), IN(I_WOUT), IN(I_WUP), IN(I_WDOWN), ws + WS_WB, (LAS float*)(L + wave * 16384), TI_IN, 2 * TI_LAYER, gw, ngw, lane);
              __syncthreads(); }
            { IDS(); conv_fft_items(P_UT, P_KF, P_TW, (LAS f32x2v*)L, bx, G, 1024, tid); }
            { IDS(); seam_arrive(SEAM(6), xbar); }
            { IDS(); seam_wait(SEAM(5), xbar); }
            { IDS(); for (int it = G - 1 - bx; it < 128; it += G) ctx_conv_item(P_KC, P_FSUMC, P_UC, IN(I_HBIASD), P_OC, (LAS float*)L, it, tid);
              __syncthreads(); }
            { IDS(); const int vcu = (G % 8 == 0) ? (bx % 8) * (G / 8) + bx / 8 : bx;
              for (int i = 0; i < 5; ++i) {
                const int u = i * 256 + vcu; if (i == 4 && vcu >= 32) break;
                const attn_body::bf16* Zb = (const attn_body::bf16*)P_Z; attn_body::bf16* Ob = (attn_body::bf16*)P_OC;
                int b, h, NT; size_t qrow, lrow;
                if (i < 4) { const int bh = u >> 5, qb = u & 31; b = bh >> 3; h = bh & 7; qrow = (size_t)b * SEQ + qb * 256; lrow = (size_t)b * SEQ; NT = 4 + SEQ / 64; }
                else { b = vcu >> 3; h = vcu & 7; qrow = (size_t)ML + b * CTXL; lrow = qrow; NT = 4; }
                const int kvh = h >> 1; const size_t crow = (size_t)ML + b * CTXL;
                attn_body::attn_unit<8, false>(Zb + qrow * ZW + h * 64, Zb + crow * ZW + 512 + kvh * 64, Zb + lrow * ZW + 512 + kvh * 64, Zb + crow * ZW + 768 + kvh * 64, Zb + lrow * ZW + 768 + kvh * 64,
                                               Ob + qrow * DM + h * 64, NT, 0, 0, 0.f, (char*)lds);
              } }
            { IDS(); seam_wait(SEAM(6), xbar); }
            { IDS(); hyena_post(P_UT, P_OC, (LAS float*)L, bx, G, tid); }
        } else {
            { IDS(); const int vcu = (G % 8 == 0) ? (bx % 8) * (G / 8) + bx / 8 : bx;
              for (int i = 0; i < 4; ++i) {
                const int u = i * 256 + vcu, bh = u >> 5, qb = u & 31, b = bh >> 3, h = bh & 7, kvh = h >> 1;
                const int q0 = qb * 256, klo = q0 - 128 < 0 ? 0 : q0 - 128, khi = q0 + 384 > SEQ ? SEQ : q0 + 384;
                const size_t qrow = (size_t)b * SEQ + q0, crow = (size_t)ML + b * CTXL, lrow = (size_t)b * SEQ + klo;
                const attn_body::bf16* Zb = (const attn_body::bf16*)P_Z; attn_body::bf16* Ob = (attn_body::bf16*)P_OC;
                attn_body::attn_unit<8, true>(Zb + qrow * ZW + h * 64, Zb + crow * ZW + 512 + kvh * 64, Zb + lrow * ZW + 512 + kvh * 64, Zb + crow * ZW + 768 + kvh * 64, Zb + lrow * ZW + 768 + kvh * 64,
                                              Ob + qrow * DM + h * 64, 4 + (khi - klo) / 64, q0, klo, IN(I_SINK)[h] * 1.4426950408889634f, (char*)lds);
              } }
        }
        GSYNC();
        { IDS();
#pragma unroll 1
          for (int part = 0; part < (last ? 1 : 2); ++part) {
              if (part == 1) { seam_arrive(SEAM(1), xbar); if (bx >= 16) break; }
              pg8::Gemm g{P_OC + (part ? (size_t)ML * DM : 0), (const bf16*)(P_WB + WB_OUT), part ? MC : ML, DM, DM}; pg8::StaticOrder S; S.init(g.M, g.N, G, bx);
              EpiRes E{IN(I_X), IN(I_CTX), P_XR, OUT, P_MODL + 2 * 1024, last ? 1 : 0, 1, part ? 128 : 0};
              GEMM_CALL(EpiRes); }
          if (!last && bx >= 16) { seam_wait(SEAM(1), xbar);
              modulate_rows(nullptr, nullptr, P_XR, IN(I_NFFN) + layer * DM, P_MODL, 3 * 1024, P_XN, 0, ML, (bx - 16) * 8 + wave, (G - 16) * 8, lane); } }
        GSYNC();
        { IDS(); modulate_rows(nullptr, nullptr, P_XR, IN(I_NFFN) + layer * DM, P_MODL, 3 * 1024, P_XN, last ? 0 : ML, last ? ML : MT, gw, ngw, lane); }
        if (layer == 1) GSYNC(); else { IDS(); seam_arrive(SEAM(7), xbar); }
        { IDS();
#pragma unroll 1
          for (int part = 0; part < (last ? 1 : 2); ++part) {
              if (part == 1) { seam_arrive(SEAM(2), xbar); if (bx >= 88) break; seam_wait(SEAM(7), xbar); }
              pg8::Gemm g{P_XN + (part ? (size_t)ML * DM : 0), (const bf16*)(P_WB + WB_UP), part ? MC : ML, FF2, DM}; pg8::StaticOrder S; S.init(g.M, g.N, G, bx);
              EpiGate E{P_G, P_EA, P_EV, IN(I_FCW) + (size_t)layer * 3 * FF, IN(I_FCB) + (size_t)layer * FF, part ? 128 : 0};
              GEMM_CALL(EpiGate); }
          if (!last && bx >= 88) { seam_wait(SEAM(2), xbar);
              ffn_fixup(P_G, P_EA, P_EV, IN(I_FCW) + (size_t)layer * 3 * FF, IN(I_FCB) + (size_t)layer * FF, 0, ML / 64, (bx - 88) * NTHR + tid, (G - 88) * NTHR); } }
        GSYNC();
        { IDS(); ffn_fixup(P_G, P_EA, P_EV, IN(I_FCW) + (size_t)layer * 3 * FF, IN(I_FCB) + (size_t)layer * FF, last ? 0 : ML / 64, last ? ML / 64 : MT / 64, bx * NTHR + tid, G * NTHR); }
        if (layer == 1) GSYNC(); else { IDS(); seam_arrive(SEAM(8), xbar); }
        { IDS();
          { pg8::Gemm g{P_G, (const bf16*)(P_WB + WB_DOWN), ML, DM, FF, 0}; pg8::StaticOrder S; S.init(g.M, g.N, G, bx);
            EpiRes E{nullptr, nullptr, P_XR, OUT, P_MODL + 5 * 1024, 1, last ? 0 : 1, 0};
            GEMM_CALL(EpiRes); }
          if (!last) { seam_arrive(SEAM(3), xbar);
              if (bx < 32) { seam_wait(SEAM(8), xbar); const int half = bx >> 4;
                  pg8::Gemm g{P_G + (size_t)ML * FF + half * (FF / 2), (const bf16*)(P_WB + WB_DOWN) + half * (FF / 2), MC, DM, FF / 2, FF}; pg8::StaticOrder S; S.init(g.M, g.N, G, bx & 15);
                  EpiPartial E{P_PART + (size_t)half * MC * DM};
                  GEMM_CALL(EpiPartial); } }
          if (!last && bx >= 32) { seam_wait(SEAM(3), xbar);
              modulate_rows(nullptr, nullptr, P_XR, IN(I_NMIX) + DM, P_MOD + (size_t)5 * 6144, 0, P_XN, 0, ML, (bx - 32) * 8 + wave, (G - 32) * 8, lane); } }
        if (layer == 0) GSYNC();
    }
}

extern "C" void kernel_launch(void* const* d_in, const int* in_sizes, int n_in, void* d_out, int out_size, void* d_ws, size_t ws_size, hipStream_t stream) {
    static int grid = 0;
    if (grid == 0) {
        if (n_in != 29 || out_size != ML * DM || ws_size < WS_END) { fprintf(stderr, "kernel_launch: unexpected shapes (n_in %d, out %d, ws %zu < %zu)\n", n_in, out_size, ws_size, (size_t)WS_END); grid = -1; return; }
        int dev = 0, cus = 0, per_cu = 0;
        hipGetDevice(&dev); hipDeviceGetAttribute(&cus, hipDeviceAttributeMultiprocessorCount, dev);
        if (hipFuncSetAttribute((const void*)hfb_fwd, hipFuncAttributeMaxDynamicSharedMemorySize, LDS_BYTES) != hipSuccess) { fprintf(stderr, "kernel_launch: hipFuncSetAttribute failed\n"); grid = -1; return; }
        if (hipOccupancyMaxActiveBlocksPerMultiprocessor(&per_cu, (const void*)hfb_fwd, NTHR, LDS_BYTES) != hipSuccess || per_cu < 1) { fprintf(stderr, "kernel_launch: occupancy query says %d\n", per_cu); per_cu = 1; }
        (void)hipGetLastError();
        grid = cus;
    }
    if (grid < 0) return;
    Args a{};
    for (int i = 0; i < 29; ++i) a.in[i] = (const float*)d_in[i];
    a.out = (float*)d_out; a.ws = (unsigned char*)d_ws;
    void* args[] = {&a};
    hipError_t e = hipLaunchCooperativeKernel((const void*)hfb_fwd, dim3(grid), dim3(NTHR), args, LDS_BYTES, stream);
    if (e != hipSuccess) fprintf(stderr, "cooperative launch failed: %s (grid %d)\n", hipGetErrorString(e), grid);
}
```

```cpp
#include <hip/hip_runtime.h>
#include <hip/hip_cooperative_groups.h>
#include <hip/hip_bf16.h>
#include <cstdio>
#include <cstdint>
#include <cmath>
namespace cg = cooperative_groups;
namespace pg8 {
#define PG8_LAS __attribute__((address_space(3)))
typedef unsigned short bf16_t;
typedef short bf16x8 __attribute__((ext_vector_type(8)));
typedef float f32x4 __attribute__((ext_vector_type(4)));
typedef unsigned u32x4 __attribute__((ext_vector_type(4)));
constexpr int BM = 256, BK = 64, HALF = 128, HTB = HALF * BK * 2  , STAGE_BYTES = 8 * HTB, NXCD = 8, WGM = 8;

__host__ __device__ __forceinline__ int lds_byte(int r, int c) { const int st = (r >> 4) * 2 + (c >> 5), rr = r & 15, cc = c & 31, ob = rr * 64 + cc * 2; return st * 1024 + (ob ^ (((ob >> 9) & 1) << 5)); }
__host__ __device__ __forceinline__ void stage_rc(int b, int& R, int& C) { const int st = b / 1024, sb = b % 1024, swz = sb ^ (((sb >> 9) & 1) << 5); R = (st >> 1) * 16 + swz / 64; C = (st & 1) * 32 + (swz % 64) / 2; }
__host__ __device__ __forceinline__ int perm32(int rho) { const int n = rho >> 4, i = rho & 15; return 8 * (i >> 2) + 4 * n + (i & 3); }

struct Unit { int pm, pn; };
struct Gemm { const bf16_t* A; const bf16_t* Bt; int M, N, K, ld; };

struct StaticOrder {
    int nM, nN, nwg, G, c;
    __host__ __device__ void init(int M, int N, int G_, int c_) { nM = M / BM; nN = N / BM; nwg = nM * nN; G = G_; c = c_; }
    __host__ __device__ bool next(int i, Unit& u) const {
        const long L = (long)i * G + c; if (L >= nwg) return false;
        int wgid = (int)L; { const int q = nwg / NXCD, r = nwg % NXCD, xcd = wgid % NXCD, off = wgid / NXCD; wgid = (xcd < r ? xcd * (q + 1) : r * (q + 1) + (xcd - r) * q) + off; }
        const int nig = WGM * nN, gid = wgid / nig, fm = gid * WGM, gsz = (nM - fm) < WGM ? (nM - fm) : WGM;
        u.pm = fm + ((wgid % nig) % gsz); u.pn = (wgid % nig) / gsz; return true;
    }
    __device__ __forceinline__ void a_ready(const Unit&) const {}
    __device__ __forceinline__ void done(const Unit&) const {}
};

__device__ __forceinline__ unsigned cvt_pk_bf16(float lo, float hi) { unsigned r; asm volatile("v_cvt_pk_bf16_f32 %0, %1, %2" : "=v"(r) : "v"(lo), "v"(hi)); return r; }
template <class Epi, class Sched, bool ALIGN_EPI = false, bool SP2 = false>
__device__ __forceinline__ void gemm_phase(PG8_LAS unsigned char* lds, const Gemm g, const Sched& S, const Epi& E) {
    int tid_o = threadIdx.x; asm volatile("" : "+v"(tid_o));
    const int tid = tid_o, wid = __builtin_amdgcn_readfirstlane(tid >> 6), lane = tid & 63, wr = wid >> 2, wc = wid & 3, fr = lane & 15, fq = lane >> 4;
    const int K = g.K, nt = K / BK, LD = g.ld ? g.ld : g.K;
    unsigned voffA[2], voffB[2];
#pragma unroll
    for (int i = 0; i < 2; ++i) { int R, C; stage_rc(tid * 16 + i * 8192, R, C); const int Rb = Epi::PERM ? ((R & ~31) + perm32(R & 31)) : R;
        voffA[i] = (unsigned)(R * LD + C) * 2u; voffB[i] = (unsigned)(Rb * LD + C) * 2u; }
    const size_t kstep = (size_t)(BK * 2);
    const size_t hstep = (size_t)HALF * LD * 2;
    const size_t tstep = 2 * hstep;
    const unsigned ldsw = (unsigned)wid * 1024u;
    const int aoff = lds_byte(wr * 64 + fr, fq * 8), boff = lds_byte(wc * 32 + fr, fq * 8);
#define PG8_SA(b, h) (((b) * 2 + (h)) * HTB)
#define PG8_SB(b, h) ((4 + (b) * 2 + (h)) * HTB)
#define PG8_STAGE(bufoff, gbase, voff) do { _Pragma("unroll") for (int _i = 0; _i < 2; ++_i) \
        __builtin_amdgcn_global_load_lds((const unsigned*)((const char*)(gbase) + (voff)[_i]), (PG8_LAS unsigned*)(lds + (bufoff) + ldsw + _i * 8192), 16, 0, 0); } while (0)
#define PG8_LDA(dst, b, h) do { _Pragma("unroll") for (int m = 0; m < 4; ++m) _Pragma("unroll") for (int k = 0; k < 2; ++k) dst[m][k] = *(const PG8_LAS bf16x8*)(lds + PG8_SA(b, h) + aoff + m * 2048 + k * 1024); } while (0)
#define PG8_LDB(dst, b, h) do { _Pragma("unroll") for (int n = 0; n < 2; ++n) _Pragma("unroll") for (int k = 0; k < 2; ++k) dst[n][k] = *(const PG8_LAS bf16x8*)(lds + PG8_SB(b, h) + boff + n * 2048 + k * 1024); } while (0)
#define PG8_MMA(ai, bj, At, Bt) do { __builtin_amdgcn_s_setprio(1); _Pragma("unroll") for (int m = 0; m < 4; ++m) _Pragma("unroll") for (int n = 0; n < 2; ++n) _Pragma("unroll") for (int k = 0; k < 2; ++k) \
        acc[ai][bj][m][n] = __builtin_amdgcn_mfma_f32_16x16x32_bf16(Bt[n][k], At[m][k], acc[ai][bj][m][n], 0, 0, 0); __builtin_amdgcn_s_setprio(0); } while (0)
#define PG8_WAIT_V(n) asm volatile("s_waitcnt vmcnt(" #n ")" ::: "memory")
#define PG8_WAIT_L(n) asm volatile("s_waitcnt lgkmcnt(" #n ")" ::: "memory")
#define PG8_BAR __builtin_amdgcn_s_barrier()
#define PG8_SCHED __builtin_amdgcn_sched_barrier(0)
    Unit cur, nxt; int ui = 0;
    if (!S.next(0, cur)) return;
    f32x4 acc[2][2][4][2];
#pragma unroll
    for (int a = 0; a < 2; ++a)
#pragma unroll
        for (int b = 0; b < 2; ++b)
#pragma unroll
            for (int m = 0; m < 4; ++m)
#pragma unroll
                for (int n = 0; n < 2; ++n) acc[a][b][m][n] = (f32x4){0.f, 0.f, 0.f, 0.f};
    bf16x8 At[4][2], B0[2][2], B1[2][2];
    const char* cA = (const char*)g.A + (size_t)cur.pm * tstep; const char* cB = (const char*)g.Bt + (size_t)cur.pn * tstep;
    S.a_ready(cur);
    if constexpr (SP2) {
        PG8_STAGE(PG8_SB(0, 0), cB, voffB); PG8_STAGE(PG8_SB(0, 1), cB + hstep, voffB); PG8_STAGE(PG8_SA(0, 0), cA, voffA); PG8_STAGE(PG8_SA(0, 1), cA + hstep, voffA);
        if (wr == 1) PG8_BAR;
        PG8_WAIT_V(2); PG8_BAR;
        PG8_STAGE(PG8_SB(1, 0), cB + kstep, voffB); PG8_STAGE(PG8_SA(1, 0), cA + kstep, voffA); PG8_STAGE(PG8_SB(1, 1), cB + hstep + kstep, voffB);
        PG8_WAIT_V(6); PG8_BAR;
    } else {
        PG8_STAGE(PG8_SB(0, 0), cB, voffB); PG8_STAGE(PG8_SA(0, 0), cA, voffA); PG8_STAGE(PG8_SB(0, 1), cB + hstep, voffB); PG8_STAGE(PG8_SA(0, 1), cA + hstep, voffA);
        if (wr == 1) PG8_BAR;
        PG8_WAIT_V(4); PG8_BAR;
        PG8_STAGE(PG8_SB(1, 0), cB + kstep, voffB); PG8_STAGE(PG8_SA(1, 0), cA + kstep, voffA); PG8_STAGE(PG8_SB(1, 1), cB + hstep + kstep, voffB);
        PG8_WAIT_V(6); PG8_BAR;
    }
    for (;;) {
        const bool has_next = S.next(ui + 1, nxt);
        const char* nA = has_next ? (const char*)g.A + (size_t)nxt.pm * tstep : cA; const char* nB = has_next ? (const char*)g.Bt + (size_t)nxt.pn * tstep : cB;
        for (int t = 0; t < nt; t += 2) {
            const bool last = (t == nt - 2);
            const char* a1 = cA + (size_t)(t + 1) * kstep;
            const char* a2 = last ? nA : cA + (size_t)(t + 2) * kstep; const char* b2 = last ? nB : cB + (size_t)(t + 2) * kstep;
            const char* a3 = a2 + kstep; const char* b3 = b2 + kstep;
            if (last && has_next) S.a_ready(nxt);
            if constexpr (SP2) {
            PG8_LDB(B0, 0, 0); PG8_LDB(B1, 0, 1); PG8_SCHED; PG8_LDA(At, 0, 0); PG8_STAGE(PG8_SA(1, 1), a1 + hstep, voffA);
            PG8_WAIT_V(8); PG8_WAIT_L(0); PG8_BAR; PG8_MMA(0, 0, At, B0); PG8_MMA(0, 1, At, B1); PG8_BAR; PG8_SCHED;
            PG8_LDA(At, 0, 1); PG8_STAGE(PG8_SB(0, 0), b2, voffB); PG8_STAGE(PG8_SB(0, 1), b2 + hstep, voffB); PG8_STAGE(PG8_SA(0, 0), a2, voffA);
            PG8_WAIT_V(8); PG8_WAIT_L(0); PG8_BAR; PG8_MMA(1, 0, At, B0); PG8_MMA(1, 1, At, B1); PG8_BAR; PG8_SCHED;
            PG8_LDB(B0, 1, 0); PG8_LDB(B1, 1, 1); PG8_SCHED; PG8_LDA(At, 1, 0); PG8_STAGE(PG8_SA(0, 1), a2 + hstep, voffA);
            PG8_WAIT_V(8); PG8_WAIT_L(0); PG8_BAR; PG8_MMA(0, 0, At, B0); PG8_MMA(0, 1, At, B1); PG8_BAR; PG8_SCHED;
            PG8_LDA(At, 1, 1); PG8_STAGE(PG8_SB(1, 0), b3, voffB); PG8_STAGE(PG8_SB(1, 1), b3 + hstep, voffB); PG8_STAGE(PG8_SA(1, 0), a3, voffA);
            PG8_WAIT_V(8); PG8_WAIT_L(0); PG8_BAR; PG8_MMA(1, 0, At, B0); PG8_MMA(1, 1, At, B1); PG8_BAR; PG8_SCHED;
            } else {
            PG8_LDB(B0, 0, 0); PG8_SCHED; PG8_LDA(At, 0, 0); PG8_STAGE(PG8_SA(1, 1), a1 + hstep, voffA);
            PG8_WAIT_L(8); PG8_BAR; PG8_WAIT_L(0); PG8_MMA(0, 0, At, B0); PG8_BAR; PG8_SCHED;
            PG8_LDB(B1, 0, 1); PG8_STAGE(PG8_SB(0, 0), b2, voffB);
            PG8_BAR; PG8_WAIT_L(0); PG8_MMA(0, 1, At, B1); PG8_BAR;
            PG8_LDA(At, 0, 1); PG8_STAGE(PG8_SA(0, 0), a2, voffA);
            PG8_BAR; PG8_WAIT_L(0); PG8_MMA(1, 0, At, B0); PG8_BAR; PG8_SCHED;
            PG8_STAGE(PG8_SB(0, 1), b2 + hstep, voffB);
            PG8_WAIT_V(6); PG8_BAR; PG8_MMA(1, 1, At, B1); PG8_BAR;
            PG8_LDB(B0, 1, 0); PG8_SCHED; PG8_LDA(At, 1, 0); PG8_STAGE(PG8_SA(0, 1), a2 + hstep, voffA);
            PG8_WAIT_L(8); PG8_BAR; PG8_WAIT_L(0); PG8_MMA(0, 0, At, B0); PG8_BAR; PG8_SCHED;
            PG8_LDB(B1, 1, 1); PG8_STAGE(PG8_SB(1, 0), b3, voffB);
            PG8_BAR; PG8_WAIT_L(0); PG8_MMA(0, 1, At, B1); PG8_BAR;
            PG8_LDA(At, 1, 1); PG8_STAGE(PG8_SA(1, 0), a3, voffA);
            PG8_BAR; PG8_WAIT_L(0); PG8_MMA(1, 0, At, B0); PG8_BAR; PG8_SCHED;
            PG8_STAGE(PG8_SB(1, 1), b3 + hstep, voffB);
            PG8_WAIT_V(6); PG8_BAR; PG8_MMA(1, 1, At, B1); PG8_BAR;
            }
        }
        if constexpr (ALIGN_EPI) { if (wr == 0) PG8_BAR; }
        if constexpr (!Epi::AFTER_DRAIN) { E(acc, cur, wr, wc, fr, fq); S.done(cur); }
        if (!has_next) break;
#pragma unroll
        for (int a = 0; a < 2; ++a)
#pragma unroll
            for (int b = 0; b < 2; ++b)
#pragma unroll
                for (int m = 0; m < 4; ++m)
#pragma unroll
                    for (int n = 0; n < 2; ++n) acc[a][b][m][n] = (f32x4){0.f, 0.f, 0.f, 0.f};
        cur = nxt; cA = nA; cB = nB; ++ui;
        if constexpr (ALIGN_EPI) { if (wr == 1) PG8_BAR; }
    }
    PG8_WAIT_V(0);
    if constexpr (!ALIGN_EPI) { if (wr == 0) PG8_BAR; }
    PG8_BAR;
    if constexpr (Epi::AFTER_DRAIN) { E.fused(acc, cur, wr, wc, fr, fq, lds, wid, lane); S.done(cur); }
#undef PG8_SA
#undef PG8_SB
#undef PG8_STAGE
#undef PG8_LDA
#undef PG8_LDB
#undef PG8_MMA
#undef PG8_WAIT_V
#undef PG8_WAIT_L
#undef PG8_BAR
#undef PG8_SCHED
}
}
#include <hip/hip_bf16.h>
#include <cmath>
namespace attn_body {
using bf16=__hip_bfloat16;
using bf16x8=__attribute__((ext_vector_type(8)))short;
using s16x4=__attribute__((ext_vector_type(4)))short;
using f32x16=__attribute__((ext_vector_type(16)))float;
using u32x4=__attribute__((ext_vector_type(4)))unsigned;
constexpr int D=64,ZP=2560,OP=1024;
constexpr int NW=8,QBLK=32,QB=QBLK*NW,KVBLK=64;
__device__ __forceinline__ int crow(int r,int hi){return (r&3)+8*(r>>2)+4*hi;}
#define SBAR() __builtin_amdgcn_sched_barrier(0)
__device__ __forceinline__ void cmask(f32x16&p0,f32x16&p1,int jb,int qrel,int hi){
  const float NEG=-INFINITY; int kb=64*jb+4*hi;
  #pragma unroll
  for(int r=0;r<16;++r){int kv=kb+(r&3)+8*(r>>2); if(kv>qrel)p0[r]=NEG; if(kv+32>qrel)p1[r]=NEG;}
}

__device__ __forceinline__ void bandmask(f32x16&p0,f32x16&p1,int ktile0,int qabs,int hi){
  const float NEG=-INFINITY; const int kb=ktile0+4*hi-qabs;
  #pragma unroll
  for(int r=0;r<16;++r){int d=kb+(r&3)+8*(r>>2); if(d>128||d<-128)p0[r]=NEG; if(d+32>128||d+32<-128)p1[r]=NEG;}
}
constexpr int NSLOT=3, SLOTB=8192;
constexpr int LDS_K=0, LDS_V=NSLOT*SLOTB, LDS_WS=2*NSLOT*SLOTB, LDS_OST=LDS_WS+NW*64*4, LDS_BYTES=LDS_OST+NW*4096;
constexpr float C2=0.125f*1.4426950408889634f;
__device__ __forceinline__ void glds16(const void*gsrc,unsigned lds_dst){unsigned keep;
  asm volatile("s_mov_b32 %0, m0\n\ts_mov_b32 m0, %2\n\ts_nop 0\n\tglobal_load_lds_dwordx4 %1, off\n\ts_mov_b32 m0, %0":"=&s"(keep):"v"(gsrc),"s"(lds_dst):"memory");}
__device__ __forceinline__ float max3f(float a,float b,float c){float r;asm("v_max3_f32 %0, %1, %2, %3":"=v"(r):"v"(a),"v"(b),"v"(c));return r;}
__device__ __forceinline__ float max2f(float a,float b){float r;asm("v_max_f32_e32 %0, %1, %2":"=v"(r):"v"(a),"v"(b));return r;}
__device__ __forceinline__ float fadd_s(float a,float b){float r;asm("v_add_f32_e32 %0, %1, %2":"=v"(r):"v"(a),"v"(b));return r;}
__device__ __forceinline__ float fsub_s(float a,float b){float r;asm("v_sub_f32_e32 %0, %1, %2":"=v"(r):"v"(a),"v"(b));return r;}
typedef float f32x2_t __attribute__((ext_vector_type(2))); typedef __bf16 bf16x2_t __attribute__((ext_vector_type(2)));
__device__ __forceinline__ unsigned cvtpk_s(float lo,float hi){f32x2_t v={lo,hi};bf16x2_t b=__builtin_convertvector(v,bf16x2_t);return __builtin_bit_cast(unsigned,b);}
#define WAIT_BAR(N) asm volatile("s_waitcnt vmcnt(" #N ") lgkmcnt(0)\n\ts_barrier":::"memory")

__device__ __forceinline__ void qkt(f32x16&p0,f32x16&p1,const char*Kslot,const bf16x8*qr,const f32x16&negm,int r32,int hi){
  const char*kb=Kslot+hi*1024+r32*16;
  #pragma unroll
  for(int d0=0;d0<4;++d0){
    const bf16x8 b0=*reinterpret_cast<const bf16x8*>(kb+d0*2048);
    const bf16x8 b1=*reinterpret_cast<const bf16x8*>(kb+d0*2048+512);
    if(d0==0){p0=__builtin_amdgcn_mfma_f32_32x32x16_bf16(b0,qr[0],negm,0,0,0);p1=__builtin_amdgcn_mfma_f32_32x32x16_bf16(b1,qr[0],negm,0,0,0);}
    else{p0=__builtin_amdgcn_mfma_f32_32x32x16_bf16(b0,qr[d0],p0,0,0,0);p1=__builtin_amdgcn_mfma_f32_32x32x16_bf16(b1,qr[d0],p1,0,0,0);}}
}
typedef __attribute__((address_space(3))) const char* lds_cptr;
typedef short v4i16_t __attribute__((ext_vector_type(4)));
__device__ __forceinline__ void kload8(bf16x8*kf,lds_cptr kp){
  kf[0]=*(const __attribute__((address_space(3))) bf16x8*)(kp);      kf[1]=*(const __attribute__((address_space(3))) bf16x8*)(kp+512);
  kf[2]=*(const __attribute__((address_space(3))) bf16x8*)(kp+2048); kf[3]=*(const __attribute__((address_space(3))) bf16x8*)(kp+2560);
  kf[4]=*(const __attribute__((address_space(3))) bf16x8*)(kp+4096); kf[5]=*(const __attribute__((address_space(3))) bf16x8*)(kp+4608);
  kf[6]=*(const __attribute__((address_space(3))) bf16x8*)(kp+6144); kf[7]=*(const __attribute__((address_space(3))) bf16x8*)(kp+6656);
}
__device__ __forceinline__ void kload2(bf16x8*kf,lds_cptr kp,int j){ kf[2*j]=*(const __attribute__((address_space(3))) bf16x8*)(kp+j*2048); kf[2*j+1]=*(const __attribute__((address_space(3))) bf16x8*)(kp+j*2048+512); }
__device__ __forceinline__ s16x4 vtr(lds_cptr p){ return __builtin_bit_cast(s16x4,__builtin_amdgcn_ds_read_tr16_b64_v4i16((__attribute__((address_space(3))) v4i16_t*)p)); }
__device__ __forceinline__ float rowmax(const f32x16&p0,const f32x16&p1){
  float a=max3f(p0[0],p0[1],p1[0]),b=max3f(p0[2],p0[3],p1[1]);a=max3f(a,p1[2],p1[3]);
  #pragma unroll
  for(int r=4;r<16;r+=4){a=max3f(a,p0[r],p0[r+1]);b=max3f(b,p0[r+2],p0[r+3]);a=max3f(a,p1[r],p1[r+1]);b=max3f(b,p1[r+2],p1[r+3]);}
  const float m=max2f(a,b);
  auto rr=__builtin_amdgcn_permlane32_swap(__float_as_uint(m),__float_as_uint(m),false,false);
  return max2f(__uint_as_float(rr[0]),__uint_as_float(rr[1]));
}
__device__ __forceinline__ void pv(f32x16*o,int vb,bf16x8 pa0,bf16x8 pa1,bf16x8 pa2,bf16x8 pa3){
  #pragma unroll
  for(int d0=0;d0<2;++d0){s16x4 lo[4],hi[4];
    #pragma unroll
    for(int ks=0;ks<4;++ks){
      asm volatile("ds_read_b64_tr_b16 %0,%1 offset:%c2":"=&v"(lo[ks]):"v"(vb),"i"(d0*4096+ks*1024):"memory");
      asm volatile("ds_read_b64_tr_b16 %0,%1 offset:%c2":"=&v"(hi[ks]):"v"(vb),"i"(d0*4096+ks*1024+512):"memory");}
    asm volatile("s_waitcnt lgkmcnt(0)":::"memory");SBAR();
    #define PK(k) (bf16x8){lo[k][0],lo[k][1],lo[k][2],lo[k][3],hi[k][0],hi[k][1],hi[k][2],hi[k][3]}
    o[d0]=__builtin_amdgcn_mfma_f32_32x32x16_bf16(pa0,PK(0),o[d0],0,0,0);
    o[d0]=__builtin_amdgcn_mfma_f32_32x32x16_bf16(pa1,PK(1),o[d0],0,0,0);
    o[d0]=__builtin_amdgcn_mfma_f32_32x32x16_bf16(pa2,PK(2),o[d0],0,0,0);
    o[d0]=__builtin_amdgcn_mfma_f32_32x32x16_bf16(pa3,PK(3),o[d0],0,0,0);
    #undef PK
  }
}

#ifndef ATTN_STORE16
#define ATTN_STORE16(p,v) (*(u32x4*)(p)=(v))
#endif
template<int THRL,bool BANDED> __device__ __forceinline__ void attn_unit(const bf16*Qrows,const bf16*__restrict__ Kc,const bf16*__restrict__ Kl,const bf16*__restrict__ Vc,const bf16*__restrict__ Vl,bf16*Orows,const int NT,const int qpos0,const int kpos0,const float sink_l2,char*shm){
  int tid_o=threadIdx.x; asm volatile("":"+v"(tid_o)); const int tid=tid_o,lane=tid&63,r32=lane&31,hi=lane>>5; const int wid=__builtin_amdgcn_readfirstlane(tid>>6);
  const bf16*Qw=Qrows+(long)(wid*QBLK)*ZP;
  const unsigned lds0=(unsigned)(uintptr_t)shm;
  float*wsf=(float*)(shm+LDS_WS)+wid*64;
  const long koff=(long)lane*ZP+wid*8, voff=(long)(16*(wid&3)+(lane>>2))*ZP+(wid>>2)*32+(lane&3)*8;
  const bf16*ksrc_c=Kc+koff,*ksrc_l=Kl+koff-(long)4*KVBLK*ZP,*vsrc_c=Vc+voff,*vsrc_l=Vl+voff-(long)4*KVBLK*ZP;
  const unsigned kdst=lds0+LDS_K+wid*1024, vdst=lds0+LDS_V+wid*1024;
  #define DMA_K(t,slot) glds16((((t)<4)?ksrc_c:ksrc_l)+(long)(t)*KVBLK*ZP,(unsigned)__builtin_amdgcn_readfirstlane(kdst+(slot)))
  #define DMA_V(t,slot) glds16((((t)<4)?vsrc_c:vsrc_l)+(long)(t)*KVBLK*ZP,(unsigned)__builtin_amdgcn_readfirstlane(vdst+(slot)))
  const int vb0=(int)(lds0+LDS_V)+((lane>>4)&1)*32+(lane&3)*8+(4*hi+((lane&15)>>2))*64;
  const char*Kbase=shm+LDS_K; bf16x8 kf[8];
  const lds_cptr shm3=(lds_cptr)shm; const lds_cptr kp0=shm3+LDS_K+hi*1024+r32*16; const lds_cptr vp0=shm3+LDS_V+((lane>>4)&1)*32+(lane&3)*8+(4*hi+((lane&15)>>2))*64;
  DMA_K(0,0);DMA_V(0,0);DMA_K(1,SLOTB);
  bf16x8 qr[4];
  #pragma unroll
  for(int d0=0;d0<4;++d0)qr[d0]=*reinterpret_cast<const bf16x8*>(&Qw[(long)r32*ZP+d0*16+hi*8]);
  float mhat=0.f,l_reg=0.f;f32x16 o[2];o[0]=f32x16{};o[1]=f32x16{};f32x16 negm=f32x16{};asm volatile("":"+v"(negm));
  const int qrel=wid*QBLK+r32;
  #define CMASK(P0,P1,t) do{ if(BANDED&&(t)>=4) bandmask(P0,P1,kpos0+64*((t)-4),qpos0+qrel,hi); }while(0)
  bool resc=false;
  #define START(P0,P1) do{ const float rm=rowmax(P0,P1); resc=false; \
    { const float dl=rm; mhat=fadd_s(mhat,dl); \
      _Pragma("unroll") for(int r=0;r<16;++r){P0[r]=fsub_s(P0[r],dl);P1[r]=fsub_s(P1[r],dl);} \
      _Pragma("unroll") for(int r=0;r<16;++r)negm[r]=-mhat; asm volatile("":"+v"(negm)); } \
    _Pragma("unroll") for(int r=0;r<16;++r)P0[r]=__builtin_amdgcn_exp2f(P0[r]); }while(0)
  #define RESC() do{ if(resc){ asm volatile("s_waitcnt lgkmcnt(0)":::"memory"); \
      _Pragma("unroll") for(int d_=0;d_<2;++d_) _Pragma("unroll") for(int r=0;r<16;++r)o[d_][r]*=wsf[crow(r,hi)]; } }while(0)
  f32x16 pA0,pA1,pB0,pB1;
  int sl_prev=0,sl_cur=0,sl_next=SLOTB;
  #define ROT() do{sl_prev=sl_cur;sl_cur=sl_next;sl_next=(sl_next==(NSLOT-1)*SLOTB)?0:sl_next+SLOTB;}while(0)
  DMA_K(2,2*SLOTB);
  WAIT_BAR(3);
  qkt(pA0,pA1,Kbase,qr,negm,r32,hi);asm volatile("s_nop 15\n\ts_nop 7":"+v"(pA0),"+v"(pA1));CMASK(pA0,pA1,0);
  START(pA0,pA1);
  _Pragma("unroll") for(int r=0;r<16;++r)pA1[r]=__builtin_amdgcn_exp2f(pA1[r]);
  WAIT_BAR(0);
  DMA_K(3,0);DMA_V(1,SLOTB);
  ROT();
  kload8(kf,kp0+sl_cur);
  WAIT_BAR(2);
  s16x4 vlo[8],vhi[8]; u32x4 pw0,pw1,pw2,pw3;
  #define PKW(P,B) cvtpk_s(P[B],P[B+1])
  #define PAF(k) __builtin_bit_cast(bf16x8,pw##k)
  #define VFR(i) (bf16x8){vlo[i][0],vlo[i][1],vlo[i][2],vlo[i][3],vhi[i][0],vhi[i][1],vhi[i][2],vhi[i][3]}
  #define PIN(x) asm volatile("":"+v"(x))
  #define MX3(a,b,c) __builtin_fmaxf(__builtin_fmaxf((a),(b)),(c))
  #define GAPA(MF,A0,A1,A2,A3,W0,W1,PW) do{ MF; sacc+=A0; sacc+=A1; sacc+=A2; sacc+=A3; PIN(sacc); W0; W1; PIN(PW); SBAR(); }while(0)
  #define EX(v) __builtin_amdgcn_exp2f(v)
  #define GAPB(MF,X,B) do{ MF; X[B]=EX(X[B]); X[B+1]=EX(X[B+1]); X[B+2]=EX(X[B+2]); X[B+3]=EX(X[B+3]); PIN(X); SBAR(); }while(0)
  #define VRD(i) do{ vlo[i]=vtr(vp_+(((i)>>2)*4096+((i)&3)*1024)); vhi[i]=vtr(vp_+(((i)>>2)*4096+((i)&3)*1024+512)); }while(0)
  #define KRD(G,j) do{ if(G){ kload2(kf,kp0+sl_next,j); SBAR(); } }while(0)
  #define STEP(C0,C1,P0,P1,t,GK,GV,GL) do{ SBAR(); \
    const lds_cptr vp_=vp0+sl_prev; \
    VRD(0); SBAR(); float sacc=(P0[0]+P0[1]); \
    GAPA(C0=__builtin_amdgcn_mfma_f32_32x32x16_bf16(kf[0],qr[0],negm,0,0,0), P0[2],P0[3],P0[4],P0[5],     pw0[0]=PKW(P0,0), pw0[1]=PKW(P0,2), pw0); \
    VRD(4); SBAR(); GAPA(C1=__builtin_amdgcn_mfma_f32_32x32x16_bf16(kf[1],qr[0],negm,0,0,0), P0[6],P0[7],P0[8],P0[9],     pw0[2]=PKW(P0,4), pw0[3]=PKW(P0,6), pw0); \
    VRD(1); SBAR(); GAPA(C0=__builtin_amdgcn_mfma_f32_32x32x16_bf16(kf[2],qr[1],C0,0,0,0),   P0[10],P0[11],P0[12],P0[13], pw1[0]=PKW(P0,8), pw1[1]=PKW(P0,10), pw1); \
    VRD(5); SBAR(); GAPA(C1=__builtin_amdgcn_mfma_f32_32x32x16_bf16(kf[3],qr[1],C1,0,0,0),   P0[14],P0[15],P1[0],P1[1],   pw1[2]=PKW(P0,12),pw1[3]=PKW(P0,14), pw1); \
    VRD(2); SBAR(); GAPA(C0=__builtin_amdgcn_mfma_f32_32x32x16_bf16(kf[4],qr[2],C0,0,0,0),   P1[2],P1[3],P1[4],P1[5],     pw2[0]=PKW(P1,0), pw2[1]=PKW(P1,2), pw2); \
    VRD(6); SBAR(); GAPA(C1=__builtin_amdgcn_mfma_f32_32x32x16_bf16(kf[5],qr[2],C1,0,0,0),   P1[6],P1[7],P1[8],P1[9],     pw2[2]=PKW(P1,4), pw2[3]=PKW(P1,6), pw2); \
    VRD(3); SBAR(); GAPA(C0=__builtin_amdgcn_mfma_f32_32x32x16_bf16(kf[6],qr[3],C0,0,0,0),   P1[10],P1[11],P1[12],P1[13], pw3[0]=PKW(P1,8), pw3[1]=PKW(P1,10), pw3); \
    VRD(7); SBAR(); GAPA(C1=__builtin_amdgcn_mfma_f32_32x32x16_bf16(kf[7],qr[3],C1,0,0,0),   P1[14],P1[15],0.f,0.f,       pw3[2]=PKW(P1,12),pw3[3]=PKW(P1,14), pw3); \
    l_reg+=sacc; \
    if(GK){DMA_K((t)+3,sl_cur);} if(GV){DMA_V((t)+1,sl_next);} \
    CMASK(C0,C1,t); \
    { float a=MX3(C0[0],C0[1],C1[0]),b=MX3(C0[2],C0[3],C1[1]); a=MX3(a,C1[2],C1[3]); \
      _Pragma("unroll") for(int r=4;r<16;r+=4){a=MX3(a,C0[r],C0[r+1]);b=MX3(b,C0[r+2],C0[r+3]);a=MX3(a,C1[r],C1[r+1]);b=MX3(b,C1[r+2],C1[r+3]);} \
      float rm=__builtin_fmaxf(a,b); { auto rr=__builtin_amdgcn_permlane32_swap(__float_as_uint(rm),__float_as_uint(rm),false,false); rm=__builtin_fmaxf(__uint_as_float(rr[0]),__uint_as_float(rr[1])); } \
      resc=false; \
      if(__builtin_expect(__any(rm>(float)THRL),0)){ const float dl=__builtin_fmaxf(rm,0.f); mhat+=dl; \
        _Pragma("unroll") for(int r=0;r<16;++r){C0[r]-=dl;C1[r]-=dl;} \
        _Pragma("unroll") for(int r=0;r<16;++r)negm[r]=-mhat; asm volatile("":"+v"(negm)); \
        const float f=__builtin_amdgcn_exp2f(-dl); l_reg*=f; if(hi==0)wsf[r32]=f; resc=true; } } \
    SBAR(); \
    GAPB(o[0]=__builtin_amdgcn_mfma_f32_32x32x16_bf16(PAF(0),VFR(0),o[0],0,0,0), C0,0); \
    GAPB(o[1]=__builtin_amdgcn_mfma_f32_32x32x16_bf16(PAF(0),VFR(4),o[1],0,0,0), C0,4); \
    KRD(GL,0); GAPB(o[0]=__builtin_amdgcn_mfma_f32_32x32x16_bf16(PAF(1),VFR(1),o[0],0,0,0), C0,8); \
    KRD(GL,1); GAPB(o[1]=__builtin_amdgcn_mfma_f32_32x32x16_bf16(PAF(1),VFR(5),o[1],0,0,0), C0,12); \
    KRD(GL,2); GAPB(o[0]=__builtin_amdgcn_mfma_f32_32x32x16_bf16(PAF(2),VFR(2),o[0],0,0,0), C1,0); \
    KRD(GL,3); GAPB(o[1]=__builtin_amdgcn_mfma_f32_32x32x16_bf16(PAF(2),VFR(6),o[1],0,0,0), C1,4); \
    GAPB(o[0]=__builtin_amdgcn_mfma_f32_32x32x16_bf16(PAF(3),VFR(3),o[0],0,0,0), C1,8); \
    GAPB(o[1]=__builtin_amdgcn_mfma_f32_32x32x16_bf16(PAF(3),VFR(7),o[1],0,0,0), C1,12); \
    }while(0)
  int t=1;
  for(;t+5<NT;t+=2){
    STEP(pB0,pB1,pA0,pA1,t,true,true,true);     WAIT_BAR(2); RESC(); ROT();
    STEP(pA0,pA1,pB0,pB1,t+1,true,true,true);   WAIT_BAR(2); RESC(); ROT();
  }
  #undef CMASK
  #define CMASK(P0,P1,t) do{ if(BANDED&&(t)>=4) bandmask(P0,P1,kpos0+64*((t)-4),qpos0+qrel,hi); }while(0)
  #define ENDW(tt) do{ if((tt)+3<NT){WAIT_BAR(2);} else if((tt)+2<NT){WAIT_BAR(1);} else {WAIT_BAR(0);} }while(0)
  for(;t+1<NT;t+=2){
    STEP(pB0,pB1,pA0,pA1,t,(t+3<NT),(t+1<NT),(t+1<NT));       ENDW(t);   RESC(); ROT();
    STEP(pA0,pA1,pB0,pB1,t+1,(t+4<NT),(t+2<NT),(t+2<NT));     ENDW(t+1); RESC(); ROT();
  }
  STEP(pB0,pB1,pA0,pA1,NT-1,false,false,false); RESC();
  { float sacc=pB0[0]+pB0[1]; _Pragma("unroll") for(int r=2;r<16;++r)sacc+=pB0[r]; _Pragma("unroll") for(int r=0;r<16;++r)sacc+=pB1[r]; l_reg+=sacc;
    pw0=(u32x4){PKW(pB0,0),PKW(pB0,2),PKW(pB0,4),PKW(pB0,6)};pw1=(u32x4){PKW(pB0,8),PKW(pB0,10),PKW(pB0,12),PKW(pB0,14)};pw2=(u32x4){PKW(pB1,0),PKW(pB1,2),PKW(pB1,4),PKW(pB1,6)};pw3=(u32x4){PKW(pB1,8),PKW(pB1,10),PKW(pB1,12),PKW(pB1,14)};
    SBAR(); pv(o,vb0+sl_cur,PAF(0),PAF(1),PAF(2),PAF(3)); }
  #undef PKW
  #undef PAF
  #undef VFR
  #undef PIN
  #undef MX3
  #undef GAPA
  #undef GAPB
  #undef EX
  #undef VRD
  #undef KRD
  #undef STEP
  #undef ENDW
  {auto rr=__builtin_amdgcn_permlane32_swap(__float_as_uint(l_reg),__float_as_uint(l_reg),false,false);l_reg=__uint_as_float(rr[0])+__uint_as_float(rr[1]);}
  if(BANDED) l_reg+=__builtin_amdgcn_exp2f(sink_l2-mhat);
  if(hi==0)wsf[32+r32]=l_reg;asm volatile("s_waitcnt lgkmcnt(0)":::"memory");
  float rli[16];
  #pragma unroll
  for(int r=0;r<16;++r)rli[r]=__builtin_amdgcn_rcpf(wsf[32+crow(r,hi)]);
  bf16*Ow=Orows+(long)(wid*QBLK)*OP;
  { bf16*stg=(bf16*)(shm+LDS_OST)+wid*2048;
    #pragma unroll
    for(int r=0;r<16;++r){const int orow=crow(r,hi);
      #pragma unroll
      for(int d0=0;d0<2;++d0)stg[orow*64+d0*32+r32]=__float2bfloat16(o[d0][r]*rli[r]);}
    asm volatile("s_waitcnt lgkmcnt(0)":::"memory");
    #pragma unroll
    for(int i=0;i<4;++i){const int row=i*8+(lane>>3),ch=lane&7; const u32x4 v=*(const u32x4*)(stg+row*64+ch*8); ATTN_STORE16(Ow+(long)row*OP+ch*8,v);} }
  asm volatile("s_waitcnt lgkmcnt(0)\n\ts_barrier":::"memory");
  #undef DMA_K
  #undef DMA_V
  #undef CMASK
  #undef START
  #undef RESC
  #undef ROT
}
constexpr int ATTN_LDS_BYTES=LDS_BYTES;
#undef SBAR
#undef WAIT_BAR
}

#define LAS __attribute__((address_space(3)))
typedef unsigned short bf16;
typedef unsigned v4u __attribute__((ext_vector_type(4)));
typedef float f32x4 __attribute__((ext_vector_type(4)));
typedef float f32x2v __attribute__((ext_vector_type(2)));

constexpr int DM = 1024, NBATCH = 4, SEQ = 8192, CTXL = 256;
constexpr int ML = NBATCH * SEQ, MC = NBATCH * CTXL, MT = ML + MC;
constexpr int ZW = 2560, FF = 2816, FF2 = 5632, CW = 512, NFFT = 16384;
constexpr int NTHR = 512;
constexpr size_t MiB = 1u << 20;
constexpr size_t WS_MOD = 0;
constexpr size_t WS_TW = 256 * 1024;
constexpr size_t WS_ROPE = 320 * 1024;
constexpr size_t WS_FSUMC = 384 * 1024;
constexpr size_t WS_BAR = 448 * 1024;
constexpr size_t WS_FSUM = 1 * MiB;
constexpr size_t WS_KC = 2 * MiB;
constexpr size_t WS_UC = 3 * MiB;
constexpr size_t WS_WB = 5 * MiB;
constexpr size_t WB_IN = 0, WB_OUT = 5 * MiB, WB_UP = 7 * MiB, WB_DOWN = 18 * MiB, WB_LAYER = 23 * MiB + 512 * 1024;
constexpr size_t WS_XC = 52 * MiB;
constexpr size_t WS_XN = 56 * MiB;
constexpr size_t WS_Z = 122 * MiB;
constexpr size_t WS_OC = 287 * MiB;
constexpr size_t WS_PART = 340 * MiB;
constexpr size_t WS_UT = 353 * MiB;
constexpr size_t WS_XR = 353 * MiB;
constexpr size_t WS_KF = 417 * MiB;
constexpr size_t WS_AV = 122 * MiB;
constexpr size_t WS_G = 122 * MiB;
constexpr size_t WS_EA = 304 * MiB;
constexpr size_t WS_EV = 327 * MiB;
constexpr size_t WS_END = 481 * MiB;
constexpr int LDS_BYTES = 147456;

__device__ __forceinline__ unsigned f2bf(float f) { unsigned u = __builtin_bit_cast(unsigned, f); return (u + 0x7fffu + ((u >> 16) & 1u)) >> 16; }
__device__ __forceinline__ unsigned pk2(float lo, float hi) { return f2bf(lo) | (f2bf(hi) << 16); }
__device__ __forceinline__ float bflo(unsigned w) { return __builtin_bit_cast(float, w << 16); }
__device__ __forceinline__ float bfhi(unsigned w) { return __builtin_bit_cast(float, w & 0xffff0000u); }
__device__ __forceinline__ void unpack8(const v4u w, float* f) { f[0] = bflo(w.x); f[1] = bfhi(w.x); f[2] = bflo(w.y); f[3] = bfhi(w.y); f[4] = bflo(w.z); f[5] = bfhi(w.z); f[6] = bflo(w.w); f[7] = bfhi(w.w); }
__device__ __forceinline__ v4u pack8(const float* f) { v4u o; o.x = pk2(f[0], f[1]); o.y = pk2(f[2], f[3]); o.z = pk2(f[4], f[5]); o.w = pk2(f[6], f[7]); return o; }
__device__ __forceinline__ float wave_sum(float v) {
#pragma unroll
    for (int o = 1; o < 64; o <<= 1) v += __shfl_xor(v, o);
    return v;
}

struct EpiStoreBf16 {
    static constexpr bool PERM = true, AFTER_DRAIN = false;
    bf16* O; int ldc; const float* qn; const float* kn; const f32x2v* rope; int pm0, pn0;
    __device__ __forceinline__ void operator()(const pg8::f32x4 (&acc)[2][2][4][2], const pg8::Unit& u, int wr, int wc, int fr, int fq) const {
        const int row0 = u.pm * 256 + wr * 64 + fr, gpn = u.pn + pn0;
        if (qn && gpn < 3) {
            constexpr float C2 = 0.125f * 1.4426950408889634f;
            const bool isq = gpn < 2, lat = (u.pm + pm0) < 128, second = fq >= 2; const float* gn = isq ? qn : kn;
            f32x4 g4[2][2];
#pragma unroll
            for (int bj = 0; bj < 2; ++bj)
#pragma unroll
                for (int n = 0; n < 2; ++n) g4[bj][n] = *(const f32x4*)(gn + 32 * bj + 8 * fq + 4 * n);
#pragma unroll
            for (int ai = 0; ai < 2; ++ai)
#pragma unroll
                for (int m = 0; m < 4; ++m) { const int lrow = row0 + ai * 128 + m * 16, t = ((u.pm + pm0) * 256 + wr * 64 + fr + ai * 128 + m * 16) & (SEQ - 1);
                    float sq = 0.f;
#pragma unroll
                    for (int bj = 0; bj < 2; ++bj)
#pragma unroll
                        for (int n = 0; n < 2; ++n) { const pg8::f32x4 v = acc[ai][bj][m][n]; sq += (v[0] * v[0] + v[1] * v[1]) + (v[2] * v[2] + v[3] * v[3]); }
                    sq += __shfl_xor(sq, 16); sq += __shfl_xor(sq, 32);
                    const float rinv = 1.0f / sqrtf(sq * (1.f / 64.f) + 1e-6f);
#pragma unroll
                    for (int bj = 0; bj < 2; ++bj) { float y[8];
#pragma unroll
                        for (int n = 0; n < 2; ++n)
#pragma unroll
                            for (int jx = 0; jx < 4; ++jx) y[4 * n + jx] = acc[ai][bj][m][n][jx] * rinv * g4[bj][n][jx];
                        float other[8];
#pragma unroll
                        for (int i = 0; i < 8; ++i) other[i] = __shfl_xor(y[i], 32);
                        if (lat) { const int pos = bj ? (t & 63) : (t >> 6); const f32x4* rp = (const f32x4*)(rope + pos * 16 + 8 * (fq & 1));
#pragma unroll
                            for (int h2 = 0; h2 < 4; ++h2) { const f32x4 cs = rp[h2];
                                y[2 * h2] = second ? (other[2 * h2] * cs.y + y[2 * h2] * cs.x) : (y[2 * h2] * cs.x - other[2 * h2] * cs.y);
                                y[2 * h2 + 1] = second ? (other[2 * h2 + 1] * cs.w + y[2 * h2 + 1] * cs.z) : (y[2 * h2 + 1] * cs.z - other[2 * h2 + 1] * cs.w); } }
                        if (isq) {
#pragma unroll
                            for (int i = 0; i < 8; ++i) y[i] *= C2; }
                        v4u w; w.x = pg8::cvt_pk_bf16(y[0], y[1]); w.y = pg8::cvt_pk_bf16(y[2], y[3]); w.z = pg8::cvt_pk_bf16(y[4], y[5]); w.w = pg8::cvt_pk_bf16(y[6], y[7]);
                        *(v4u*)(O + (size_t)lrow * ldc + u.pn * 256 + 64 * wc + 32 * bj + 8 * fq) = w; } }
            return;
        }
        const int col0 = u.pn * 256 + wc * 32 + 8 * fq;
#pragma unroll
        for (int ai = 0; ai < 2; ++ai)
#pragma unroll
            for (int m = 0; m < 4; ++m) { bf16* rowp = O + (size_t)(row0 + ai * 128 + m * 16) * ldc + col0;
#pragma unroll
                for (int bj = 0; bj < 2; ++bj) { const pg8::f32x4 v0 = acc[ai][bj][m][0], v1 = acc[ai][bj][m][1]; v4u w;
                    w.x = pg8::cvt_pk_bf16(v0[0], v0[1]); w.y = pg8::cvt_pk_bf16(v0[2], v0[3]); w.z = pg8::cvt_pk_bf16(v1[0], v1[1]); w.w = pg8::cvt_pk_bf16(v1[2], v1[3]);
                    *(v4u*)(rowp + bj * 128) = w; } }
    }
};
struct EpiRes {
    static constexpr bool PERM = true, AFTER_DRAIN = false;
    const float* srcL; const float* srcC; bf16* XR; float* outF; const float* gate; int src_bf, dst_bf, pm0;
    __device__ __forceinline__ void operator()(const pg8::f32x4 (&acc)[2][2][4][2], const pg8::Unit& u, int wr, int wc, int fr, int fq) const {
        const int pm = u.pm + pm0; const float* g = gate + (pm < 128 ? (pm >> 5) : 4) * 6144;
        const int grow0 = pm * 256 + wr * 64 + fr, col0 = u.pn * 256 + wc * 32 + 8 * fq;
        f32x4 gv[2][2];
#pragma unroll
        for (int bj = 0; bj < 2; ++bj)
#pragma unroll
            for (int n = 0; n < 2; ++n) gv[bj][n] = *(const f32x4*)(g + col0 + bj * 128 + 4 * n);
#pragma unroll
        for (int ai = 0; ai < 2; ++ai)
#pragma unroll
            for (int mh = 0; mh < 2; ++mh) {
                v4u raw[2][2]; f32x4 xf[2][2][2];
#pragma unroll
                for (int mm = 0; mm < 2; ++mm)
#pragma unroll
                    for (int bj = 0; bj < 2; ++bj) { const size_t p = (size_t)(grow0 + ai * 128 + (2 * mh + mm) * 16) * DM + col0 + bj * 128;
                        if (src_bf) raw[mm][bj] = *(const v4u*)(XR + p);
                        else { const float* sp = pm < 128 ? srcL + p : srcC + (p - (size_t)ML * DM); xf[mm][bj][0] = *(const f32x4*)sp; xf[mm][bj][1] = *(const f32x4*)(sp + 4); } }
#pragma unroll
                for (int mm = 0; mm < 2; ++mm)
#pragma unroll
                    for (int bj = 0; bj < 2; ++bj) { const int m = 2 * mh + mm; const size_t p = (size_t)(grow0 + ai * 128 + m * 16) * DM + col0 + bj * 128;
                        f32x4 v0, v1;
                        if (src_bf) { float x[8]; unpack8(raw[mm][bj], x); v0 = (f32x4){x[0], x[1], x[2], x[3]}; v1 = (f32x4){x[4], x[5], x[6], x[7]}; } else { v0 = xf[mm][bj][0]; v1 = xf[mm][bj][1]; }
                        v0 = v0 + gv[bj][0] * acc[ai][bj][m][0]; v1 = v1 + gv[bj][1] * acc[ai][bj][m][1];
                        if (dst_bf) { v4u w; w.x = pg8::cvt_pk_bf16(v0[0], v0[1]); w.y = pg8::cvt_pk_bf16(v0[2], v0[3]); w.z = pg8::cvt_pk_bf16(v1[0], v1[1]); w.w = pg8::cvt_pk_bf16(v1[2], v1[3]); *(v4u*)(XR + p) = w; }
                        else { float* dp = outF + p; *(f32x4*)dp = v0; *(f32x4*)(dp + 4) = v1; } }
            }
    }
};
struct EpiPartial {
    static constexpr bool PERM = true, AFTER_DRAIN = false;
    float* P;
    __device__ __forceinline__ void operator()(const pg8::f32x4 (&acc)[2][2][4][2], const pg8::Unit& u, int wr, int wc, int fr, int fq) const {
        const int row0 = u.pm * 256 + wr * 64 + fr, col0 = u.pn * 256 + wc * 32 + 8 * fq;
#pragma unroll
        for (int ai = 0; ai < 2; ++ai)
#pragma unroll
            for (int m = 0; m < 4; ++m) { float* rp = P + (size_t)(row0 + ai * 128 + m * 16) * DM + col0;
#pragma unroll
                for (int bj = 0; bj < 2; ++bj) { *(f32x4*)(rp + bj * 128) = acc[ai][bj][m][0]; *(f32x4*)(rp + bj * 128 + 4) = acc[ai][bj][m][1]; } }
    }
};
__device__ __forceinline__ float gelu_fast(float x) { const float u = x + 0.044715f * x * x * x; return x * __builtin_amdgcn_rcpf(1.f + __builtin_amdgcn_exp2f(-2.302208198f * u)); }
__device__ __forceinline__ float dpp_ror1(float v) { return __builtin_bit_cast(float, __builtin_amdgcn_update_dpp(0, __builtin_bit_cast(int, v), 0x121, 0xf, 0xf, false)); }
__device__ __forceinline__ float dpp_rol1(float v) { return __builtin_bit_cast(float, __builtin_amdgcn_update_dpp(0, __builtin_bit_cast(int, v), 0x12F, 0xf, 0xf, false)); }
struct EpiGate {
    static constexpr bool PERM = true, AFTER_DRAIN = false;
    bf16* G; float* EA; float* EV; const float* cw; const float* cb; int pm0;
    __device__ __forceinline__ void operator()(const pg8::f32x4 (&acc)[2][2][4][2], const pg8::Unit& u, int wr, int wc, int fr, int fq) const {
        const int jcol = u.pn * 128 + wc * 32 + 8 * fq;
        f32x4 w0[2], w1[2], w2[2], bb[2];
#pragma unroll
        for (int n = 0; n < 2; ++n) { w0[n] = *(const f32x4*)(cw + jcol + 4 * n); w1[n] = *(const f32x4*)(cw + FF + jcol + 4 * n); w2[n] = *(const f32x4*)(cw + 2 * FF + jcol + 4 * n); bb[n] = *(const f32x4*)(cb + jcol + 4 * n); }
        typedef float f32x2 __attribute__((ext_vector_type(2)));
        const bool l15 = fr == 15, l0 = fr == 0;
#pragma unroll
        for (int ai = 0; ai < 2; ++ai) {
            const int row_b = (u.pm + pm0) * 256 + ai * 128 + wr * 64, blk = row_b >> 6;
#pragma unroll
            for (int m = 0; m < 4; ++m) {
                float o[8];
#pragma unroll
                for (int n = 0; n < 2; ++n)
#pragma unroll
                    for (int jp = 0; jp < 2; ++jp) {
                        const f32x2 cur = (f32x2){acc[ai][0][m][n][2 * jp], acc[ai][0][m][n][2 * jp + 1]};
                        f32x2 su = cur, sd = cur;
                        if (m > 0) { su.x = l15 ? acc[ai][0][m - 1][n][2 * jp] : cur.x; su.y = l15 ? acc[ai][0][m - 1][n][2 * jp + 1] : cur.y; }
                        if (m < 3) { sd.x = l0 ? acc[ai][0][m + 1][n][2 * jp] : cur.x; sd.y = l0 ? acc[ai][0][m + 1][n][2 * jp + 1] : cur.y; }
                        const f32x2 up = (f32x2){dpp_ror1(su.x), dpp_ror1(su.y)}, dn = (f32x2){dpp_rol1(sd.x), dpp_rol1(sd.y)};
                        const f32x2 c0 = (f32x2){w0[n][2 * jp], w0[n][2 * jp + 1]}, c1 = (f32x2){w1[n][2 * jp], w1[n][2 * jp + 1]}, c2 = (f32x2){w2[n][2 * jp], w2[n][2 * jp + 1]}, cbv = (f32x2){bb[n][2 * jp], bb[n][2 * jp + 1]};
                        const f32x2 a2 = c0 * up + (c1 * cur + (c2 * dn + cbv));
                        const f32x2 u2 = a2 * (a2 * a2 * 0.044715f + 1.0f) * (-2.302208198f);
                        const f32x2 den = (f32x2){1.f + __builtin_amdgcn_exp2f(u2.x), 1.f + __builtin_amdgcn_exp2f(u2.y)};
                        const f32x2 vv = (f32x2){acc[ai][1][m][n][2 * jp], acc[ai][1][m][n][2 * jp + 1]};
                        const f32x2 g2 = a2 * vv * (f32x2){__builtin_amdgcn_rcpf(den.x), __builtin_amdgcn_rcpf(den.y)};
                        o[4 * n + 2 * jp] = g2.x; o[4 * n + 2 * jp + 1] = g2.y;
                    }
                const int rb = 16 * m + fr;
                if (rb >= 1 && rb <= 62) { v4u w; w.x = pg8::cvt_pk_bf16(o[0], o[1]); w.y = pg8::cvt_pk_bf16(o[2], o[3]); w.z = pg8::cvt_pk_bf16(o[4], o[5]); w.w = pg8::cvt_pk_bf16(o[6], o[7]); *(v4u*)(G + (size_t)(row_b + rb) * FF + jcol) = w; }
                if ((m == 0 && fr < 2) || (m == 3 && fr > 13)) {
                    const int slot = m == 0 ? fr : fr - 12;
                    float* ea = EA + ((size_t)blk * 4 + slot) * FF + jcol;
                    *(f32x4*)ea = acc[ai][0][m][0]; *(f32x4*)(ea + 4) = acc[ai][0][m][1];
                    if (slot == 0 || slot == 3) { float* ev = EV + ((size_t)blk * 2 + (slot == 3 ? 1 : 0)) * FF + jcol; *(f32x4*)ev = acc[ai][1][m][0]; *(f32x4*)(ev + 4) = acc[ai][1][m][1]; }
                }
            }
        }
    }
};
__device__ __forceinline__ void ffn_fixup(bf16* G, const float* EA, const float* EV, const float* cw, const float* cb, int kb_lo, int kb_hi, int gtid, int gthreads) {
    const int idx_hi = kb_hi * 2 * (FF / 4);
    for (int idxa = kb_lo * 2 * (FF / 4) + gtid; idxa < idx_hi; idxa += 2 * gthreads) {
        f32x4 up[2], cur[2], dn[2], v[2]; int rowq[2], jq[2];
#pragma unroll
        for (int q = 0; q < 2; ++q) { const int idx = idxa + q * gthreads < idx_hi ? idxa + q * gthreads : idxa;
            const int j = (idx % (FF / 4)) * 4, rs = idx / (FF / 4), sel = rs & 1, kb = rs >> 1;
            const int row = kb * 64 + (sel ? 63 : 0); const bool lat = row < ML; const int tpos = lat ? (row & (SEQ - 1)) : ((row - ML) & (CTXL - 1)); const int slen = lat ? SEQ : CTXL;
            const f32x4 zero = (f32x4){0.f, 0.f, 0.f, 0.f}; rowq[q] = row; jq[q] = j;
            if (!sel) { up[q] = tpos > 0 ? *(const f32x4*)(EA + ((size_t)(kb - 1) * 4 + 3) * FF + j) : zero; cur[q] = *(const f32x4*)(EA + ((size_t)kb * 4 + 0) * FF + j); dn[q] = *(const f32x4*)(EA + ((size_t)kb * 4 + 1) * FF + j); v[q] = *(const f32x4*)(EV + ((size_t)kb * 2 + 0) * FF + j); }
            else { up[q] = *(const f32x4*)(EA + ((size_t)kb * 4 + 2) * FF + j); cur[q] = *(const f32x4*)(EA + ((size_t)kb * 4 + 3) * FF + j); dn[q] = tpos < slen - 1 ? *(const f32x4*)(EA + ((size_t)(kb + 1) * 4 + 0) * FF + j) : zero; v[q] = *(const f32x4*)(EV + ((size_t)kb * 2 + 1) * FF + j); } }
#pragma unroll
        for (int q = 0; q < 2; ++q) { if (idxa + q * gthreads >= idx_hi) continue; const int j = jq[q];
            const f32x4 w0 = *(const f32x4*)(cw + j), w1 = *(const f32x4*)(cw + FF + j), w2 = *(const f32x4*)(cw + 2 * FF + j), bb = *(const f32x4*)(cb + j);
            float o[4];
#pragma unroll
            for (int i = 0; i < 4; ++i) o[i] = gelu_fast(w0[i] * up[q][i] + w1[i] * cur[q][i] + w2[i] * dn[q][i] + bb[i]) * v[q][i];
            const unsigned long long pk = (unsigned long long)pk2(o[0], o[1]) | ((unsigned long long)pk2(o[2], o[3]) << 32);
            *(unsigned long long*)(G + (size_t)rowq[q] * FF + j) = pk; }
    }
}

__device__ __forceinline__ void transpose_item(const float* W, int K, int N, bf16* WT, int kb, int nb, int rbase, LAS float* scr, int lane) {
    const int k0 = 64 * kb, n0 = 32 * nb;
    float tv[32];
#pragma unroll
    for (int i = 0; i < 32; ++i) tv[i] = W[(size_t)(k0 + 2 * i + (lane >> 5)) * N + n0 + (lane & 31)];
#pragma unroll
    for (int i = 0; i < 32; ++i) scr[(2 * i + (lane >> 5)) * 33 + (lane & 31)] = tv[i];
    asm volatile("s_waitcnt lgkmcnt(0)" ::: "memory");
    const int c = lane & 7;
#pragma unroll
    for (int j = 0; j < 4; ++j) { const int n = (lane >> 3) + 8 * j; const LAS float* s = scr + (8 * c) * 33 + n;
        v4u o; o.x = pk2(s[0 * 33], s[1 * 33]); o.y = pk2(s[2 * 33], s[3 * 33]); o.z = pk2(s[4 * 33], s[5 * 33]); o.w = pk2(s[6 * 33], s[7 * 33]);
        *(v4u*)(WT + (size_t)(rbase + n) * K + k0 + 8 * c) = o; }
    asm volatile("s_waitcnt lgkmcnt(0)" ::: "memory");
}
constexpr int TI_IN = 16 * 80, TI_OUT = 16 * 32, TI_UP = 16 * 176, TI_DOWN = 44 * 32, TI_LAYER = TI_IN + TI_OUT + TI_UP + TI_DOWN;
__device__ __forceinline__ void p0_weights(const float* w_in, const float* w_out, const float* w_up, const float* w_down, unsigned char* wb, LAS float* scr, int it0, int it1, int gw, int ngw, int lane) {
    for (int it = it0 + gw; it < it1; it += ngw) {
        const int l = it / TI_LAYER; int r = it % TI_LAYER; unsigned char* base = wb + (size_t)l * WB_LAYER;
        if (r < TI_IN) { const int nb = r % 80, n0 = 32 * nb; int rb = n0;
            if (n0 < 768) { const int o = n0 & 255; rb = (n0 & ~255) + 128 * ((o & 63) >> 5) + 32 * (o >> 6); }
            transpose_item(w_in + (size_t)l * DM * ZW, DM, ZW, (bf16*)(base + WB_IN), r / 80, nb, rb, scr, lane); continue; } r -= TI_IN;
        if (r < TI_OUT) { transpose_item(w_out + (size_t)l * DM * DM, DM, DM, (bf16*)(base + WB_OUT), r / 32, r % 32, 32 * (r % 32), scr, lane); continue; } r -= TI_OUT;
        if (r < TI_UP) { const int nb = r % 176, n0 = 32 * nb; const int m = n0 < FF ? n0 : n0 - FF; const int rb = (m / 128) * 256 + (n0 < FF ? 0 : 128) + (m % 128);
            transpose_item(w_up + (size_t)l * DM * FF2, DM, FF2, (bf16*)(base + WB_UP), r / 176, nb, rb, scr, lane); continue; } r -= TI_UP;
        transpose_item(w_down + (size_t)l * FF * DM, FF, DM, (bf16*)(base + WB_DOWN), r / 32, r % 32, 32 * (r % 32), scr, lane);
    }
}
__device__ __forceinline__ void p0_mod_item(const float* c, const float* c_ctx, const float* ada_w, const float* ada_b, float* mod, LAS float* L, int item, int tid) {
    const int l = item / 96, n0 = (item % 96) * 64, wave = tid >> 6, lane = tid & 63;
    LAS float* sl = L; LAS float* red = L + 5 * 1024;
    const float* w = ada_w + (size_t)l * DM * 6144 + n0 + lane + (size_t)(wave * 128) * 6144;
    float wv[32];
#pragma unroll
    for (int i = 0; i < 32; ++i) wv[i] = w[(size_t)i * 6144];
    for (int i = tid; i < 5 * 1024; i += NTHR) { const int r = i >> 10, k = i & 1023; const float v = r < 4 ? c[r * 1024 + k] : c_ctx[k]; sl[i] = v / (1.f + __expf(-v)); }
    __syncthreads();
    float acc[5] = {0.f, 0.f, 0.f, 0.f, 0.f};
#pragma unroll 1
    for (int kb = 0; kb < 128; kb += 32) {
        float wn[32];
        if (kb + 32 < 128) {
#pragma unroll
            for (int i = 0; i < 32; ++i) wn[i] = w[(size_t)(kb + 32 + i) * 6144]; }
#pragma unroll
        for (int i = 0; i < 32; ++i) { const int k = wave * 128 + kb + i;
#pragma unroll
            for (int r = 0; r < 5; ++r) acc[r] += sl[r * 1024 + k] * wv[i]; }
#pragma unroll
        for (int i = 0; i < 32; ++i) wv[i] = wn[i];
    }
#pragma unroll
    for (int r = 0; r < 5; ++r) red[(wave * 5 + r) * 64 + lane] = acc[r];
    __syncthreads();
    if (tid < 320) { const int r = tid >> 6; float s = 0.f;
#pragma unroll
        for (int w8 = 0; w8 < 8; ++w8) s += red[(w8 * 5 + r) * 64 + lane];
        mod[(size_t)(l * 5 + r) * 6144 + n0 + lane] = s + ada_b[l * 6144 + n0 + lane]; }
    __syncthreads();
}
template <bool CTXF, int HALF = -1>
__device__ __forceinline__ void p0_filter_item(const float* w1, const float* b1, const float* w2, const float* b2, const float* w3, const float* b3, const float* w4, const float* freq,
                                               float* KT, float* FS, LAS float* L, int chunk, int tid) {
    constexpr int n = CTXF ? 256 : 8192; const int t0 = chunk * 32;
    LAS float* feats = L; LAS float* h1 = L + 32 * 36; LAS float* h2 = h1 + 2048; LAS float* h3 = h2 + 2048;
    LAS float* W1 = L + 7296; LAS float* W2 = W1 + 2112; LAS float* W3 = W2 + 4096; LAS float* T = L + 17664;
    float bq1[4], bq2[4], bq3[4], fq4[4];
#pragma unroll
    for (int i = 0; i < 4; ++i) { const int jx = 4 * (tid & 15) + i; bq1[i] = b1[jx]; bq2[i] = b2[jx]; bq3[i] = b3[jx]; fq4[i] = freq[jx]; }
    for (int i = tid; i < 528; i += NTHR) *(LAS f32x4*)(W1 + 4 * i) = *(const f32x4*)(w1 + 4 * i);
    for (int i = tid; i < 1024; i += NTHR) { *(LAS f32x4*)(W2 + 4 * i) = *(const f32x4*)(w2 + 4 * i); *(LAS f32x4*)(W3 + 4 * i) = *(const f32x4*)(w3 + 4 * i); }
    for (int i = tid; i < 32 * 33; i += NTHR) { const int tap = i / 33, e = i % 33, t = t0 + tap; float val;
        if (e == 0) val = (float)t / (float)(n - 1);
        else { const int j = (e - 1) & 15; const float f = 1e-4f + (float)j * ((15.0f - 1e-4f) / 15.0f); float sn, cs; sincospif(f * (2.0f * (float)t / (float)n), &sn, &cs); val = e <= 16 ? cs : -sn; }
        feats[tap * 36 + e] = val; }
    __syncthreads();
    const int tap4 = tid >> 4, jb = tid & 15;
    { float s4[4];
#pragma unroll
      for (int i = 0; i < 4; ++i) s4[i] = bq1[i];
#pragma unroll 3
      for (int e = 0; e < 33; ++e) { const float fv = feats[tap4 * 36 + e]; const f32x4 wq = *(const LAS f32x4*)(W1 + e * 64 + 4 * jb);
#pragma unroll
          for (int i = 0; i < 4; ++i) s4[i] += fv * wq[i]; }
      *(LAS f32x4*)(h1 + tap4 * 64 + 4 * jb) = (f32x4){__sinf(fq4[0] * s4[0]), __sinf(fq4[1] * s4[1]), __sinf(fq4[2] * s4[2]), __sinf(fq4[3] * s4[3])}; }
    __syncthreads();
    { float s4[4];
#pragma unroll
      for (int i = 0; i < 4; ++i) s4[i] = bq2[i];
#pragma unroll 4
      for (int e = 0; e < 64; ++e) { const float fv = h1[tap4 * 64 + e]; const f32x4 wq = *(const LAS f32x4*)(W2 + e * 64 + 4 * jb);
#pragma unroll
          for (int i = 0; i < 4; ++i) s4[i] += fv * wq[i]; }
      *(LAS f32x4*)(h2 + tap4 * 64 + 4 * jb) = (f32x4){__sinf(fq4[0] * s4[0]), __sinf(fq4[1] * s4[1]), __sinf(fq4[2] * s4[2]), __sinf(fq4[3] * s4[3])}; }
    __syncthreads();
    { float s4[4];
#pragma unroll
      for (int i = 0; i < 4; ++i) s4[i] = bq3[i];
#pragma unroll 4
      for (int e = 0; e < 64; ++e) { const float fv = h2[tap4 * 64 + e]; const f32x4 wq = *(const LAS f32x4*)(W3 + e * 64 + 4 * jb);
#pragma unroll
          for (int i = 0; i < 4; ++i) s4[i] += fv * wq[i]; }
      *(LAS f32x4*)(h3 + tap4 * 64 + 4 * jb) = (f32x4){__sinf(fq4[0] * s4[0]), __sinf(fq4[1] * s4[1]), __sinf(fq4[2] * s4[2]), __sinf(fq4[3] * s4[3])}; }
    __syncthreads();
    typedef short fbf16x8 __attribute__((ext_vector_type(8)));
    typedef float ff32x16 __attribute__((ext_vector_type(16)));
    const int wave = tid >> 6, lane = tid & 63, r32 = lane & 31, hi = lane >> 5;
    constexpr int NB = HALF < 0 ? 4 : 2;
    const int col0 = HALF < 0 ? 128 * wave : (HALF == 0 ? 64 * wave : 512 + 64 * wave);
    fbf16x8 afr[4];
#pragma unroll
    for (int ks = 0; ks < 4; ++ks) { const LAS float* hp = h3 + r32 * 64 + 16 * ks + 8 * hi; const f32x4 a = *(const LAS f32x4*)hp, b = *(const LAS f32x4*)(hp + 4);
        v4u w; w.x = pk2(a.x, a.y); w.y = pk2(a.z, a.w); w.z = pk2(b.x, b.y); w.w = pk2(b.z, b.w); afr[ks] = __builtin_bit_cast(fbf16x8, w); }
    ff32x16 acc[NB];
    float wv[4][8], wn[4][8];
    { const float* wp = w4 + col0 + r32 + (size_t)(8 * hi) * 1024;
#pragma unroll
      for (int ks = 0; ks < 4; ++ks)
#pragma unroll
          for (int e = 0; e < 8; ++e) wv[ks][e] = wp[(size_t)(16 * ks + e) * 1024]; }
#pragma unroll
    for (int nb = 0; nb < NB; ++nb) {
        if (nb + 1 < NB) { const float* wp = w4 + col0 + 32 * (nb + 1) + r32 + (size_t)(8 * hi) * 1024;
#pragma unroll
            for (int ks = 0; ks < 4; ++ks)
#pragma unroll
                for (int e = 0; e < 8; ++e) wn[ks][e] = wp[(size_t)(16 * ks + e) * 1024]; }
#pragma unroll
        for (int r = 0; r < 16; ++r) acc[nb][r] = 0.f;
#pragma unroll
        for (int ks = 0; ks < 4; ++ks) { v4u w; w.x = pk2(wv[ks][0], wv[ks][1]); w.y = pk2(wv[ks][2], wv[ks][3]); w.z = pk2(wv[ks][4], wv[ks][5]); w.w = pk2(wv[ks][6], wv[ks][7]);
            acc[nb] = __builtin_amdgcn_mfma_f32_32x32x16_bf16(afr[ks], __builtin_bit_cast(fbf16x8, w), acc[nb], 0, 0, 0); }
#pragma unroll
        for (int ks = 0; ks < 4; ++ks)
#pragma unroll
            for (int e = 0; e < 8; ++e) wv[ks][e] = wn[ks][e];
    }
#pragma unroll
    for (int nb = 0; nb < NB; ++nb) { const int col = col0 + 32 * nb + r32, c = col & 511; const bool bwd = col >= 512;
        const float delta = 3.0701134573253944f + (float)c * (12.280453829301577f / 511.f); float sa = 0.f;
#pragma unroll
        for (int r = 0; r < 16; ++r) { const int t = t0 + (r & 3) + 8 * (r >> 2) + 4 * hi; const float t01 = (float)t * (1.0f / (float)(n - 1)); const float v = acc[nb][r] * (__expf(-t01 * delta) + 0.05f);
            acc[nb][r] = v; if (!bwd || t > 0) sa += fabsf(v); }
        sa += __shfl_xor(sa, 32); if (hi == 0) FS[chunk * 1024 + col] = sa; }
    const int cc = lane >> 5, tp = lane & 31, tt = t0 + tp;
    if constexpr (HALF != 1) {
    if (HALF == 0 || wave < 4) {
#pragma unroll
        for (int nb = 0; nb < NB; ++nb) { const int c = (col0 + 32 * nb + r32) & 511;
#pragma unroll
            for (int r = 0; r < 16; ++r) T[c * 33 + (r & 3) + 8 * (r >> 2) + 4 * hi] = acc[nb][r]; } }
    __syncthreads();
#pragma unroll 1
    for (int cp = 0; cp < 32; ++cp) { const int c = wave * 64 + 2 * cp + cc; const float v = T[c * 33 + tp];
        if (CTXF) KT[(size_t)(255 + tt) * 512 + c] = v; else KT[(size_t)c * NFFT + tt] = v; }
    __syncthreads(); }
    if constexpr (HALF != 0) {
    if (HALF == 1 || wave >= 4) {
#pragma unroll
        for (int nb = 0; nb < NB; ++nb) { const int c = (col0 + 32 * nb + r32) & 511;
#pragma unroll
            for (int r = 0; r < 16; ++r) T[c * 33 + (r & 3) + 8 * (r >> 2) + 4 * hi] = acc[nb][r]; } }
    __syncthreads();
#pragma unroll 1
    for (int cp = 0; cp < 32; ++cp) { const int c = wave * 64 + 2 * cp + cc; const float v = T[c * 33 + tp];
        if (tt > 0) { if (CTXF) KT[(size_t)(255 - tt) * 512 + c] = v; else KT[(size_t)c * NFFT + NFFT - tt] = v; } } }
    if (!CTXF && chunk == 0) KT[(size_t)tid * NFFT + 8192] = 0.f;
    __syncthreads();
}

constexpr int FFT_LDS_ELEMS = NFFT + NFFT / 32;
__device__ __forceinline__ int pidx(int i) { return i + (i >> 5); }
__device__ __forceinline__ f32x2v cmulv(const f32x2v a, const f32x2v b) { return (f32x2v){a.x * b.x - a.y * b.y, a.x * b.y + a.y * b.x}; }
template <int K32> __device__ __forceinline__ f32x2v e32() {
    constexpr float C[16] = {1.0f, 0.98078528040323043f, 0.92387953251128674f, 0.83146961230254524f, 0.70710678118654752f, 0.55557023301960218f, 0.38268343236508977f, 0.19509032201612825f,
                             0.0f, -0.19509032201612825f, -0.38268343236508977f, -0.55557023301960218f, -0.70710678118654752f, -0.83146961230254524f, -0.92387953251128674f, -0.98078528040323043f};
    constexpr float Sn[16] = {0.0f, 0.19509032201612825f, 0.38268343236508977f, 0.55557023301960218f, 0.70710678118654752f, 0.83146961230254524f, 0.92387953251128674f, 0.98078528040323043f,
                              1.0f, 0.98078528040323043f, 0.92387953251128674f, 0.83146961230254524f, 0.70710678118654752f, 0.55557023301960218f, 0.38268343236508977f, 0.19509032201612825f};
    return (f32x2v){C[K32], -Sn[K32]};
}
template <int S, int LOGR, bool INV, int Q, int M>
__device__ __forceinline__ void fft_bfly(f32x2v (&x)[1 << LOGR], const f32x2v (&bq)[LOGR]) {
    constexpr int R = 1 << LOGR, BS = NFFT >> S, STR = BS / R, bit = 1 << (LOGR - 1 - Q);
    if constexpr (M < R) {
        if constexpr (!(M & bit)) {
            constexpr int k32 = ((M & (bit - 1)) << Q) * (32 / R);
            f32x2v w;
            if constexpr (STR == 1) w = e32<k32>(); else if constexpr (k32 == 0) w = bq[Q]; else w = cmulv(bq[Q], e32<k32>());
            const f32x2v a = x[M], b = x[M + bit];
            if constexpr (!INV) { const f32x2v d = a - b; x[M] = a + b; x[M + bit] = cmulv(d, w); }
            else { const f32x2v t = (f32x2v){b.x * w.x + b.y * w.y, b.y * w.x - b.x * w.y}; x[M] = a + t; x[M + bit] = a - t; }
        }
        fft_bfly<S, LOGR, INV, Q, M + 1>(x, bq);
    }
}
template <int S, int LOGR, bool INV, int QQ, int QEND = LOGR>
__device__ __forceinline__ void fft_substages(f32x2v (&x)[1 << LOGR], const f32x2v (&bq)[LOGR]) {
    if constexpr (QQ < QEND) { constexpr int Q = INV ? LOGR - 1 - QQ : QQ; fft_bfly<S, LOGR, INV, Q, 0>(x, bq); fft_substages<S, LOGR, INV, QQ + 1, QEND>(x, bq); }
}
template <int M> __device__ __forceinline__ void fft_zhi_stage(f32x2v (&x)[16], const f32x2v b0) {
    if constexpr (M < 8) { x[M + 8] = cmulv(x[M], M == 0 ? b0 : cmulv(b0, e32<2 * M>())); fft_zhi_stage<M + 1>(x, b0); }
}
template <int M> __device__ __forceinline__ void fft_half_stage(f32x2v (&x)[16], const f32x2v b0) {
    if constexpr (M < 8) { const f32x2v w = M == 0 ? b0 : cmulv(b0, e32<2 * M>()), b = x[M + 8]; x[M] = x[M] + (f32x2v){b.x * w.x + b.y * w.y, b.y * w.x - b.x * w.y}; fft_half_stage<M + 1>(x, b0); }
}
template <bool INV>
__device__ __forceinline__ void fft_super0_half(LAS f32x2v* buf, const f32x2v* __restrict__ TW, int tid) {
#pragma unroll
    for (int g = tid; g < NFFT / 16; g += NTHR) {
        f32x2v x[16], bq[4];
#pragma unroll
        for (int m = 0; m < (INV ? 16 : 8); ++m) x[m] = buf[pidx(g + m * 1024)];
        bq[0] = TW[g];
#pragma unroll
        for (int q = 1; q < 4; ++q) bq[q] = cmulv(bq[q - 1], bq[q - 1]);
        if constexpr (!INV) { fft_zhi_stage<0>(x, bq[0]); fft_substages<0, 4, false, 1>(x, bq); }
        else { fft_substages<0, 4, true, 0, 3>(x, bq); fft_half_stage<0>(x, bq[0]); }
#pragma unroll
        for (int m = 0; m < (INV ? 8 : 16); ++m) buf[pidx(g + m * 1024)] = x[m];
    }
    __syncthreads();
}
template <int S, int LOGR, bool INV>
__device__ __forceinline__ void fft_super(LAS f32x2v* buf, const f32x2v* __restrict__ TW, int tid) {
    constexpr int R = 1 << LOGR, BS = NFFT >> S, STR = BS / R, NG = NFFT / R;
#pragma unroll
    for (int g = tid; g < NG; g += NTHR) {
        const int lo = g % STR, hi = g / STR, base = hi * BS + lo;
        f32x2v x[R], bq[LOGR];
#pragma unroll
        for (int m = 0; m < R; ++m) x[m] = buf[pidx(base + m * STR)];
        if constexpr (STR > 1) { bq[0] = TW[lo << S];
#pragma unroll
            for (int q = 1; q < LOGR; ++q) bq[q] = cmulv(bq[q - 1], bq[q - 1]); }
        else {
#pragma unroll
            for (int q = 0; q < LOGR; ++q) bq[q] = (f32x2v){1.f, 0.f}; }
        fft_substages<S, LOGR, INV, 0>(x, bq);
#pragma unroll
        for (int m = 0; m < R; ++m) buf[pidx(base + m * STR)] = x[m];
    }
    __syncthreads();
}
__device__ __forceinline__ void fft_fwd(LAS f32x2v* buf, const f32x2v* TW, int tid) { fft_super<0, 4, false>(buf, TW, tid); fft_super<4, 5, false>(buf, TW, tid); fft_super<9, 5, false>(buf, TW, tid); }
__device__ __forceinline__ void fft_mid_mul(LAS f32x2v* buf, const f32x4 (&kq)[16], int tid) {
    f32x2v x[32], bq[5];
#pragma unroll
    for (int m = 0; m < 32; ++m) x[m] = buf[pidx(32 * tid + m)];
#pragma unroll
    for (int q = 0; q < 5; ++q) bq[q] = (f32x2v){1.f, 0.f};
    fft_substages<9, 5, false, 0>(x, bq);
#pragma unroll
    for (int m = 0; m < 16; ++m) { x[2 * m] = cmulv(x[2 * m], (f32x2v){kq[m].x, kq[m].y}); x[2 * m + 1] = cmulv(x[2 * m + 1], (f32x2v){kq[m].z, kq[m].w}); }
    fft_substages<9, 5, true, 0>(x, bq);
#pragma unroll
    for (int m = 0; m < 32; ++m) buf[pidx(32 * tid + m)] = x[m];
    __syncthreads();
}
__device__ __forceinline__ void fft_inv(LAS f32x2v* buf, const f32x2v* TW, int tid) { fft_super<12, 2, true>(buf, TW, tid); fft_super<8, 4, true>(buf, TW, tid); fft_super<4, 4, true>(buf, TW, tid); fft_super<0, 4, true>(buf, TW, tid); }

__device__ __forceinline__ void filter_fft_item(const float* KT, const float* FS, const float* bias_d, f32x2v* KF, const f32x2v* TW, LAS f32x2v* buf, LAS float* misc, int cp, int tid) {
    const int c1 = 2 * cp, c2 = c1 + 1;
    const f32x4* s1 = (const f32x4*)(KT + (size_t)c1 * NFFT); const f32x4* s2 = (const f32x4*)(KT + (size_t)c2 * NFFT);
    for (int i = tid; i < NFFT / 4; i += NTHR) { const f32x4 v = s1[i], w = s2[i];
#pragma unroll
        for (int k = 0; k < 4; ++k) buf[pidx(4 * i + k)] = (f32x2v){v[k], w[k]}; }
    if (tid < 128) { const int c = c1 + (tid >> 6), ln = tid & 63; float s = 0.f;
#pragma unroll
        for (int k = 0; k < 4; ++k) { const int ch = ln * 4 + k; s += FS[ch * 1024 + c] + FS[ch * 1024 + 512 + c]; }
        s = wave_sum(s); if (ln == 0) misc[tid >> 6] = 0.5f / (s * (float)NFFT); }
    __syncthreads();
    fft_fwd(buf, TW, tid);
    const float sc1 = misc[0], sc2 = misc[1]; f32x2v* d1 = KF + (size_t)c1 * NFFT; f32x2v* d2 = KF + (size_t)c2 * NFFT;
    const float bd1 = bias_d[c1] * (1.f / (float)NFFT), bd2 = bias_d[c2] * (1.f / (float)NFFT);
    for (int i = tid; i < NFFT; i += NTHR) {
        const int f = (int)(__brev((unsigned)i) >> 18), j = (int)(__brev((unsigned)((NFFT - f) & (NFFT - 1))) >> 18);
        const f32x2v zf = buf[pidx(i)], zm = buf[pidx(j)];
        d1[i] = (f32x2v){(zf.x + zm.x) * sc1 + bd1, (zf.y - zm.y) * sc1};
        d2[i] = (f32x2v){(zf.y + zm.y) * sc2 + bd2, (zm.x - zf.x) * sc2};
    }
    __syncthreads();
}
__device__ __forceinline__ void conv_fft_items(float* UT, const f32x2v* KF, const f32x2v* TW, LAS f32x2v* buf, int first, int step, int n_items, int tid) {
    f32x4 ua[4], ub[4];
#define CV_ROWS(item_) f32x4* u0 = (f32x4*)(UT + ((size_t)(2 * ((item_) >> 9)) * CW + ((item_) & 511)) * SEQ); f32x4* u1 = u0 + (size_t)CW * SEQ / 4
    if (first < n_items) { CV_ROWS(first);
#pragma unroll
        for (int q = 0; q < 4; ++q) { ua[q] = u0[tid + NTHR * q]; ub[q] = u1[tid + NTHR * q]; } }
    for (int item = first; item < n_items; item += step) {
        CV_ROWS(item);
#pragma unroll
        for (int q = 0; q < 4; ++q) { const int i = tid + NTHR * q;
#pragma unroll
            for (int k = 0; k < 4; ++k) buf[pidx(4 * i + k)] = (f32x2v){ua[q][k], ub[q][k]}; }
        __syncthreads();
        fft_super0_half<false>(buf, TW, tid);
        fft_super<4, 5, false>(buf, TW, tid);
        { f32x4 kq[16]; const f32x4* kf = (const f32x4*)(KF + (size_t)(item & 511) * NFFT) + 16 * tid;
#pragma unroll
          for (int m = 0; m < 16; ++m) kq[m] = kf[m];
          fft_mid_mul(buf, kq, tid); }
        fft_super<4, 5, true>(buf, TW, tid);
        if (item + step < n_items) { const int nx = item + step; f32x4* v0 = (f32x4*)(UT + ((size_t)(2 * (nx >> 9)) * CW + (nx & 511)) * SEQ); f32x4* v1 = v0 + (size_t)CW * SEQ / 4;
#pragma unroll
            for (int q = 0; q < 4; ++q) { ua[q] = v0[tid + NTHR * q]; ub[q] = v1[tid + NTHR * q]; } }
        fft_super0_half<true>(buf, TW, tid);
#pragma unroll
        for (int q = 0; q < 4; ++q) { const int i = tid + NTHR * q; f32x4 a, b;
#pragma unroll
            for (int k = 0; k < 4; ++k) { const f32x2v y = buf[pidx(4 * i + k)]; a[k] = y.x; b[k] = y.y; }
            u0[i] = a; u1[i] = b; }
        __syncthreads();
    }
#undef CV_ROWS
}

__device__ __forceinline__ void modulate_rows(const float* srcL, const float* srcC, const bf16* XR  , const float* g, const float* mod  , int shoff, bf16* XN, int row_lo, int row_hi, int gw, int ngw, int lane, const float* part = nullptr  , const float* pgate = nullptr) {
    for (int rowa = row_lo + gw; rowa < row_hi; rowa += 2 * ngw) {
        f32x4 v[2][4]; float ss[2];
#pragma unroll
        for (int q = 0; q < 2; ++q) { const int row = rowa + q * ngw;
            if (row < row_hi) {
                if (XR) { const unsigned long long* xr = (const unsigned long long*)(XR + (size_t)row * DM) + lane;
#pragma unroll
                    for (int j = 0; j < 4; ++j) { const unsigned long long w = xr[64 * j]; const unsigned lo = (unsigned)w, hi = (unsigned)(w >> 32); v[q][j] = (f32x4){bflo(lo), bfhi(lo), bflo(hi), bfhi(hi)}; }
                    if (part) { const float* p0 = part + (size_t)(row - ML) * DM + 4 * lane;
#pragma unroll
                        for (int j = 0; j < 4; ++j) v[q][j] = v[q][j] + *(const f32x4*)(pgate + 4 * lane + 256 * j) * (*(const f32x4*)(p0 + 256 * j) + *(const f32x4*)(p0 + (size_t)MC * DM + 256 * j)); } }
                else { const f32x4* xr = (const f32x4*)(row < ML ? srcL + (size_t)row * DM : srcC + (size_t)(row - ML) * DM) + lane;
#pragma unroll
                    for (int j = 0; j < 4; ++j) v[q][j] = xr[64 * j]; } }
            else {
#pragma unroll
                for (int j = 0; j < 4; ++j) v[q][j] = (f32x4){0.f, 0.f, 0.f, 0.f}; } }
#pragma unroll
        for (int q = 0; q < 2; ++q) { ss[q] = 0.f;
#pragma unroll
            for (int j = 0; j < 4; ++j) ss[q] += (v[q][j].x * v[q][j].x + v[q][j].y * v[q][j].y) + (v[q][j].z * v[q][j].z + v[q][j].w * v[q][j].w); }
#pragma unroll
        for (int o = 1; o < 64; o <<= 1) { ss[0] += __shfl_xor(ss[0], o); ss[1] += __shfl_xor(ss[1], o); }
#pragma unroll
        for (int q = 0; q < 2; ++q) { const int row = rowa + q * ngw; if (row >= row_hi) continue;
            const float* mr = mod + (row < ML ? (row >> 13) : 4) * 6144;
            const float rinv = 1.0f / sqrtf(ss[q] * (1.f / DM) + 1e-6f);
            unsigned long long* o8 = (unsigned long long*)(XN + (size_t)row * DM) + lane;
#pragma unroll
            for (int j = 0; j < 4; ++j) { const int col = 4 * lane + 256 * j; const f32x4 gg = *(const f32x4*)(g + col), sh = *(const f32x4*)(mr + shoff + col), sc = *(const f32x4*)(mr + shoff + 1024 + col);
                const f32x4 y = v[q][j] * rinv * gg * (sc + 1.0f) + sh;
                o8[64 * j] = (unsigned long long)pk2(y.x, y.y) | ((unsigned long long)pk2(y.z, y.w) << 32); } }
    }
}
__device__ __forceinline__ void qk_norm_rope(bf16* Z, const float* qn, const float* kn, const f32x2v* ROPE, int it_lo, int it_hi, int blk, int nblk, int tid) {
    constexpr float C2 = 0.125f * 1.4426950408889634f;
    const int j = tid & 7;
    for (int ita = it_lo + blk; ita < it_hi; ita += 4 * nblk) {
        v4u raw[4];
#pragma unroll
        for (int q = 0; q < 4; ++q) { const int it = ita + q * nblk; if (it < it_hi) { const int hr = it * 64 + (tid >> 3); raw[q] = *(const v4u*)(Z + (size_t)(hr / 12) * ZW + (hr % 12) * 64 + 8 * j); } else raw[q] = (v4u){0u, 0u, 0u, 0u}; }
#pragma unroll
        for (int q = 0; q < 4; ++q) { const int it = ita + q * nblk; if (it >= it_hi) continue;
            const int hr = it * 64 + (tid >> 3), row = hr / 12, head = hr % 12;
            bf16* p = Z + (size_t)row * ZW + head * 64 + 8 * j;
            float x[8]; unpack8(raw[q], x);
            float ss = 0.f;
#pragma unroll
            for (int i = 0; i < 8; ++i) ss += x[i] * x[i];
            ss += __shfl_xor(ss, 1); ss += __shfl_xor(ss, 2); ss += __shfl_xor(ss, 4);
            const float rinv = 1.0f / sqrtf(ss * (1.f / 64.f) + 1e-6f);
            const float* gn = (head < 8 ? qn : kn) + 8 * j;
#pragma unroll
            for (int i = 0; i < 8; ++i) x[i] = x[i] * rinv * gn[i];
            float other[8];
#pragma unroll
            for (int i = 0; i < 8; ++i) other[i] = __shfl_xor(x[i], 2);
            if (row < ML) {
                const int t = row & (SEQ - 1), pos = (j >> 2) ? (t & 63) : (t >> 6), jj = j & 3, f0 = (jj & 1) * 8; const bool second = (jj >> 1) != 0;
                const f32x2v* rp = ROPE + pos * 16 + f0;
#pragma unroll
                for (int i = 0; i < 8; ++i) { const f32x2v cs = rp[i]; x[i] = second ? (other[i] * cs.y + x[i] * cs.x) : (x[i] * cs.x - other[i] * cs.y); }
            }
            if (head < 8) {
#pragma unroll
                for (int i = 0; i < 8; ++i) x[i] *= C2;
            }
            *(v4u*)p = pack8(x);
        }
    }
}
__device__ __forceinline__ void hyena_pre(const bf16* Z, const float* cw, const float* cb, bf16* OC, float* UT, float* UC, LAS float* T, int it_lo, int it_hi, int blk, int nblk, int tid) {
    const int tt = tid >> 3, cg8 = (tid & 7) * 8, c0 = (blk & 7) * 64, c = c0 + cg8;
    float w[3][4][8];
#pragma unroll
    for (int gsel = 0; gsel < 3; ++gsel)
#pragma unroll
        for (int i = 0; i < 8; ++i) { const int col = gsel * CW + c + i; w[gsel][0][i] = cw[col]; w[gsel][1][i] = cw[3 * CW + col]; w[gsel][2][i] = cw[6 * CW + col]; w[gsel][3][i] = cb[col]; }
    const v4u zero = (v4u){0u, 0u, 0u, 0u};
    const int rt_hi = it_hi >> 3, rstep = nblk >> 3;
    v4u cur[9], nxt[9];
#define HP_LOAD(dst, rt_) do { const int row_ = (rt_) * 64 + tt; const bool lat_ = row_ < ML; const int tp_ = lat_ ? (row_ & (SEQ - 1)) : ((row_ - ML) & (CTXL - 1)); const int sl_ = lat_ ? SEQ : CTXL; \
        _Pragma("unroll") for (int g_ = 0; g_ < 3; ++g_) { const bf16* zp_ = Z + (size_t)row_ * ZW + 1024 + g_ * CW + c; dst[3 * g_ + 1] = *(const v4u*)zp_; \
            dst[3 * g_] = tp_ > 0 ? *(const v4u*)(zp_ - ZW) : zero; dst[3 * g_ + 2] = tp_ < sl_ - 1 ? *(const v4u*)(zp_ + ZW) : zero; } } while (0)
    int rt = (it_lo >> 3) + (blk >> 3);
    if (rt < rt_hi) HP_LOAD(cur, rt);
    for (; rt < rt_hi; rt += rstep) {
        const int row = rt * 64 + tt; const bool lat = row < ML;
        if (rt + rstep < rt_hi) HP_LOAD(nxt, rt + rstep);
        float zc[3][8];
#pragma unroll
        for (int gsel = 0; gsel < 3; ++gsel) { float a[8], b[8], d[8]; unpack8(cur[3 * gsel], a); unpack8(cur[3 * gsel + 1], b); unpack8(cur[3 * gsel + 2], d);
#pragma unroll
            for (int i = 0; i < 8; ++i) zc[gsel][i] = a[i] * w[gsel][0][i] + b[i] * w[gsel][1][i] + d[i] * w[gsel][2][i] + w[gsel][3][i]; }
        *(v4u*)(OC + (size_t)row * DM + 512 + c) = pack8(zc[0]);
        float u[8];
#pragma unroll
        for (int i = 0; i < 8; ++i) u[i] = zc[2][i] * zc[1][i];
        if (lat) {
#pragma unroll
            for (int i = 0; i < 8; ++i) T[tt * 65 + cg8 + i] = u[i];
            __syncthreads();
            const int cl = tid >> 3, seg = (tid & 7) * 8, b = row >> 13, tb = (rt * 64) & (SEQ - 1);
            f32x4 o0, o1;
#pragma unroll
            for (int i = 0; i < 4; ++i) { o0[i] = T[(seg + i) * 65 + cl]; o1[i] = T[(seg + 4 + i) * 65 + cl]; }
            float* dst = UT + ((size_t)b * CW + c0 + cl) * SEQ + tb + seg;
            *(f32x4*)dst = o0; *(f32x4*)(dst + 4) = o1;
            __syncthreads();
        } else {
            float* dst = UC + (size_t)(row - ML) * CW + c;
            *(f32x4*)dst = (f32x4){u[0], u[1], u[2], u[3]}; *(f32x4*)(dst + 4) = (f32x4){u[4], u[5], u[6], u[7]};
        }
#pragma unroll
        for (int k = 0; k < 9; ++k) cur[k] = nxt[k];
    }
#undef HP_LOAD
}
__device__ __forceinline__ void ctx_conv_item(const float* KC, const float* FSC, const float* UC, const float* bias_d, bf16* OC, LAS float* L, int item, int tid) {
    const int b = item >> 5, c0 = (item & 31) * 16, cl = tid & 15, tg = tid >> 4, c = c0 + cl;
    LAS float* Ks = L; LAS float* Us = L + 512 * 16;
    for (int i = tid; i < 511 * 4; i += NTHR) { const int r = i >> 2, q = (i & 3) * 4; *(LAS f32x4*)(Ks + r * 16 + q) = *(const f32x4*)(KC + (size_t)r * CW + c0 + q); }
    for (int i = tid; i < 256 * 4; i += NTHR) { const int r = i >> 2, q = (i & 3) * 4; *(LAS f32x4*)(Us + r * 16 + q) = *(const f32x4*)(UC + ((size_t)b * CTXL + r) * CW + c0 + q); }
    __syncthreads();
    float acc[8];
#pragma unroll
    for (int i = 0; i < 8; ++i) acc[i] = 0.f;
    const int T0 = 8 * tg;
#pragma unroll 1
    for (int s0 = 0; s0 < CTXL; s0 += 8) {
        float kw[15], uu[8];
#pragma unroll
        for (int d = 0; d < 15; ++d) { const int idx = T0 + 255 - s0 + (d - 7); kw[d] = (idx >= 0 && idx < 511) ? Ks[idx * 16 + cl] : 0.f; }
#pragma unroll
        for (int j = 0; j < 8; ++j) uu[j] = Us[(s0 + j) * 16 + cl];
#pragma unroll
        for (int j = 0; j < 8; ++j)
#pragma unroll
            for (int i = 0; i < 8; ++i) acc[i] += kw[i - j + 7] * uu[j];
    }
    float sn = 0.f;
#pragma unroll
    for (int ch = 0; ch < 8; ++ch) sn += FSC[ch * 1024 + c] + FSC[ch * 1024 + 512 + c];
    const float rs = 1.f / sn, bd = bias_d[c];
#pragma unroll
    for (int i = 0; i < 8; ++i) { const int t = T0 + i; bf16* op = OC + (size_t)(ML + b * CTXL + t) * DM + 512 + c;
        const float x0 = __builtin_bit_cast(float, (unsigned)(*op) << 16);
        *op = (bf16)f2bf((acc[i] * rs + Us[t * 16 + cl] * bd) * x0); }
    __syncthreads();
}
__device__ __forceinline__ void hyena_post(const float* UT, bf16* OC, LAS float* T, int blk, int nblk, int tid) {
    const int c0 = (blk & 7) * 64, rstep = nblk >> 3, cl = tid >> 3, seg = (tid & 7) * 8, tt = tid >> 3, cg8 = (tid & 7) * 8;
    f32x4 a0, a1, n0, n1; v4u xc, xn;
#define HQ_LOAD(o0_, o1_, x_, rt_) do { const int b_ = ((rt_) * 64) >> 13, tb_ = ((rt_) * 64) & (SEQ - 1); const float* src_ = UT + ((size_t)b_ * CW + c0 + cl) * SEQ + tb_ + seg; \
        o0_ = *(const f32x4*)src_; o1_ = *(const f32x4*)(src_ + 4); x_ = *(const v4u*)(OC + (size_t)((rt_) * 64 + tt) * DM + 512 + c0 + cg8); } while (0)
    int rt = blk >> 3;
    if (rt < ML / 64) HQ_LOAD(a0, a1, xc, rt);
    for (; rt < ML / 64; rt += rstep) {
        if (rt + rstep < ML / 64) HQ_LOAD(n0, n1, xn, rt + rstep);
#pragma unroll
        for (int i = 0; i < 4; ++i) { T[(seg + i) * 65 + cl] = a0[i]; T[(seg + 4 + i) * 65 + cl] = a1[i]; }
        __syncthreads();
        { float x0[8]; unpack8(xc, x0);
#pragma unroll
          for (int i = 0; i < 8; ++i) x0[i] *= T[tt * 65 + cg8 + i];
          *(v4u*)(OC + (size_t)(rt * 64 + tt) * DM + 512 + c0 + cg8) = pack8(x0); }
        __syncthreads();
        a0 = n0; a1 = n1; xc = xn;
    }
#undef HQ_LOAD
}
__device__ __forceinline__ void short_conv(const bf16* Z, const float* cw, bf16* OC, int blk, int nblk, int tid) {
    const int cg8 = (tid & 63) * 8;
    float w0[8], w1[8], w2[8];
#pragma unroll
    for (int i = 0; i < 8; ++i) { w0[i] = cw[cg8 + i]; w1[i] = cw[CW + cg8 + i]; w2[i] = cw[2 * CW + cg8 + i]; }
    const v4u zero = (v4u){0u, 0u, 0u, 0u};
    for (int ita = blk; ita < ML / 8; ita += 2 * nblk) {
        v4u r[2][7];
#pragma unroll
        for (int q = 0; q < 2; ++q) { const int it = ita + q * nblk; const bool ok = it < ML / 8; const int row = (ok ? it : ita) * 8 + (tid >> 6), t = row & (SEQ - 1);
            const bf16* zp = Z + (size_t)row * ZW + 1024 + cg8;
            r[q][0] = *(const v4u*)zp; r[q][1] = *(const v4u*)(zp + 512); r[q][2] = *(const v4u*)(zp + 1024);
            r[q][3] = t > 0 ? *(const v4u*)(zp - ZW + 512) : zero; r[q][4] = t > 0 ? *(const v4u*)(zp - ZW + 1024) : zero;
            r[q][5] = t < SEQ - 1 ? *(const v4u*)(zp + ZW + 512) : zero; r[q][6] = t < SEQ - 1 ? *(const v4u*)(zp + ZW + 1024) : zero; }
#pragma unroll
        for (int q = 0; q < 2; ++q) { const int it = ita + q * nblk; if (it >= ML / 8) continue; const int row = it * 8 + (tid >> 6);
            float bg[8], c1[8], x1[8], acc[8];
            unpack8(r[q][0], bg); unpack8(r[q][1], c1); unpack8(r[q][2], x1);
#pragma unroll
            for (int i = 0; i < 8; ++i) acc[i] = c1[i] * x1[i] * w1[i];
            unpack8(r[q][3], c1); unpack8(r[q][4], x1);
#pragma unroll
            for (int i = 0; i < 8; ++i) acc[i] += c1[i] * x1[i] * w0[i];
            unpack8(r[q][5], c1); unpack8(r[q][6], x1);
#pragma unroll
            for (int i = 0; i < 8; ++i) acc[i] += c1[i] * x1[i] * w2[i];
#pragma unroll
            for (int i = 0; i < 8; ++i) acc[i] *= bg[i];
            *(v4u*)(OC + (size_t)row * DM + 512 + cg8) = pack8(acc); }
    }
}
__device__ __forceinline__ float gelu_tanh(float x) { const float u = 0.7978845608028654f * (x + 0.044715f * x * x * x); const float e = __expf(2.f * u); const float th = 1.f - 2.f / (e + 1.f); return 0.5f * x * (1.f + th); }
__device__ __forceinline__ void ffn_gate(const bf16* AV, bf16* G, const float* cw, const float* cb, int row0, int nrows, int blk, int nblk, int tid) {
    const int rs = tid >> 5, jl = tid & 31;
    for (int it = blk; it < nrows / 64; it += nblk) {
        const int r0 = it * 64 + rs * 4;
        for (int cbk = 0; cbk < 11; ++cbk) {
            const int j = cbk * 256 + jl * 8;
            const int ca = (j >> 7) * 256 + (j & 127);
            float w0[8], w1[8], w2[8], bb[8];
#pragma unroll
            for (int i = 0; i < 8; ++i) { w0[i] = cw[j + i]; w1[i] = cw[FF + j + i]; w2[i] = cw[2 * FF + j + i]; bb[i] = cb[j + i]; }
            float prev[8], cur[8], nxt[8];
            { const int gr = row0 + r0; const bool lat = gr < ML; const int tpos = lat ? (gr & (SEQ - 1)) : ((gr - ML) & (CTXL - 1));
              if (tpos > 0) unpack8(*(const v4u*)(AV + (size_t)(r0 - 1) * FF2 + ca), prev); else { for (int i = 0; i < 8; ++i) prev[i] = 0.f; } }
            unpack8(*(const v4u*)(AV + (size_t)r0 * FF2 + ca), cur);
#pragma unroll
            for (int rr = 0; rr < 4; ++rr) {
                const int lr = r0 + rr, gr = row0 + lr; const bool lat = gr < ML; const int tpos = lat ? (gr & (SEQ - 1)) : ((gr - ML) & (CTXL - 1)); const int slen = lat ? SEQ : CTXL;
                if (tpos < slen - 1) unpack8(*(const v4u*)(AV + (size_t)(lr + 1) * FF2 + ca), nxt); else { for (int i = 0; i < 8; ++i) nxt[i] = 0.f; }
                float vv[8], o[8]; unpack8(*(const v4u*)(AV + (size_t)lr * FF2 + ca + 128), vv);
#pragma unroll
                for (int i = 0; i < 8; ++i) { const float a = prev[i] * w0[i] + cur[i] * w1[i] + nxt[i] * w2[i] + bb[i]; o[i] = gelu_tanh(a) * vv[i]; }
                *(v4u*)(G + (size_t)lr * FF + j) = pack8(o);
#pragma unroll
                for (int i = 0; i < 8; ++i) { prev[i] = cur[i]; cur[i] = nxt[i]; }
            }
        }
    }
}

#define RLX_AGENT __ATOMIC_RELAXED, __HIP_MEMORY_SCOPE_AGENT

#define XB_TMO      128
#define XB_XCNT(j)  (256  + 64 * (j))
#define XB_XSUB(j)  (1280 + 64 * (j))
#define XB_XGEN(j)  (2304 + 64 * (j))
#define XB_TOP      3328
#define XB_TOPGEN   3392
#define XCD_BAR_WORDS 3456
#define XB_SPIN_CAP (1u << 18)

__device__ __forceinline__ unsigned xb_ld(unsigned* p)              { return __hip_atomic_load(p, __ATOMIC_RELAXED, __HIP_MEMORY_SCOPE_AGENT); }
__device__ __forceinline__ unsigned xb_add(unsigned* p, unsigned v) { return __hip_atomic_fetch_add(p, v, __ATOMIC_RELAXED, __HIP_MEMORY_SCOPE_AGENT); }
__device__ __forceinline__ unsigned xb_xcc_id() { return (unsigned)__builtin_amdgcn_s_getreg((3 << 11) | 20) & 0xFu; }
#define XB_SPIN(cond, bar) do { unsigned _sp = 0; while (cond) { __builtin_amdgcn_s_sleep(1); \
    if ((++_sp & 255u) == 0u) { if (xb_ld(&(bar)[XB_TMO])) break; if (_sp > XB_SPIN_CAP) { atomicAdd(&(bar)[XB_TMO], 1u); break; } } } } while (0)

struct XcdBarrier {
    unsigned* bar; unsigned x;
    volatile LAS unsigned* st;
};

__device__ __forceinline__ XcdBarrier xcd_barrier_post(unsigned* bar, volatile LAS unsigned* st) {
    XcdBarrier b; b.bar = bar; b.x = xb_xcc_id(); b.st = st;
    if (threadIdx.x == 0) (void)xb_add(&bar[XB_XCNT(b.x)], 1u);
    return b;
}
__device__ __forceinline__ void xcd_barrier_complete(unsigned* bar, unsigned x, unsigned& nloc, unsigned& nx) {
    const unsigned G = gridDim.x * gridDim.y * gridDim.z;
    unsigned sum, cnt, mine, sp = 0u;
    for (;;) {
        sum = 0u; cnt = 0u; mine = 0u;
#pragma unroll
        for (unsigned j = 0; j < 16; ++j) { const unsigned c = xb_ld(&bar[XB_XCNT(j)]); sum += c; cnt += (c > 0u) ? 1u : 0u; mine = (j == x) ? c : mine; }
        if (sum == G) break;
        __builtin_amdgcn_s_sleep(1);
        if ((++sp & 255u) == 0u) { if (xb_ld(&bar[XB_TMO])) break; if (sp > XB_SPIN_CAP) { atomicAdd(&bar[XB_TMO], 1u); break; } }
    }
    nloc = mine > 0u ? mine : 1u; nx = cnt > 0u ? cnt : 1u;
}

__device__ __forceinline__ void xcd_barrier(const XcdBarrier& b) {
    asm volatile("s_waitcnt vmcnt(0)" ::: "memory");
    __syncthreads();
    if (threadIdx.x == 0) {
        unsigned* bar = b.bar;
        __builtin_amdgcn_s_waitcnt(0);
        unsigned nloc = b.st[0], nx = b.st[1];
        if (nloc == 0u) { xcd_barrier_complete(bar, b.x, nloc, nx); b.st[0] = nloc; b.st[1] = nx; }
        const unsigned old = xb_add(&bar[XB_XSUB(b.x)], 1u);
        const unsigned gen = old / nloc;
        if (old + 1u == (gen + 1u) * nloc) {
            __builtin_amdgcn_fence(__ATOMIC_RELEASE, "agent");
            asm volatile("s_waitcnt vmcnt(0)" ::: "memory");
            const unsigned og = xb_add(&bar[XB_TOP], 1u);
            const unsigned tg = og / nx;
            if (og + 1u == (tg + 1u) * nx) xb_add(&bar[XB_TOPGEN], 1u);
            else XB_SPIN(xb_ld(&bar[XB_TOPGEN]) == tg, bar);
            __builtin_amdgcn_fence(__ATOMIC_ACQUIRE, "agent");
            xb_add(&bar[XB_XGEN(b.x)], 1u);
            asm volatile("s_waitcnt vmcnt(0)" ::: "memory");
        } else {
            XB_SPIN(xb_ld(&bar[XB_XGEN(b.x)]) == gen, bar);
            __builtin_amdgcn_fence(__ATOMIC_ACQUIRE, "agent");
            asm volatile("s_waitcnt vmcnt(0)" ::: "memory");
        }
    }
    __syncthreads();
}


constexpr int SEAM_STRIDE = 1152, N_SEAMS = 10;
__device__ __forceinline__ void seam_arrive(unsigned* sw, const XcdBarrier& b) {
    asm volatile("s_waitcnt vmcnt(0)" ::: "memory");
    __syncthreads();
    if (threadIdx.x == 0) { const unsigned nloc = b.st[0]; const unsigned old = xb_add(&sw[64 * (1 + b.x)], 1u);
        if (old + 1u == nloc) { __builtin_amdgcn_fence(__ATOMIC_RELEASE, "agent"); asm volatile("s_waitcnt vmcnt(0)" ::: "memory"); (void)xb_add(&sw[0], 1u); } }
}
__device__ __forceinline__ void seam_wait(unsigned* sw, const XcdBarrier& b) {
    if (threadIdx.x == 0) { const unsigned nx = b.st[1]; unsigned sp = 0u; while (xb_ld(&sw[0]) < nx) { __builtin_amdgcn_s_sleep(4); if (++sp > (1u << 22)) break; }
        __builtin_amdgcn_fence(__ATOMIC_ACQUIRE, "agent"); asm volatile("s_waitcnt vmcnt(0)" ::: "memory"); }
    __syncthreads();
}
constexpr int SEAM_WORDS = N_SEAMS * SEAM_STRIDE;

struct Args { const float* in[29]; float* out; unsigned char* ws; };
enum { I_X = 0, I_C, I_CTX, I_CCTX, I_ADAW, I_ADAB, I_NMIX, I_NFFN, I_WIN, I_WOUT, I_QN, I_KN, I_SINK, I_HCW, I_HCB, I_HW1, I_HB1, I_HW2, I_HB2, I_HW3, I_HB3, I_HW4, I_HFREQ, I_HBIASD, I_SCW, I_WUP, I_FCW, I_FCB, I_WDOWN };

#ifndef PHMASK
#define PHMASK 0xffffffffu
#endif
#define PH(n) ((PHMASK >> (n)) & 1u)
#ifndef DBL
#define DBL 0
#endif
#define REP(b) for (int rep_ = 0; rep_ < (((DBL >> (b)) & 1) ? 2 : 1); ++rep_)
#define TBEG(b) unsigned long long t0_ = 0; if ((DBL >> (b)) & 1) t0_ = __builtin_amdgcn_s_memrealtime()
#define TEND(b) do { if ((DBL >> (b)) & 1) { const unsigned long long t1_ = __builtin_amdgcn_s_memrealtime(), d_ = t1_ - t0_; while (__builtin_amdgcn_s_memrealtime() - t1_ < d_) __builtin_amdgcn_s_sleep(8); } } while (0)
#define GSYNC() do { xcd_barrier(xbar); if (DBL & 1) xcd_barrier(xbar); } while (0)
typedef const float* const __attribute__((address_space(4))) * kargp_t;
#define IDS() int tid = threadIdx.x; asm volatile("" : "+v"(tid)); const int lane = tid & 63, wave = __builtin_amdgcn_readfirstlane(tid >> 6); int bx = blockIdx.x; asm volatile("" : "+s"(bx)); \
    const int gw = bx * 8 + wave, G = gridDim.x, ngw = G * 8; (void)lane; (void)gw; (void)wave; (void)ngw; \
    unsigned long long kb_ = (unsigned long long)__builtin_amdgcn_kernarg_segment_ptr(); asm volatile("" : "+s"(kb_)); const kargp_t KA = (kargp_t)kb_; \
    unsigned char* const ws = (unsigned char*)KA[30]; float* const OUT = (float*)KA[29]; (void)ws; (void)OUT; \
    const bool last = layer == 1; (void)last
#define IN(i) (KA[i])
#define P_MOD ((float*)(ws + WS_MOD))
#define P_TW ((f32x2v*)(ws + WS_TW))
#define P_ROPE ((f32x2v*)(ws + WS_ROPE))
#define P_FSUMC ((float*)(ws + WS_FSUMC))
#define P_FSUM ((float*)(ws + WS_FSUM))
#define P_KC ((float*)(ws + WS_KC))
#define P_UC ((float*)(ws + WS_UC))
#define P_XC ((float*)(ws + WS_XC))
#define P_XR ((bf16*)(ws + WS_XR))
#define P_PART ((float*)(ws + WS_PART))
#define P_XN ((bf16*)(ws + WS_XN))
#define P_Z ((bf16*)(ws + WS_Z))
#define P_OC ((bf16*)(ws + WS_OC))
#define P_UT ((float*)(ws + WS_UT))
#define P_KF ((f32x2v*)(ws + WS_KF))
#define P_AV ((bf16*)(ws + WS_AV))
#define P_G ((bf16*)(ws + WS_G))
#define P_EA ((float*)(ws + WS_EA))
#define P_EV ((float*)(ws + WS_EV))
#define P_MODL (P_MOD + (size_t)layer * 5 * 6144)
#define P_WB (ws + WS_WB + (size_t)layer * WB_LAYER)
#define RES_L (last ? (const float*)OUT : IN(I_X))
#define RES_C (last ? (const float*)P_XC : IN(I_CTX))
__global__ void __launch_bounds__(NTHR, 2) hfb_fwd(Args a) {
    extern __shared__ __attribute__((aligned(16))) unsigned char lds[];
    cg::grid_group grid = cg::this_grid();
    LAS unsigned char* L = (LAS unsigned char*)lds;
    (void)a;
    volatile LAS unsigned* xst = (volatile LAS unsigned*)(L + LDS_BYTES - 64);
    if (threadIdx.x < 2) xst[threadIdx.x] = 0u;
    __syncthreads();
    XcdBarrier xbar;
    { unsigned long long kb0 = (unsigned long long)__builtin_amdgcn_kernarg_segment_ptr(); unsigned char* ws0 = (unsigned char*)((kargp_t)kb0)[30];
      if (blockIdx.x == 0) { unsigned* bw = (unsigned*)(ws0 + WS_BAR); for (int i = threadIdx.x; i < XCD_BAR_WORDS + SEAM_WORDS; i += NTHR) bw[i] = 0u; __threadfence(); } }
    { TBEG(7);
    { const int layer = 0; IDS(); if (PH(0)) p0_weights(IN(I_WIN), IN(I_WOUT), IN(I_WUP), IN(I_WDOWN), ws + WS_WB, (LAS float*)(L + wave * 16384), 0, TI_IN, gw, ngw, lane);
      __syncthreads(); }
    { const int layer = 0; IDS(); if (PH(1)) for (int lt = bx; lt < 512; lt += G) {
        int it; if (lt < 256) it = lt; else { const int j = lt - 256; if (j < 212) it = 272 + j; else if (j < 240) continue; else it = 256 + (j - 240); }
        if (it < 256) { TBEG(18); p0_filter_item<false>(IN(I_HW1), IN(I_HB1), IN(I_HW2), IN(I_HB2), IN(I_HW3), IN(I_HB3), IN(I_HW4), IN(I_HFREQ), P_UT, P_FSUM, (LAS float*)L, it, tid); TEND(18); }
        else if (it < 264) p0_filter_item<true, 0>(IN(I_HW1), IN(I_HB1), IN(I_HW2), IN(I_HB2), IN(I_HW3), IN(I_HB3), IN(I_HW4), IN(I_HFREQ), P_KC, P_FSUMC, (LAS float*)L, it - 256, tid);
        else if (it < 272) p0_filter_item<true, 1>(IN(I_HW1), IN(I_HB1), IN(I_HW2), IN(I_HB2), IN(I_HW3), IN(I_HB3), IN(I_HW4), IN(I_HFREQ), P_KC, P_FSUMC, (LAS float*)L, it - 264, tid);
        else if (it < 464) { TBEG(20); p0_mod_item(IN(I_C), IN(I_CCTX), IN(I_ADAW), IN(I_ADAB), P_MOD, (LAS float*)L, it - 272, tid); TEND(20); }
        else if (it < 480) { const int k = (it - 464) * NTHR + tid; float s, c; sincospif(2.0f * (float)k / (float)NFFT, &s, &c); P_TW[k] = (f32x2v){c, -s}; }
        else { const int e = (it - 480) * NTHR + tid, pos = e >> 4, f = e & 15; const float inv_pi = exp2f(-(float)f * 0.8304820237218406f) * 0.3183098861837907f; float sn, cs; sincospif((float)pos * inv_pi, &sn, &cs); P_ROPE[e] = (f32x2v){cs, sn}; }
    } }
    TEND(7); }
    grid.sync();
    { unsigned long long kb0 = (unsigned long long)__builtin_amdgcn_kernarg_segment_ptr(); unsigned char* ws0 = (unsigned char*)((kargp_t)kb0)[30]; xbar = xcd_barrier_post((unsigned*)(ws0 + WS_BAR), xst); }

#define SEAM(k) ((unsigned*)(ws + WS_BAR) + XCD_BAR_WORDS + SEAM_STRIDE * (k))
#define GEMM_CALL(EpiT) pg8::gemm_phase<EpiT, pg8::StaticOrder, true, true>(L, g, S, E)
#pragma unroll 1
    for (int layer = 0; layer < 2; ++layer) {
        { IDS(); if (!last) { for (int c = bx; c < CW / 2; c += G) filter_fft_item(P_UT, P_FSUM, IN(I_HBIASD), P_KF, P_TW, (LAS f32x2v*)L, (LAS float*)(L + FFT_LDS_ELEMS * 8), c, tid);
                              modulate_rows(IN(I_X), IN(I_CTX), nullptr, IN(I_NMIX), P_MODL, 0, P_XN, 0, MT, gw, ngw, lane); }
                   else modulate_rows(nullptr, nullptr, P_XR, IN(I_NMIX) + DM, P_MODL, 0, P_XN, ML, MT, gw, ngw, lane, P_PART, P_MOD + (size_t)4 * 6144 + 5 * 1024); }
        if (layer == 0) GSYNC(); else { IDS(); seam_arrive(SEAM(9), xbar); }
        { IDS(); const int nctx = last ? 8 : 40;
#pragma unroll 1
          for (int part = 0; part < 2; ++part) {
              if (part == 1) { seam_arrive(SEAM(last ? 4 : 0), xbar); if (bx >= nctx) break; if (last) seam_wait(SEAM(9), xbar); }
              const bool kv = part == 1 && last;
              pg8::Gemm g{P_XN + (part ? (size_t)ML * DM : 0), (const bf16*)(P_WB + WB_IN) + (kv ? (size_t)512 * DM : 0), part ? MC : ML, kv ? 512 : ZW, DM};
              pg8::StaticOrder S; S.init(g.M, g.N, G, bx); EpiStoreBf16 E{P_Z + (part ? (size_t)ML * ZW : 0) + (kv ? 512 : 0), ZW, IN(I_QN) + layer * 64, IN(I_KN) + layer * 64, P_ROPE, part ? 128 : 0, kv ? 2 : 0};
              GEMM_CALL(EpiStoreBf16); }
          if (bx >= nctx) { seam_wait(SEAM(last ? 4 : 0), xbar); const int rk = bx - nctx, nr = G - nctx;
              if (!last) hyena_pre(P_Z, IN(I_HCW), IN(I_HCB), P_OC, P_UT, P_UC, (LAS float*)L, 0, (ML / 64) * 8, rk, nr, tid);
              else short_conv(P_Z, IN(I_SCW), P_OC, rk, nr, tid); } }
        GSYNC();
        if (layer == 0) { { IDS(); hyena_pre(P_Z, IN(I_HCW), IN(I_HCB), P_OC, P_UT, P_UC, (LAS float*)L, (ML / 64) * 8, (MT / 64) * 8, bx, G, tid); }
                          { IDS(); seam_arrive(SEAM(5), xbar); } }
        if (layer == 0) {
            { IDS(); p0_weights(IN(I_WIN), IN(I_WOUT), IN(I_WUP), IN(I_WDOWN), ws + WS_WB, (LAS float*)(L + wave * 16384), TI_IN, 2 * TI_LAYER, gw, ngw, lane);
              __syncthreads(); }
            { IDS(); conv_fft_items(P_UT, P_KF, P_TW, (LAS f32x2v*)L, bx, G, 1024, tid); }
            { IDS(); seam_arrive(SEAM(6), xbar); }
            { IDS(); seam_wait(SEAM(5), xbar); }
            { IDS(); for (int it = G - 1 - bx; it < 128; it += G) ctx_conv_item(P_KC, P_FSUMC, P_UC, IN(I_HBIASD), P_OC, (LAS float*)L, it, tid);
              __syncthreads(); }
            { IDS(); const int vcu = (G % 8 == 0) ? (bx % 8) * (G / 8) + bx / 8 : bx;
              for (int i = 0; i < 5; ++i) {
                const int u = i * 256 + vcu; if (i == 4 && vcu >= 32) break;
                const attn_body::bf16* Zb = (const attn_body::bf16*)P_Z; attn_body::bf16* Ob = (attn_body::bf16*)P_OC;
                int b, h, NT; size_t qrow, lrow;
                if (i < 4) { const int bh = u >> 5, qb = u & 31; b = bh >> 3; h = bh & 7; qrow = (size_t)b * SEQ + qb * 256; lrow = (size_t)b * SEQ; NT = 4 + SEQ / 64; }
                else { b = vcu >> 3; h = vcu & 7; qrow = (size_t)ML + b * CTXL; lrow = qrow; NT = 4; }
                const int kvh = h >> 1; const size_t crow = (size_t)ML + b * CTXL;
                attn_body::attn_unit<12, false>(Zb + qrow * ZW + h * 64, Zb + crow * ZW + 512 + kvh * 64, Zb + lrow * ZW + 512 + kvh * 64, Zb + crow * ZW + 768 + kvh * 64, Zb + lrow * ZW + 768 + kvh * 64,
                                               Ob + qrow * DM + h * 64, NT, 0, 0, 0.f, (char*)lds);
              } }
            { IDS(); seam_wait(SEAM(6), xbar); }
            { IDS(); hyena_post(P_UT, P_OC, (LAS float*)L, bx, G, tid); }
        } else {
            { IDS(); const int vcu = (G % 8 == 0) ? (bx % 8) * (G / 8) + bx / 8 : bx;
              for (int i = 0; i < 4; ++i) {
                const int u = i * 256 + vcu, bh = u >> 5, qb = u & 31, b = bh >> 3, h = bh & 7, kvh = h >> 1;
                const int q0 = qb * 256, klo = q0 - 128 < 0 ? 0 : q0 - 128, khi = q0 + 384 > SEQ ? SEQ : q0 + 384;
                const size_t qrow = (size_t)b * SEQ + q0, crow = (size_t)ML + b * CTXL, lrow = (size_t)b * SEQ + klo;
                const attn_body::bf16* Zb = (const attn_body::bf16*)P_Z; attn_body::bf16* Ob = (attn_body::bf16*)P_OC;
                attn_body::attn_unit<8, true>(Zb + qrow * ZW + h * 64, Zb + crow * ZW + 512 + kvh * 64, Zb + lrow * ZW + 512 + kvh * 64, Zb + crow * ZW + 768 + kvh * 64, Zb + lrow * ZW + 768 + kvh * 64,
                                              Ob + qrow * DM + h * 64, 4 + (khi - klo) / 64, q0, klo, IN(I_SINK)[h] * 1.4426950408889634f, (char*)lds);
              } }
        }
        GSYNC();
        { IDS();
#pragma unroll 1
          for (int part = 0; part < (last ? 1 : 2); ++part) {
              if (part == 1) { seam_arrive(SEAM(1), xbar); if (bx >= 16) break; }
              pg8::Gemm g{P_OC + (part ? (size_t)ML * DM : 0), (const bf16*)(P_WB + WB_OUT), part ? MC : ML, DM, DM}; pg8::StaticOrder S; S.init(g.M, g.N, G, bx);
              EpiRes E{IN(I_X), IN(I_CTX), P_XR, OUT, P_MODL + 2 * 1024, last ? 1 : 0, 1, part ? 128 : 0};
              GEMM_CALL(EpiRes); }
          if (!last && bx >= 16) { seam_wait(SEAM(1), xbar);
              modulate_rows(nullptr, nullptr, P_XR, IN(I_NFFN) + layer * DM, P_MODL, 3 * 1024, P_XN, 0, ML, (bx - 16) * 8 + wave, (G - 16) * 8, lane); } }
        GSYNC();
        { IDS(); modulate_rows(nullptr, nullptr, P_XR, IN(I_NFFN) + layer * DM, P_MODL, 3 * 1024, P_XN, last ? 0 : ML, last ? ML : MT, gw, ngw, lane); }
        if (layer == 1) GSYNC(); else { IDS(); seam_arrive(SEAM(7), xbar); }
        { IDS();
#pragma unroll 1
          for (int part = 0; part < (last ? 1 : 2); ++part) {
              if (part == 1) { seam_arrive(SEAM(2), xbar); if (bx >= 88) break; seam_wait(SEAM(7), xbar); }
              pg8::Gemm g{P_XN + (part ? (size_t)ML * DM : 0), (const bf16*)(P_WB + WB_UP), part ? MC : ML, FF2, DM}; pg8::StaticOrder S; S.init(g.M, g.N, G, bx);
              EpiGate E{P_G, P_EA, P_EV, IN(I_FCW) + (size_t)layer * 3 * FF, IN(I_FCB) + (size_t)layer * FF, part ? 128 : 0};
              GEMM_CALL(EpiGate); }
          if (!last && bx >= 88) { seam_wait(SEAM(2), xbar);
              ffn_fixup(P_G, P_EA, P_EV, IN(I_FCW) + (size_t)layer * 3 * FF, IN(I_FCB) + (size_t)layer * FF, 0, ML / 64, (bx - 88) * NTHR + tid, (G - 88) * NTHR); } }
        GSYNC();
        { IDS(); ffn_fixup(P_G, P_EA, P_EV, IN(I_FCW) + (size_t)layer * 3 * FF, IN(I_FCB) + (size_t)layer * FF, last ? 0 : ML / 64, last ? ML / 64 : MT / 64, bx * NTHR + tid, G * NTHR); }
        if (layer == 1) GSYNC(); else { IDS(); seam_arrive(SEAM(8), xbar); }
        { IDS();
          { pg8::Gemm g{P_G, (const bf16*)(P_WB + WB_DOWN), ML, DM, FF, 0}; pg8::StaticOrder S; S.init(g.M, g.N, G, bx);
            EpiRes E{nullptr, nullptr, P_XR, OUT, P_MODL + 5 * 1024, 1, last ? 0 : 1, 0};
            GEMM_CALL(EpiRes); }
          if (!last) { seam_arrive(SEAM(3), xbar);
              if (bx < 32) { seam_wait(SEAM(8), xbar); const int half = bx >> 4;
                  pg8::Gemm g{P_G + (size_t)ML * FF + half * (FF / 2), (const bf16*)(P_WB + WB_DOWN) + half * (FF / 2), MC, DM, FF / 2, FF}; pg8::StaticOrder S; S.init(g.M, g.N, G, bx & 15);
                  EpiPartial E{P_PART + (size_t)half * MC * DM};
                  GEMM_CALL(EpiPartial); } }
          if (!last && bx >= 32) { seam_wait(SEAM(3), xbar);
              modulate_rows(nullptr, nullptr, P_XR, IN(I_NMIX) + DM, P_MOD + (size_t)5 * 6144, 0, P_XN, 0, ML, (bx - 32) * 8 + wave, (G - 32) * 8, lane); } }
        if (layer == 0) GSYNC();
    }
}

extern "C" void kernel_launch(void* const* d_in, const int* in_sizes, int n_in, void* d_out, int out_size, void* d_ws, size_t ws_size, hipStream_t stream) {
    static int grid = 0;
    if (grid == 0) {
        if (n_in != 29 || out_size != ML * DM || ws_size < WS_END) { fprintf(stderr, "kernel_launch: unexpected shapes (n_in %d, out %d, ws %zu < %zu)\n", n_in, out_size, ws_size, (size_t)WS_END); grid = -1; return; }
        int dev = 0, cus = 0, per_cu = 0;
        hipGetDevice(&dev); hipDeviceGetAttribute(&cus, hipDeviceAttributeMultiprocessorCount, dev);
        if (hipFuncSetAttribute((const void*)hfb_fwd, hipFuncAttributeMaxDynamicSharedMemorySize, LDS_BYTES) != hipSuccess) { fprintf(stderr, "kernel_launch: hipFuncSetAttribute failed\n"); grid = -1; return; }
        if (hipOccupancyMaxActiveBlocksPerMultiprocessor(&per_cu, (const void*)hfb_fwd, NTHR, LDS_BYTES) != hipSuccess || per_cu < 1) { fprintf(stderr, "kernel_launch: occupancy query says %d\n", per_cu); per_cu = 1; }
        (void)hipGetLastError();
        grid = cus;
    }
    if (grid < 0) return;
    Args a{};
    for (int i = 0; i < 29; ++i) a.in[i] = (const float*)d_in[i];
    a.out = (float*)d_out; a.ws = (unsigned char*)d_ws;
    void* args[] = {&a};
    hipError_t e = hipLaunchCooperativeKernel((const void*)hfb_fwd, dim3(grid), dim3(NTHR), args, LDS_BYTES, stream);
    if (e != hipSuccess) fprintf(stderr, "cooperative launch failed: %s (grid %d)\n", hipGetErrorString(e), grid);
}
```
